# Optimizing an MI355X kernel written in HIP

```python
import math
import jax, jax.numpy as jnp
from jax import lax
import numpy as np

D_MODEL = 1024
BATCH = 4
SEQ = 8192
DEPTH = 1

SSM_WIDTH = 512
SSM_GROUP = 16
SSM_GROUPS = SSM_WIDTH // SSM_GROUP
SSM_STATE = 64
DT_MIN = 1e-3
DT_MAX = 1e-1
N_HEADS = 8
HEAD_DIM = 64
ATTN_WIDTH = N_HEADS * HEAD_DIM
MOBA_BLOCK = 256
MOBA_TOPK = 3
QUERY_CHUNK = 32
ROPE_THETA = 500000.0
ROPE_DIM = HEAD_DIM // 4
N_GROUPS = 4
EXPERTS_PER_GROUP = 8
N_EXPERTS = N_GROUPS * EXPERTS_PER_GROUP
TOPK_INNER = 2
D_EXPERT = 128
EPS = 1e-6
IN_WIDTH = SSM_WIDTH + 3 * ATTN_WIDTH + 2 * D_MODEL

kernel_name = "hybrid_s5_moba_hmoe_block"


def _rmsnorm(x, g):
    xf = x.astype(jnp.float32)
    y = xf * lax.rsqrt(jnp.mean(xf * xf, axis=-1, keepdims=True) + EPS)
    return (y * g.astype(jnp.float32)).astype(x.dtype)


def _partial_rope(x, pos):
    half = ROPE_DIM // 2
    inv_freq = ROPE_THETA ** (-jnp.arange(half, dtype=jnp.float32) * 2.0 / ROPE_DIM)
    ang = pos[:, None] * inv_freq[None, :]
    cos, sin = jnp.cos(ang), jnp.sin(ang)
    x1 = x[..., :half]
    x2 = x[..., half:ROPE_DIM]
    rot = jnp.concatenate([x1 * cos - x2 * sin, x2 * cos + x1 * sin], axis=-1)
    return jnp.concatenate([rot, x[..., ROPE_DIM:]], axis=-1)


def _ssm_combine(e1, e2):
    a1r, a1i, b1r, b1i = e1
    a2r, a2i, b2r, b2i = e2
    return (a1r * a2r - a1i * a2i,
            a1r * a2i + a1i * a2r,
            a2r * b1r - a2i * b1i + b2r,
            a2r * b1i + a2i * b1r + b2i)


def _s5_branch(u, lam_re, lam_im, log_dt, b_re, b_im, c_re, c_im, d_skip, w_glu, b_glu):
    Bsz, S, _ = u.shape
    f32 = jnp.float32
    uf = u.astype(f32).reshape(Bsz, S, SSM_GROUPS, SSM_GROUP)
    dt = jnp.exp(log_dt.astype(f32))[:, None]
    lr = jnp.minimum(lam_re.astype(f32), -1e-4)
    li = lam_im.astype(f32)
    mag = jnp.exp(lr * dt)
    ar = mag * jnp.cos(li * dt)
    ai = mag * jnp.sin(li * dt)
    den = lr * lr + li * li
    nr = ar - 1.0
    ni = ai
    cr = (nr * lr + ni * li) / den
    ci = (ni * lr - nr * li) / den
    brf, bif = b_re.astype(f32), b_im.astype(f32)
    bbr = cr[..., None] * brf - ci[..., None] * bif
    bbi = cr[..., None] * bif + ci[..., None] * brf
    bu_r = jnp.einsum('bsgc,gnc->bsgn', uf, bbr)
    bu_i = jnp.einsum('bsgc,gnc->bsgn', uf, bbi)
    a_r = jnp.broadcast_to(ar, bu_r.shape)
    a_i = jnp.broadcast_to(ai, bu_i.shape)
    _, _, st_r, st_i = lax.associative_scan(_ssm_combine, (a_r, a_i, bu_r, bu_i), axis=1)
    y = (jnp.einsum('bsgn,gcn->bsgc', st_r, c_re.astype(f32))
         - jnp.einsum('bsgn,gcn->bsgc', st_i, c_im.astype(f32)))
    y = y.reshape(Bsz, S, SSM_WIDTH) + d_skip.astype(f32) * uf.reshape(Bsz, S, SSM_WIDTH)
    z = jax.nn.gelu(y)
    out = z * jax.nn.sigmoid(z @ w_glu.astype(f32) + b_glu.astype(f32))
    return out.astype(u.dtype)


def _moba_attention(q, k, v):
    Bsz, H, S, Dh = q.shape
    nb = -(-S // MOBA_BLOCK)
    s_pad = nb * MOBA_BLOCK
    padw = ((0, 0), (0, 0), (0, s_pad - S), (0, 0))
    q = jnp.pad(q, padw)
    k = jnp.pad(k, padw)
    v = jnp.pad(v, padw)
    kb = k.reshape(Bsz, H, nb, MOBA_BLOCK, Dh)
    vb = v.reshape(Bsz, H, nb, MOBA_BLOCK, Dh)
    kmean = jnp.mean(kb, axis=3)
    qblk = jnp.arange(s_pad) // MOBA_BLOCK
    scores = jnp.einsum('bhsd,bhnd->bhsn', q, kmean)
    past = jnp.arange(nb)[None, :] < qblk[:, None]
    scores = jnp.where(past, scores, -jnp.inf)
    k_sel = min(MOBA_TOPK, nb)
    _, top_idx = lax.top_k(scores, k_sel)
    valid = top_idx < qblk[:, None]
    own = jnp.broadcast_to(qblk[:, None], (Bsz, H, s_pad, 1)).astype(top_idx.dtype)
    sel = jnp.concatenate([top_idx, own], axis=-1)
    sel_valid = jnp.concatenate([valid, jnp.ones((Bsz, H, s_pad, 1), dtype=bool)], axis=-1)
    m = k_sel + 1
    scale = HEAD_DIM ** -0.5
    gather = jax.vmap(jax.vmap(lambda blocks, idx: blocks[idx]))
    key_off = jnp.arange(MOBA_BLOCK)

    def chunk(ci):
        start = ci * QUERY_CHUNK
        qc = lax.dynamic_slice_in_dim(q, start, QUERY_CHUNK, axis=2)
        sc = lax.dynamic_slice_in_dim(sel, start, QUERY_CHUNK, axis=2)
        vc = lax.dynamic_slice_in_dim(sel_valid, start, QUERY_CHUNK, axis=2)
        kg = gather(kb, sc)
        vg = gather(vb, sc)
        logits = jnp.einsum('bhqd,bhqmld->bhqml', qc, kg) * scale
        qpos = start + jnp.arange(QUERY_CHUNK)
        kpos = sc[..., None] * MOBA_BLOCK + key_off
        allowed = vc[..., None] & (kpos <= qpos[:, None, None])
        logits = jnp.where(allowed, logits, -jnp.inf)
        p = jax.nn.softmax(logits.reshape(Bsz, H, QUERY_CHUNK, m * MOBA_BLOCK), axis=-1)
        p = p.reshape(Bsz, H, QUERY_CHUNK, m, MOBA_BLOCK)
        return jnp.einsum('bhqml,bhqmld->bhqd', p, vg)

    outs = lax.map(chunk, jnp.arange(s_pad // QUERY_CHUNK))
    out = outs.transpose(1, 2, 0, 3, 4).reshape(Bsz, H, s_pad, Dh)
    return out[:, :, :S]


def _hier_moe(h, w_rg, b_rg, w_re, b_re, w_gate, w_up, w_down):
    Bsz, S, D = h.shape
    f32 = jnp.float32
    t = h.reshape(-1, D)
    g_prob = jax.nn.softmax((t @ w_rg).astype(f32) + b_rg.astype(f32), axis=-1)
    g_p, g_idx = lax.top_k(g_prob, 1)
    e_logits = ((t @ w_re).astype(f32) + b_re.astype(f32)).reshape(-1, N_GROUPS, EXPERTS_PER_GROUP)
    g_onehot = jax.nn.one_hot(g_idx[:, 0], N_GROUPS, dtype=f32)
    e_in = jnp.einsum('tge,tg->te', e_logits, g_onehot)
    e_val, e_idx = lax.top_k(e_in, TOPK_INNER)
    e_w = jax.nn.softmax(e_val, axis=-1) * g_p
    flat = g_idx * EXPERTS_PER_GROUP + e_idx
    comb = jnp.sum(jax.nn.one_hot(flat, N_EXPERTS, dtype=f32) * e_w[..., None], axis=1)
    hg = jnp.einsum('td,edf->tef', t, w_gate)
    hu = jnp.einsum('td,edf->tef', t, w_up)
    act = jax.nn.silu(hg) * hu * comb[:, :, None].astype(t.dtype)
    y = jnp.einsum('tef,efd->td', act, w_down)
    return y.reshape(Bsz, S, D)


def setup_inputs(seed: int = 0) -> dict:
    key = jax.random.key(seed)
    ks = jax.random.split(key, 32)
    f32 = jnp.float32
    nrm = lambda k, shape, s: jax.random.normal(k, shape, f32) * s
    L = DEPTH
    lam_im = (jnp.pi * jnp.arange(SSM_STATE, dtype=f32))[None, None, :] + nrm(ks[4], (L, SSM_GROUPS, SSM_STATE), 0.01)
    return {
        "x": nrm(ks[0], (BATCH, SEQ, D_MODEL), 1.0),
        "norm1_g": 1.0 + nrm(ks[1], (L, D_MODEL), 0.01),
        "w_in": nrm(ks[2], (L, D_MODEL, IN_WIDTH), D_MODEL ** -0.5),
        "lam_re": -0.5 + nrm(ks[3], (L, SSM_GROUPS, SSM_STATE), 0.01),
        "lam_im": lam_im,
        "log_dt": jax.random.uniform(ks[5], (L, SSM_GROUPS), f32, math.log(DT_MIN), math.log(DT_MAX)),
        "ssm_b_re": nrm(ks[6], (L, SSM_GROUPS, SSM_STATE, SSM_GROUP), (2 * SSM_GROUP) ** -0.5),
        "ssm_b_im": nrm(ks[7], (L, SSM_GROUPS, SSM_STATE, SSM_GROUP), (2 * SSM_GROUP) ** -0.5),
        "ssm_c_re": nrm(ks[8], (L, SSM_GROUPS, SSM_GROUP, SSM_STATE), 0.5),
        "ssm_c_im": nrm(ks[9], (L, SSM_GROUPS, SSM_GROUP, SSM_STATE), 0.5),
        "ssm_d": nrm(ks[10], (L, SSM_WIDTH), 1.0),
        "w_glu": nrm(ks[11], (L, SSM_WIDTH, SSM_WIDTH), SSM_WIDTH ** -0.5),
        "b_glu": nrm(ks[12], (L, SSM_WIDTH), 0.01),
        "q_norm_g": 1.0 + nrm(ks[13], (L, HEAD_DIM), 0.01),
        "k_norm_g": 1.0 + nrm(ks[14], (L, HEAD_DIM), 0.01),
        "w_proj_ssm": nrm(ks[15], (L, SSM_WIDTH, D_MODEL), SSM_WIDTH ** -0.5),
        "w_proj_attn": nrm(ks[16], (L, ATTN_WIDTH, D_MODEL), ATTN_WIDTH ** -0.5),
        "w_out": nrm(ks[17], (L, D_MODEL, D_MODEL), D_MODEL ** -0.5),
        "norm2_g": 1.0 + nrm(ks[18], (L, D_MODEL), 0.01),
        "w_router_group": nrm(ks[19], (L, D_MODEL, N_GROUPS), D_MODEL ** -0.5),
        "b_router_group": nrm(ks[20], (L, N_GROUPS), 0.01),
        "w_router_expert": nrm(ks[21], (L, D_MODEL, N_EXPERTS), D_MODEL ** -0.5),
        "b_router_expert": nrm(ks[22], (L, N_EXPERTS), 0.01),
        "w_gate": nrm(ks[23], (L, N_EXPERTS, D_MODEL, D_EXPERT), D_MODEL ** -0.5),
        "w_up": nrm(ks[24], (L, N_EXPERTS, D_MODEL, D_EXPERT), D_MODEL ** -0.5),
        "w_down": nrm(ks[25], (L, N_EXPERTS, D_EXPERT, D_MODEL), D_EXPERT ** -0.5),
    }


def reference(x, norm1_g, w_in, lam_re, lam_im, log_dt, ssm_b_re, ssm_b_im, ssm_c_re, ssm_c_im,
              ssm_d, w_glu, b_glu, q_norm_g, k_norm_g, w_proj_ssm, w_proj_attn, w_out, norm2_g,
              w_router_group, b_router_group, w_router_expert, b_router_expert, w_gate, w_up, w_down):
    Bsz, S, D = x.shape
    pos = jnp.arange(S, dtype=jnp.float32)
    offs = [SSM_WIDTH, SSM_WIDTH + ATTN_WIDTH, SSM_WIDTH + 2 * ATTN_WIDTH,
            SSM_WIDTH + 3 * ATTN_WIDTH, SSM_WIDTH + 3 * ATTN_WIDTH + D_MODEL]
    for l in range(DEPTH):
        h = _rmsnorm(x, norm1_g[l])
        proj = h @ w_in[l]
        u, q, k, v, g_ssm, g_attn = jnp.split(proj, offs, axis=-1)
        y_ssm = _s5_branch(u, lam_re[l], lam_im[l], log_dt[l], ssm_b_re[l], ssm_b_im[l],
                           ssm_c_re[l], ssm_c_im[l], ssm_d[l], w_glu[l], b_glu[l]) @ w_proj_ssm[l]
        heads = lambda t: t.astype(jnp.float32).reshape(Bsz, S, N_HEADS, HEAD_DIM).transpose(0, 2, 1, 3)
        qh = _partial_rope(_rmsnorm(heads(q), q_norm_g[l]), pos)
        kh = _partial_rope(_rmsnorm(heads(k), k_norm_g[l]), pos)
        vh = heads(v)
        att = _moba_attention(qh, kh, vh)
        att = att.transpose(0, 2, 1, 3).reshape(Bsz, S, ATTN_WIDTH).astype(x.dtype)
        y_attn = att @ w_proj_attn[l]
        merged = jax.nn.sigmoid(g_ssm) * y_ssm + jax.nn.sigmoid(g_attn) * y_attn
        x = x + merged @ w_out[l]
        h2 = _rmsnorm(x, norm2_g[l])
        x = x + _hier_moe(h2, w_router_group[l], b_router_group[l], w_router_expert[l],
                          b_router_expert[l], w_gate[l], w_up[l], w_down[l])
    return x
```

```cpp
#include <hip/hip_runtime.h>
#include <hip/hip_cooperative_groups.h>
#include <cstdio>
#include <cstdint>
namespace cg = cooperative_groups;

#define LAS __attribute__((address_space(3)))
typedef unsigned short bf16_t;
typedef short bf16x8 __attribute__((ext_vector_type(8)));
typedef float f32x2 __attribute__((ext_vector_type(2)));
typedef float f32x4 __attribute__((ext_vector_type(4)));
typedef float f32x16 __attribute__((ext_vector_type(16)));
typedef unsigned u32x2 __attribute__((ext_vector_type(2)));
typedef unsigned u32x4 __attribute__((ext_vector_type(4)));
typedef __bf16 bf16x2_t __attribute__((ext_vector_type(2)));

constexpr int NB = 4, SEQ = 8192, T = NB * SEQ, DM = 1024, NIN = 4096;
constexpr int NH = 8, HD = 64, NBH = NB * NH, NBLK = 32, BLK = 256;
constexpr int SSMW = 512, NG = 32, GC = 16, NS = 64;
constexpr int CL = 32, NCH = SEQ / CL, CROWS = NB * NCH  , KU = 128 + CL * GC  , NTC = CL * GC  ;
constexpr int NE = 32, DE = 128, NPAIR = 112;
constexpr float EPS = 1e-6f;
constexpr float QSCALE = 0.125f * 1.4426950408889634f;

constexpr size_t MiB = 1u << 20;
constexpr size_t WS_CTL = 0;
constexpr size_t WS_KMEAN = 1 * MiB;
constexpr size_t WS_A32 = WS_KMEAN + 256 * 1024;
constexpr size_t WS_WRT = WS_A32 + 64 * 1024;
constexpr size_t WS_KC = 2 * MiB;
constexpr size_t WS_MIN = 3 * MiB;
constexpr size_t WS_WIN = 8 * MiB;
constexpr size_t WS_WGLU = 16 * MiB;
constexpr size_t WS_WPS = 17 * MiB;
constexpr size_t WS_WPA = 18 * MiB;
constexpr size_t WS_WOUT = 19 * MiB;
constexpr size_t WS_WGU = 21 * MiB;
constexpr size_t WS_WDN = 37 * MiB;
constexpr size_t WS_MOUT = 46 * MiB;
constexpr size_t WS_A = 50 * MiB;
constexpr size_t WS_XN = WS_A;
constexpr size_t WS_LISTS = WS_A;
constexpr size_t WS_TG = WS_A + 16 * MiB;
constexpr size_t WS_ELOC = WS_A + 40 * MiB;
constexpr size_t WS_ATT = WS_A;
constexpr size_t WS_OS = WS_A + 32 * MiB;
constexpr size_t WS_B = 114 * MiB;
constexpr size_t WS_QH = WS_B, WS_KH = WS_B + 32 * MiB, WS_VT = WS_B + 64 * MiB;
constexpr size_t WS_MG = WS_B;
constexpr size_t WS_ACT = WS_B;
constexpr size_t WS_ELTOK = WS_B + 64 * MiB;
constexpr size_t WS_ELDST = WS_B + 68 * MiB;
constexpr size_t WS_ELW = WS_B + 72 * MiB;
constexpr size_t WS_ELR2 = WS_B + 76 * MiB;
constexpr size_t WS_PLTOK = WS_B + 80 * MiB;
constexpr size_t WS_C = 210 * MiB;
constexpr size_t WS_SGS = WS_C, WS_SGA = WS_C + 64 * MiB;
constexpr size_t WS_X1B = WS_C;
constexpr size_t WS_UGS = 338 * MiB;
constexpr size_t WS_Z = 380 * MiB;
constexpr size_t WS_PML = 412 * MiB;
constexpr size_t WS_END = 420 * MiB;
constexpr int CW_LCNT = 1024;
constexpr int CW_ECNT = 4096;
constexpr int CW_PCNT = 4224;

constexpr int RING_BYTES = 131072;
constexpr int MISC_OFF = RING_BYTES;
constexpr int LDS_BYTES = 147456;

__device__ __forceinline__ unsigned pk2(float lo, float hi) { f32x2 v = {lo, hi}; bf16x2_t b = __builtin_convertvector(v, bf16x2_t); return __builtin_bit_cast(unsigned, b); }
__device__ __forceinline__ bf16_t f2bf(float f) { return (bf16_t)(pk2(f, 0.f) & 0xffffu); }
__device__ __forceinline__ float bflo(unsigned w) { return __uint_as_float(w << 16); }
__device__ __forceinline__ float bfhi(unsigned w) { return __uint_as_float(w & 0xffff0000u); }
__device__ __forceinline__ float bf2f(bf16_t b) { return __uint_as_float(((unsigned)b) << 16); }
__device__ __forceinline__ u32x4 pk8(f32x4 a, f32x4 b) { u32x4 w; w.x = pk2(a[0], a[1]); w.y = pk2(a[2], a[3]); w.z = pk2(b[0], b[1]); w.w = pk2(b[2], b[3]); return w; }
__device__ __forceinline__ void unpk8(u32x4 w, f32x4& a, f32x4& b) { a = (f32x4){bflo(w.x), bfhi(w.x), bflo(w.y), bfhi(w.y)}; b = (f32x4){bflo(w.z), bfhi(w.z), bflo(w.w), bfhi(w.w)}; }
__device__ __forceinline__ float sigmoidf_(float x) { return 1.0f / (1.0f + __expf(-x)); }
__device__ __forceinline__ float gelu_tanh(float x) { const float u = 0.7978845608028654f * (x + 0.044715f * x * x * x); const float e = __expf(-2.0f * u); return x / (1.0f + e); }
__device__ __forceinline__ int lane_id() { int l = __builtin_amdgcn_mbcnt_hi(~0u, __builtin_amdgcn_mbcnt_lo(~0u, 0u)); asm volatile("" : "+v"(l)); return l; }
__device__ __forceinline__ float shx(float v, int mask, int lane) { return __uint_as_float(__builtin_amdgcn_ds_bpermute((lane ^ mask) << 2, __float_as_uint(v))); }
__device__ __forceinline__ int shup(int v, int o, int lane) { return __builtin_amdgcn_ds_bpermute((lane - o) << 2, v); }
__device__ __forceinline__ int fresh_tid(int wave) { int t = wave * 64 + lane_id(); asm volatile("" : "+v"(t)); return t; }
__device__ __forceinline__ float wave_sum(float v) {
    const int lane = lane_id();
#pragma unroll
    for (int o = 1; o < 64; o <<= 1) v += shx(v, o, lane);
    return v;
}

namespace gk {
constexpr int BM = 256, BK = 64, HALF = 128, HTB = HALF * BK * 2, STAGE_BYTES = 8 * HTB;
__device__ __forceinline__ int lds_byte(int r, int c) { const int st = (r >> 4) * 2 + (c >> 5), rr = r & 15, cc = c & 31, ob = rr * 64 + cc * 2; return st * 1024 + (ob ^ (((ob >> 9) & 1) << 5)); }
__device__ __forceinline__ void stage_rc(int b, int& R, int& C) { const int st = b / 1024, sb = b % 1024, swz = sb ^ (((sb >> 9) & 1) << 5); R = (st >> 1) * 16 + swz / 64; C = (st & 1) * 32 + (swz % 64) / 2; }
__device__ __forceinline__ int perm32(int rho) { const int n = rho >> 4, i = rho & 15; return 8 * (i >> 2) + 4 * n + (i & 3); }

struct Unit {
    int pm, pn;
    long aoff, boff;
    int nt;
    int nvalid;
    const int* rows;
    int bsplit; long bjump;
    int aux0, aux1;
};

template <class F> __device__ __forceinline__ void epi_rows(const f32x4 (&acc)[2][2][4][2], int wr, int wc, int fr, int fq, const F& f) {
#pragma unroll
    for (int ai = 0; ai < 2; ++ai)
#pragma unroll
        for (int m = 0; m < 4; ++m) {
            const int rl = ai * HALF + wr * 64 + m * 16 + fr;
#pragma unroll
            for (int bj = 0; bj < 2; ++bj) f(rl, bj * HALF + wc * 32 + 8 * fq, acc[ai][bj][m][0], acc[ai][bj][m][1]);
        }
}

template <class Epi, class Sched, bool GATHER, bool BSPLIT>
__device__ __forceinline__ void gemm_phase(LAS unsigned char* lds, const int tid, const bf16_t* A, int lda, const bf16_t* Bt, int ldb, const Sched& S, const Epi& E) {
    const int wid = __builtin_amdgcn_readfirstlane(tid >> 6), lane = tid & 63, wr = wid >> 2, wc = wid & 3, fr = lane & 15, fq = lane >> 4;
    int Rr[2], Cc[2];
    unsigned voffA[2][2], voffB[2][2], voffN[2][2];
#pragma unroll
    for (int i = 0; i < 2; ++i) {
        stage_rc(tid * 16 + i * 8192, Rr[i], Cc[i]);
        const int Rb = (Rr[i] & ~31) + perm32(Rr[i] & 31);
#pragma unroll
        for (int h = 0; h < 2; ++h) {
            voffA[h][i] = (unsigned)((h * HALF + Rr[i]) * lda + Cc[i]) * 2u;
            voffB[h][i] = (unsigned)((h * HALF + Rb) * ldb + Cc[i]) * 2u;
            voffN[h][i] = voffA[h][i];
        }
    }
    constexpr size_t kstep = (size_t)(BK * 2);
    const unsigned ldsw = (unsigned)wid * 1024u;
    const int aoff = lds_byte(wr * 64 + fr, fq * 8), boff = lds_byte(wc * 32 + fr, fq * 8);
#define GK_SA(b, h) (((b) * 2 + (h)) * HTB)
#define GK_SB(b, h) ((4 + (b) * 2 + (h)) * HTB)
#define GK_STAGE(bufoff, gbase, voff) do { _Pragma("unroll") for (int _i = 0; _i < 2; ++_i) \
        __builtin_amdgcn_global_load_lds((const unsigned*)((const char*)(gbase) + (voff)[_i]), (LAS unsigned*)(lds + (bufoff) + ldsw + _i * 8192), 16, 0, 0); } while (0)
#define GK_LDA(dst, b, h) do { _Pragma("unroll") for (int m = 0; m < 4; ++m) _Pragma("unroll") for (int k = 0; k < 2; ++k) dst[m][k] = *(const LAS bf16x8*)(lds + GK_SA(b, h) + aoff + m * 2048 + k * 1024); } while (0)
#define GK_LDB(dst, b, h) do { _Pragma("unroll") for (int n = 0; n < 2; ++n) _Pragma("unroll") for (int k = 0; k < 2; ++k) dst[n][k] = *(const LAS bf16x8*)(lds + GK_SB(b, h) + boff + n * 2048 + k * 1024); } while (0)
#define GK_MMA(ai, bj, At, Bt_) do { __builtin_amdgcn_s_setprio(1); _Pragma("unroll") for (int m = 0; m < 4; ++m) _Pragma("unroll") for (int n = 0; n < 2; ++n) _Pragma("unroll") for (int k = 0; k < 2; ++k) \
        acc[ai][bj][m][n] = __builtin_amdgcn_mfma_f32_16x16x32_bf16(Bt_[n][k], At[m][k], acc[ai][bj][m][n], 0, 0, 0); __builtin_amdgcn_s_setprio(0); } while (0)
#define GK_WAIT_V(n) asm volatile("s_waitcnt vmcnt(" #n ")" ::: "memory")
#define GK_WAIT_L(n) asm volatile("s_waitcnt lgkmcnt(" #n ")" ::: "memory")
#define GK_BAR __builtin_amdgcn_s_barrier()
#define GK_SCHED __builtin_amdgcn_sched_barrier(0)
#define GK_GATHER(u, vo) do { if constexpr (GATHER) { _Pragma("unroll") for (int _h = 0; _h < 2; ++_h) _Pragma("unroll") for (int _i = 0; _i < 2; ++_i) { \
        const int _r = _h * HALF + Rr[_i]; const int _t = (_r < (u).nvalid) ? (u).rows[_r] : 0; vo[_h][_i] = (unsigned)(_t * lda + Cc[_i]) * 2u; } } } while (0)
#define GK_BP(u, base, t) ((base) + (size_t)(t) * kstep + ((BSPLIT && (t) >= (u).bsplit) ? (u).bjump : 0l))
    Unit cur, nxt; int ui = 0;
    if (!S.next(0, cur)) return;
    f32x4 acc[2][2][4][2];
#pragma unroll
    for (int a = 0; a < 2; ++a)
#pragma unroll
        for (int b = 0; b < 2; ++b)
#pragma unroll
            for (int m = 0; m < 4; ++m)
#pragma unroll
                for (int n = 0; n < 2; ++n) acc[a][b][m][n] = (f32x4){0.f, 0.f, 0.f, 0.f};
    bf16x8 At[4][2], B0[2][2], B1[2][2];
    const char* cA = (const char*)A + cur.aoff; const char* cB = (const char*)Bt + cur.boff;
    GK_GATHER(cur, voffA);
    GK_STAGE(GK_SB(0, 0), GK_BP(cur, cB, 0), voffB[0]); GK_STAGE(GK_SB(0, 1), GK_BP(cur, cB, 0), voffB[1]); GK_STAGE(GK_SA(0, 0), cA, voffA[0]); GK_STAGE(GK_SA(0, 1), cA, voffA[1]);
    if (wr == 1) GK_BAR;
    GK_WAIT_V(2); GK_BAR;
    GK_STAGE(GK_SB(1, 0), GK_BP(cur, cB, 1), voffB[0]); GK_STAGE(GK_SA(1, 0), cA + kstep, voffA[0]); GK_STAGE(GK_SB(1, 1), GK_BP(cur, cB, 1), voffB[1]);
    GK_WAIT_V(6); GK_BAR;
    for (;;) {
        const bool has_next = S.next(ui + 1, nxt);
        if (!has_next) nxt = cur;
        const char* nA = has_next ? (const char*)A + nxt.aoff : cA; const char* nB = has_next ? (const char*)Bt + nxt.boff : cB;
        if constexpr (GATHER) { if (has_next) { GK_GATHER(nxt, voffN); } else {
#pragma unroll
            for (int h = 0; h < 2; ++h)
#pragma unroll
                for (int i = 0; i < 2; ++i) voffN[h][i] = voffA[h][i]; } }
        const int nt = cur.nt;
        for (int t = 0; t < nt; t += 2) {
            const bool last = (t == nt - 2);
            const char* a1 = cA + (size_t)(t + 1) * kstep;
            const char* a2 = last ? nA : cA + (size_t)(t + 2) * kstep; const char* a3 = a2 + kstep;
            const char* b2 = last ? GK_BP(nxt, nB, 0) : GK_BP(cur, cB, t + 2);
            const char* b3 = last ? GK_BP(nxt, nB, 1) : GK_BP(cur, cB, t + 3);
            unsigned vA2[2][2];
#pragma unroll
            for (int h = 0; h < 2; ++h)
#pragma unroll
                for (int i = 0; i < 2; ++i) vA2[h][i] = (GATHER && last) ? voffN[h][i] : voffA[h][i];
            GK_LDB(B0, 0, 0); GK_LDB(B1, 0, 1); GK_SCHED; GK_LDA(At, 0, 0); GK_STAGE(GK_SA(1, 1), a1, voffA[1]);
            GK_WAIT_V(8); GK_WAIT_L(0); GK_BAR; GK_MMA(0, 0, At, B0); GK_MMA(0, 1, At, B1); GK_BAR; GK_SCHED;
            GK_LDA(At, 0, 1); GK_STAGE(GK_SB(0, 0), b2, voffB[0]); GK_STAGE(GK_SB(0, 1), b2, voffB[1]); GK_STAGE(GK_SA(0, 0), a2, vA2[0]);
            GK_WAIT_V(8); GK_WAIT_L(0); GK_BAR; GK_MMA(1, 0, At, B0); GK_MMA(1, 1, At, B1); GK_BAR; GK_SCHED;
            GK_LDB(B0, 1, 0); GK_LDB(B1, 1, 1); GK_SCHED; GK_LDA(At, 1, 0); GK_STAGE(GK_SA(0, 1), a2, vA2[1]);
            GK_WAIT_V(8); GK_WAIT_L(0); GK_BAR; GK_MMA(0, 0, At, B0); GK_MMA(0, 1, At, B1); GK_BAR; GK_SCHED;
            GK_LDA(At, 1, 1); GK_STAGE(GK_SB(1, 0), b3, voffB[0]); GK_STAGE(GK_SB(1, 1), b3, voffB[1]); GK_STAGE(GK_SA(1, 0), a3, vA2[0]);
            GK_WAIT_V(8); GK_WAIT_L(0); GK_BAR; GK_MMA(1, 0, At, B0); GK_MMA(1, 1, At, B1); GK_BAR; GK_SCHED;
        }
        if (wr == 0) GK_BAR;
        E(acc, cur, wr, wc, fr, fq);
        if (!has_next) break;
#pragma unroll
        for (int a = 0; a < 2; ++a)
#pragma unroll
            for (int b = 0; b < 2; ++b)
#pragma unroll
                for (int m = 0; m < 4; ++m)
#pragma unroll
                    for (int n = 0; n < 2; ++n) acc[a][b][m][n] = (f32x4){0.f, 0.f, 0.f, 0.f};
        cur = nxt; cA = nA; cB = nB; ++ui;
        if constexpr (GATHER) {
#pragma unroll
            for (int h = 0; h < 2; ++h)
#pragma unroll
                for (int i = 0; i < 2; ++i) voffA[h][i] = voffN[h][i]; }
        if (wr == 1) GK_BAR;
    }
    GK_WAIT_V(0);
    GK_BAR;
#undef GK_SA
#undef GK_SB
#undef GK_STAGE
#undef GK_LDA
#undef GK_LDB
#undef GK_MMA
#undef GK_WAIT_V
#undef GK_WAIT_L
#undef GK_BAR
#undef GK_SCHED
#undef GK_GATHER
#undef GK_BP
}

struct GridOrder {
    int nM, nN, nwg, G, c, nt; long astep, bstep;
    __device__ void init(int nM_, int nN_, int K, int lda, int ldb, int G_, int c_) { nM = nM_; nN = nN_; nwg = nM * nN; G = G_; c = c_; nt = K / BK; astep = (long)BM * lda * 2; bstep = (long)BM * ldb * 2; }
    __device__ bool next(int i, Unit& u) const {
        const long L = (long)i * G + c; if (L >= nwg) return false;
        int wgid = (int)L; { const int q = nwg / 8, r = nwg % 8, xcd = wgid % 8, off = wgid / 8; wgid = (xcd < r ? xcd * (q + 1) : r * (q + 1) + (xcd - r) * q) + off; }
        const int WGM = 8, nig = WGM * nN, gid = wgid / nig, fm = gid * WGM, gsz = (nM - fm) < WGM ? (nM - fm) : WGM;
        u.pm = fm + ((wgid % nig) % gsz); u.pn = (wgid % nig) / gsz;
        u.aoff = u.pm * astep; u.boff = u.pn * bstep; u.nt = nt; u.nvalid = 256; u.rows = nullptr; u.bsplit = 1 << 30; u.bjump = 0; u.aux0 = 0; u.aux1 = 0;
        return true;
    }
};
}

struct Params { const float* in[26]; float* out; unsigned char* ws; };
enum { I_X = 0, I_N1G, I_WIN, I_LAMRE, I_LAMIM, I_LOGDT, I_BRE, I_BIM, I_CRE, I_CIM, I_SSMD, I_WGLU, I_BGLU, I_QG, I_KG, I_WPS, I_WPA, I_WOUT, I_N2G, I_WRG, I_BRG, I_WRE, I_BREX, I_WGATE, I_WUP, I_WDOWN };

using gk::Unit; using gk::epi_rows;
typedef f32x4 Acc[2][2][4][2];

struct EpiProj {
    bf16_t *UGS, *QH, *KH, *VH, *SGS, *SGA;
    __device__ __forceinline__ void operator()(const Acc& acc, const Unit& u, int wr, int wc, int fr, int fq) const {
        const int pn = u.pn, row0 = u.pm * 256;
        epi_rows(acc, wr, wc, fr, fq, [&](int rl, int cl, f32x4 v0, f32x4 v1) {
            const int row = row0 + rl, col = pn * 256 + cl, b = row >> 13, s = row & 8191;
            if (pn < 2) {
                const int g = col >> 4, ch0 = col & 15, chunk = s >> 5, t = s & 31;
                *(u32x4*)(UGS + ((size_t)(g * CROWS + b * NCH + chunk) * KU + 128 + t * 16 + ch0)) = pk8(v0, v1);
            } else if (pn < 8) {
                const int which = (pn - 2) >> 1, c = col - 512 - which * 512, h = c >> 6, d = c & 63;
                bf16_t* base = QH + (size_t)which * (16u << 20);
                *(u32x4*)(base + ((size_t)((b * NH + h) * SEQ + s) * HD + d)) = pk8(v0, v1);
            } else {
                const int which = pn >= 12, c = col - 2048 - which * 1024;
                f32x4 a, bb;
#pragma unroll
                for (int j = 0; j < 4; ++j) { a[j] = sigmoidf_(v0[j]); bb[j] = sigmoidf_(v1[j]); }
                *(u32x4*)(SGS + (size_t)which * (32u << 20) + (size_t)row * DM + c) = pk8(a, bb);
            }
        });
    }
};
struct EpiEloc {
    float* ELOC;
    __device__ __forceinline__ void operator()(const Acc& acc, const Unit& u, int wr, int wc, int fr, int fq) const {
        const int rowbase = u.aux0 * CROWS + u.pm * 256;
        epi_rows(acc, wr, wc, fr, fq, [&](int rl, int cl, f32x4 v0, f32x4 v1) {
            if (cl < 128) { float* d = ELOC + (size_t)(rowbase + rl) * 128 + cl; *(f32x4*)d = v0; *(f32x4*)(d + 4) = v1; }
        });
    }
};
struct EpiSsm {
    bf16_t* Z;
    __device__ __forceinline__ void operator()(const Acc& acc, const Unit& u, int wr, int wc, int fr, int fq) const {
        const int g = u.aux0, r0 = u.pm * 256, c0 = u.pn * 256;
        epi_rows(acc, wr, wc, fr, fq, [&](int rl, int cl, f32x4 v0, f32x4 v1) {
            const int col = c0 + cl, t = col >> 4, ch0 = col & 15; const size_t tok = (size_t)(r0 + rl) * CL + t;
            f32x4 a, bb;
#pragma unroll
            for (int j = 0; j < 4; ++j) { a[j] = gelu_tanh(v0[j]); bb[j] = gelu_tanh(v1[j]); }
            *(u32x4*)(Z + tok * SSMW + g * GC + ch0) = pk8(a, bb);
        });
    }
};
struct EpiGlu {
    const bf16_t* Z; const float* bias; bf16_t* OS;
    __device__ __forceinline__ void operator()(const Acc& acc, const Unit& u, int wr, int wc, int fr, int fq) const {
        const int r0 = u.pm * 256, c0 = u.pn * 256;
        epi_rows(acc, wr, wc, fr, fq, [&](int rl, int cl, f32x4 v0, f32x4 v1) {
            const size_t off = (size_t)(r0 + rl) * SSMW + c0 + cl;
            f32x4 z0, z1; unpk8(*(const u32x4*)(Z + off), z0, z1);
            const f32x4 b0 = *(const f32x4*)(bias + c0 + cl), b1 = *(const f32x4*)(bias + c0 + cl + 4);
            f32x4 a, bb;
#pragma unroll
            for (int j = 0; j < 4; ++j) { a[j] = z0[j] * sigmoidf_(v0[j] + b0[j]); bb[j] = z1[j] * sigmoidf_(v1[j] + b1[j]); }
            *(u32x4*)(OS + off) = pk8(a, bb);
        });
    }
};
template <bool ACCUM> struct EpiMerge {
    const bf16_t* SG; bf16_t* MG;
    __device__ __forceinline__ void operator()(const Acc& acc, const Unit& u, int wr, int wc, int fr, int fq) const {
        const int r0 = u.pm * 256, c0 = u.pn * 256;
        epi_rows(acc, wr, wc, fr, fq, [&](int rl, int cl, f32x4 v0, f32x4 v1) {
            const size_t off = (size_t)(r0 + rl) * DM + c0 + cl;
            f32x4 s0, s1; unpk8(*(const u32x4*)(SG + off), s0, s1);
            f32x4 a = s0 * v0, bb = s1 * v1;
            if (ACCUM) { f32x4 m0, m1; unpk8(*(const u32x4*)(MG + off), m0, m1); a += m0; bb += m1; }
            *(u32x4*)(MG + off) = pk8(a, bb);
        });
    }
};
struct EpiOut {
    const float* X; float* X1; bf16_t* X1B;
    __device__ __forceinline__ void operator()(const Acc& acc, const Unit& u, int wr, int wc, int fr, int fq) const {
        const int r0 = u.pm * 256, c0 = u.pn * 256;
        epi_rows(acc, wr, wc, fr, fq, [&](int rl, int cl, f32x4 v0, f32x4 v1) {
            const size_t off = (size_t)(r0 + rl) * DM + c0 + cl;
            const f32x4 a = *(const f32x4*)(X + off) + v0, bb = *(const f32x4*)(X + off + 4) + v1;
            *(f32x4*)(X1 + off) = a; *(f32x4*)(X1 + off + 4) = bb;
            *(u32x4*)(X1B + off) = pk8(a, bb);
        });
    }
};
struct EpiGU {
    const int* ELDST; const float* ELW; const float* ELR2; bf16_t* ACT; const LAS int* pairoff;
    __device__ __forceinline__ void operator()(const Acc& acc, const Unit& u, int wr, int wc, int fr, int fq) const {
        const int e = u.aux0, tile = u.pm;
#pragma unroll
        for (int ai = 0; ai < 2; ++ai)
#pragma unroll
            for (int m = 0; m < 4; ++m) {
                const int rl = ai * 128 + wr * 64 + m * 16 + fr;
                if (rl < u.nvalid) {
                    const size_t idx = (size_t)e * T + tile * 256 + rl;
                    const int dst = ELDST[idx]; const float w = ELW[idx], r2 = ELR2[idx];
                    const int p = dst >> 17, slot = (dst >> 16) & 1, rank = dst & 0xffff;
                    const size_t prow = (size_t)(pairoff[p] + rank);
                    f32x4 a[2];
#pragma unroll
                    for (int n = 0; n < 2; ++n)
#pragma unroll
                        for (int j = 0; j < 4; ++j) { const float gt = acc[ai][0][m][n][j] * r2, up = acc[ai][1][m][n][j] * r2; a[n][j] = gt * sigmoidf_(gt) * up * w; }
                    *(u32x4*)(ACT + prow * 256 + slot * 128 + wc * 32 + 8 * fq) = pk8(a[0], a[1]);
                }
            }
    }
};
struct EpiDN {
    const int* PLTOK; float* OUT;
    __device__ __forceinline__ void operator()(const Acc& acc, const Unit& u, int wr, int wc, int fr, int fq) const {
        const int p = u.aux0, tile = u.aux1, c0 = u.pn * 256, nv = u.nvalid;
        epi_rows(acc, wr, wc, fr, fq, [&](int rl, int cl, f32x4 v0, f32x4 v1) {
            if (rl < nv) {
                const int tok = PLTOK[(size_t)p * T + tile * 256 + rl];
                float* d = OUT + (size_t)tok * DM + c0 + cl;
                const f32x4 a = *(const f32x4*)d + v0, bb = *(const f32x4*)(d + 4) + v1;
                *(f32x4*)d = a; *(f32x4*)(d + 4) = bb;
            }
        });
    }
};

struct ElocOrder {
    int G, c;
    __device__ bool next(int i, Unit& u) const {
        const int L = i * G + c; if (L >= NG * 4) return false;
        const int g = L >> 2, pm = L & 3;
        u.pm = pm; u.pn = 0; u.aoff = ((long)(g * CROWS + pm * 256) * KU + 128) * 2; u.boff = (long)g * 128 * NTC * 2; u.nt = NTC / 64;
        u.nvalid = 256; u.rows = nullptr; u.bsplit = 1 << 30; u.bjump = 0; u.aux0 = g; u.aux1 = 0; return true;
    }
};
struct SsmOrder {
    int G, c;
    __device__ bool next(int i, Unit& u) const {
        const int L = i * G + c; if (L >= NG * 8) return false;
        const int g = L >> 3, pm = (L >> 1) & 3, pn = L & 1;
        u.pm = pm; u.pn = pn; u.aoff = (long)(g * CROWS + pm * 256) * KU * 2; u.boff = (long)(g * NTC + pn * 256) * KU * 2; u.nt = pn ? 10 : 6;
        u.nvalid = 256; u.rows = nullptr; u.bsplit = 1 << 30; u.bjump = 0; u.aux0 = g; u.aux1 = 0; return true;
    }
};
struct GUOrder {
    const LAS int* epre; const LAS int* ecnt; const int* ELTOK; int G, c;
    __device__ bool next(int i, Unit& u) const {
        const int L = i * G + c; if (L >= epre[NE]) return false;
        int e = 0; while (epre[e + 1] <= L) ++e;
        e = __builtin_amdgcn_readfirstlane(e);
        const int tile = L - __builtin_amdgcn_readfirstlane(epre[e]), cnt = __builtin_amdgcn_readfirstlane(ecnt[e]);
        u.pm = tile; u.pn = 0; u.aoff = 0; u.boff = (long)e * 256 * DM * 2; u.nt = DM / 64;
        u.nvalid = min(256, cnt - tile * 256); u.rows = ELTOK + (size_t)e * T + tile * 256; u.bsplit = 1 << 30; u.bjump = 0; u.aux0 = e; u.aux1 = 0; return true;
    }
};
struct DNOrder {
    const LAS int* ppre; const LAS int* pcnt; const LAS int* pairoff; int G, c;
    __device__ bool next(int i, Unit& u) const {
        const int L = i * G + c; if (L >= ppre[NPAIR]) return false;
        int p = 0; while (ppre[p + 1] <= L) ++p;
        p = __builtin_amdgcn_readfirstlane(p);
        const int loc = L - __builtin_amdgcn_readfirstlane(ppre[p]), tile = loc >> 2, pn = loc & 3, cnt = __builtin_amdgcn_readfirstlane(pcnt[p]), po = __builtin_amdgcn_readfirstlane(pairoff[p]);
        const int g = p / 28; int q = p % 28, lo = 0; while (q >= 7 - lo) { q -= 7 - lo; ++lo; } const int hi = lo + 1 + q;
        u.pm = 0; u.pn = pn; u.aoff = (long)(po + tile * 256) * 256 * 2; u.boff = ((long)pn * 256 * (NE * DE) + (g * 8 + lo) * DE) * 2; u.nt = 4;
        u.nvalid = min(256, cnt - tile * 256); u.rows = nullptr; u.bsplit = 2; u.bjump = (long)(hi - lo) * DE * 2 - 2 * 128; u.aux0 = p; u.aux1 = tile; return true;
    }
};

__device__ __forceinline__ void p0_transpose_item(const float* W, int N, const float* kscale, bf16_t* WT, int ldt, LAS float* scr, int item, int lane) {
    const int nblk = N / 32, kb = item / nblk, nb = item % nblk, k0 = 64 * kb, n0 = 32 * nb;
#pragma unroll 8
    for (int i = 0; i < 32; ++i) { const int kk = 2 * i + (lane >> 5); float v = W[(size_t)(k0 + kk) * N + n0 + (lane & 31)]; if (kscale) v *= kscale[k0 + kk]; scr[kk * 33 + (lane & 31)] = v; }
    asm volatile("s_waitcnt lgkmcnt(0)" ::: "memory");
    const int c = lane & 7;
#pragma unroll
    for (int j = 0; j < 4; ++j) { const int n = (lane >> 3) + 8 * j; const LAS float* s = scr + (8 * c) * 33 + n;
        u32x4 o; o.x = pk2(s[0 * 33], s[1 * 33]); o.y = pk2(s[2 * 33], s[3 * 33]); o.z = pk2(s[4 * 33], s[5 * 33]); o.w = pk2(s[6 * 33], s[7 * 33]);
        *(u32x4*)(WT + (size_t)(n0 + n) * ldt + k0 + 8 * c) = o; }
    asm volatile("s_waitcnt lgkmcnt(0)" ::: "memory");
}

__device__ __forceinline__ void p0_ssm_tables(const Params& P, LAS unsigned char* lds, int g, int tid) {
    unsigned char* ws = P.ws;
    LAS double* xs = (LAS double*)lds;
    LAS double* ys = xs + 64;
    LAS float* cfr = (LAS float*)(ys + 64);
    LAS float* cfi = cfr + 64;
    LAS f32x2* AP = (LAS f32x2*)(cfi + 64);
    LAS f32x2* BB = AP + 33 * 64;
    LAS f32x2* CC = BB + 64 * 16;
    if (tid < 64) {
        const int n = tid;
        const double dt = exp((double)P.in[I_LOGDT][g]);
        const float lrf = fminf(P.in[I_LAMRE][g * NS + n], -1e-4f);
        const double lr = lrf, li = P.in[I_LAMIM][g * NS + n];
        const double x = lr * dt, y = li * dt, mag = exp(x), ar = mag * cos(y), ai = mag * sin(y);
        const double den = lr * lr + li * li, nr = ar - 1.0, ni = ai;
        xs[n] = x; ys[n] = y; cfr[n] = (float)((nr * lr + ni * li) / den); cfi[n] = (float)((ni * lr - nr * li) / den);
        const double m32 = exp(32.0 * x);
        ((f32x2*)(ws + WS_A32))[g * NS + n] = (f32x2){(float)(m32 * cos(32.0 * y)), (float)(m32 * sin(32.0 * y))};
    }
    __syncthreads();
#pragma unroll 1
    for (int idx = tid; idx < 33 * 64; idx += 512) { const int tau = idx >> 6, n = idx & 63; const double m = exp(xs[n] * tau), a = ys[n] * tau; AP[idx] = (f32x2){(float)(m * cos(a)), (float)(m * sin(a))}; }
#pragma unroll 1
    for (int idx = tid; idx < 1024; idx += 512) {
        { const int n = idx >> 4; const float br = P.in[I_BRE][(size_t)g * 1024 + idx], bi = P.in[I_BIM][(size_t)g * 1024 + idx]; BB[idx] = (f32x2){cfr[n] * br - cfi[n] * bi, cfr[n] * bi + cfi[n] * br}; }
        CC[idx] = (f32x2){P.in[I_CRE][(size_t)g * 1024 + idx], P.in[I_CIM][(size_t)g * 1024 + idx]};
    }
    __syncthreads();
    float* KC = (float*)(ws + WS_KC) + (size_t)g * 32 * 256;
#pragma unroll 1
    for (int idx = tid; idx < 32 * 256; idx += 512) {
        const int tau = idx >> 8, c = (idx >> 4) & 15, cp = idx & 15; float s = 0.f;
#pragma unroll 4
        for (int n = 0; n < 64; ++n) { const f32x2 cc = CC[c * 64 + n], ap = AP[tau * 64 + n], bb = BB[n * 16 + cp];
            const float xr = cc.x * ap.x - cc.y * ap.y, xi = cc.x * ap.y + cc.y * ap.x; s += xr * bb.x - xi * bb.y; }
        if (tau == 0 && c == cp) s += P.in[I_SSMD][g * GC + c];
        KC[idx] = s;
    }
    bf16_t* MO = (bf16_t*)(ws + WS_MOUT) + (size_t)g * NTC * 128;
#pragma unroll 1
    for (int idx = tid; idx < NTC * 128; idx += 512) {
        const int row = idx >> 7, np = idx & 127, n = np & 63, t = row >> 4, c = row & 15;
        const f32x2 cc = CC[c * 64 + n], ap = AP[(t + 1) * 64 + n];
        const float zr = cc.x * ap.x - cc.y * ap.y, zi = cc.x * ap.y + cc.y * ap.x;
        MO[idx] = f2bf(np < 64 ? zr : -zi);
    }
    bf16_t* MIN = (bf16_t*)(ws + WS_MIN) + (size_t)g * 128 * NTC;
#pragma unroll 1
    for (int idx = tid; idx < 128 * NTC; idx += 512) {
        const int np = idx >> 9, k = idx & 511, n = np & 63, s = k >> 4, cp = k & 15;
        const f32x2 ap = AP[(31 - s) * 64 + n], bb = BB[n * 16 + cp];
        const float wr_ = ap.x * bb.x - ap.y * bb.y, wi_ = ap.x * bb.y + ap.y * bb.x;
        MIN[idx] = f2bf(np < 64 ? wr_ : wi_);
    }
    __syncthreads();
}

__device__ __forceinline__ void phase0(const Params& P, LAS unsigned char* lds, int G, const int tid) {
    unsigned char* ws = P.ws;
    const int lane = tid & 63, wid = __builtin_amdgcn_readfirstlane(tid >> 6), bid = blockIdx.x;
    if (bid < NG) p0_ssm_tables(P, lds, bid, tid);
    {
        LAS float* scr = (LAS float*)(lds + wid * 16384);
        const int gw = bid * 8 + wid, NGW = G * 8;
        constexpr int I_IN = 16 * 128, I_GLU = 8 * 16, I_P = 8 * 32, I_O = 16 * 32, I_E = 64 * NE;
        constexpr int NIT = I_IN + I_GLU + 2 * I_P + I_O + 3 * I_E;
        bf16_t* WGU = (bf16_t*)(ws + WS_WGU); bf16_t* WDN = (bf16_t*)(ws + WS_WDN);
        for (int it = gw; it < NIT; it += NGW) {
            int r = it;
            if (r < I_IN) { p0_transpose_item(P.in[I_WIN], NIN, nullptr, (bf16_t*)(ws + WS_WIN), DM, scr, r, lane); continue; } r -= I_IN;
            if (r < I_GLU) { p0_transpose_item(P.in[I_WGLU], SSMW, nullptr, (bf16_t*)(ws + WS_WGLU), SSMW, scr, r, lane); continue; } r -= I_GLU;
            if (r < I_P) { p0_transpose_item(P.in[I_WPS], DM, nullptr, (bf16_t*)(ws + WS_WPS), SSMW, scr, r, lane); continue; } r -= I_P;
            if (r < I_P) { p0_transpose_item(P.in[I_WPA], DM, nullptr, (bf16_t*)(ws + WS_WPA), SSMW, scr, r, lane); continue; } r -= I_P;
            if (r < I_O) { p0_transpose_item(P.in[I_WOUT], DM, nullptr, (bf16_t*)(ws + WS_WOUT), DM, scr, r, lane); continue; } r -= I_O;
            if (r < I_E) { const int e = r >> 6; p0_transpose_item(P.in[I_WGATE] + (size_t)e * DM * DE, DE, P.in[I_N2G], WGU + (size_t)e * 256 * DM, DM, scr, r & 63, lane); continue; } r -= I_E;
            if (r < I_E) { const int e = r >> 6; p0_transpose_item(P.in[I_WUP] + (size_t)e * DM * DE, DE, P.in[I_N2G], WGU + (size_t)(e * 256 + 128) * DM, DM, scr, r & 63, lane); continue; } r -= I_E;
            { const int e = r >> 6; p0_transpose_item(P.in[I_WDOWN] + (size_t)e * DE * DM, DM, nullptr, WDN + e * DE, NE * DE, scr, r & 63, lane); }
        }
    }
    {
        bf16_t* HI = (bf16_t*)(ws + WS_WRT); bf16_t* LO = HI + 48 * DM;
        for (int idx = bid * 512 + tid; idx < 48 * DM; idx += G * 512) {
            const int col = idx >> 10, k = idx & 1023;
            float v = 0.f;
            if (col < 4) v = P.in[I_WRG][k * 4 + col]; else if (col < 36) v = P.in[I_WRE][k * 32 + col - 4];
            v *= P.in[I_N2G][k];
            const bf16_t h = f2bf(v); HI[idx] = h; LO[idx] = f2bf(v - bf2f(h));
        }
    }
    {
        const int gw = bid * 8 + wid, NGW = G * 8;
        const f32x4* gp = (const f32x4*)P.in[I_N1G] + lane;
        f32x4 gv[4];
#pragma unroll
        for (int j = 0; j < 4; ++j) gv[j] = gp[64 * j];
        for (int m = gw; m < T; m += NGW) {
            const f32x4* xr = (const f32x4*)(P.in[I_X] + (size_t)m * DM) + lane;
            f32x4 v[4]; float s = 0.f;
#pragma unroll
            for (int j = 0; j < 4; ++j) { v[j] = xr[64 * j]; s += (v[j].x * v[j].x + v[j].y * v[j].y) + (v[j].z * v[j].z + v[j].w * v[j].w); }
            const float rs = 1.0f / sqrtf(wave_sum(s) * (1.f / DM) + EPS);
            u32x2* o8 = (u32x2*)((bf16_t*)(ws + WS_XN) + (size_t)m * DM) + lane;
#pragma unroll
            for (int j = 0; j < 4; ++j) { const f32x4 y = v[j] * rs * gv[j]; u32x2 w; w.x = pk2(y.x, y.y); w.y = pk2(y.z, y.w); o8[64 * j] = w; }
        }
    }
}

__device__ __forceinline__ void qkv_unit(const Params& P, LAS unsigned char* lds, int bh, int blk, int tid) {
    unsigned char* ws = P.ws;
    LAS float* kbuf = (LAS float*)lds;
    LAS float* part = kbuf + 256 * 65;
    LAS bf16_t* vbuf = (LAS bf16_t*)(part + 512);
    const size_t blkoff = ((size_t)bh * SEQ + blk * 256) * HD;
    {
        const bool isk = tid >= 256; const int r = tid & 255, pos = blk * 256 + r;
        bf16_t* rowp = (bf16_t*)(ws + (isk ? WS_KH : WS_QH)) + blkoff + (size_t)r * HD;
        const float* gn = P.in[isk ? I_KG : I_QG];
        float x[64]; float ss = 0.f;
#pragma unroll
        for (int c = 0; c < 8; ++c) { const u32x4 w = *(const u32x4*)(rowp + c * 8); f32x4 a, b; unpk8(w, a, b);
#pragma unroll
            for (int j = 0; j < 4; ++j) { x[c * 8 + j] = a[j]; x[c * 8 + 4 + j] = b[j]; ss += a[j] * a[j] + b[j] * b[j]; } }
        const float rs = 1.0f / sqrtf(ss * (1.f / HD) + EPS);
#pragma unroll
        for (int d = 0; d < 64; ++d) x[d] = x[d] * rs * gn[d];
        const float invf[8] = {1.0f, 0.1939227432012558f, 0.03760603070259094f, 0.007292664609849453f, 0.0014142135623842478f, 0.00027424818836152554f, 5.318296098266728e-05f, 1.0313386155758053e-05f};
#pragma unroll
        for (int i = 0; i < 8; ++i) { const float ang = (float)pos * invf[i]; const float cs = cosf(ang), sn = sinf(ang); const float x1 = x[i], x2 = x[i + 8]; x[i] = x1 * cs - x2 * sn; x[i + 8] = x2 * cs + x1 * sn; }
        if (isk) {
#pragma unroll
            for (int d = 0; d < 64; ++d) kbuf[r * 65 + d] = x[d];
        }
        const float osc = isk ? 1.0f : QSCALE;
#pragma unroll
        for (int c = 0; c < 8; ++c) { u32x4 w; w.x = pk2(x[c * 8] * osc, x[c * 8 + 1] * osc); w.y = pk2(x[c * 8 + 2] * osc, x[c * 8 + 3] * osc); w.z = pk2(x[c * 8 + 4] * osc, x[c * 8 + 5] * osc); w.w = pk2(x[c * 8 + 6] * osc, x[c * 8 + 7] * osc);
            *(u32x4*)(rowp + c * 8) = w; }
    }
    {
        const int r = tid >> 1, half = tid & 1;
        const bf16_t* vp = (const bf16_t*)(ws + WS_VT) + blkoff + (size_t)r * HD + half * 32;
        u32x4 w[4];
#pragma unroll
        for (int c = 0; c < 4; ++c) w[c] = *(const u32x4*)(vp + c * 8);
#pragma unroll
        for (int c = 0; c < 4; ++c) { const unsigned q[4] = {w[c].x, w[c].y, w[c].z, w[c].w};
#pragma unroll
            for (int j = 0; j < 4; ++j) { const int d = half * 32 + c * 8 + 2 * j; vbuf[d * 264 + r] = (bf16_t)(q[j] & 0xffffu); vbuf[(d + 1) * 264 + r] = (bf16_t)(q[j] >> 16); } }
    }
    __syncthreads();
    {
        const int d = tid & 63, pt = tid >> 6; float s = 0.f;
        for (int r = 0; r < 32; ++r) s += kbuf[(pt * 32 + r) * 65 + d];
        part[pt * 64 + d] = s;
    }
    {
        const int d = tid >> 3, seg = tid & 7;
        bf16_t* op = (bf16_t*)(ws + WS_VT) + blkoff + (size_t)d * 256 + seg * 32;
#pragma unroll
        for (int c = 0; c < 4; ++c) *(u32x4*)(op + c * 8) = *(const LAS u32x4*)(vbuf + d * 264 + seg * 32 + c * 8);
    }
    __syncthreads();
    if (tid < 64) { float s = 0.f;
#pragma unroll
        for (int pt = 0; pt < 8; ++pt) s += part[pt * 64 + tid];
        ((float*)(ws + WS_KMEAN))[((size_t)bh * NBLK + blk) * HD + tid] = s * (1.f / 256.f); }
    __syncthreads();
}

__device__ __forceinline__ void select_unit(const Params& P, LAS unsigned char* lds, int bh, int qb, int tid) {
    unsigned char* ws = P.ws;
    LAS float* km = (LAS float*)lds;
    LAS int* lc = (LAS int*)(km + 32 * 64);
    LAS int* lb = lc + 32;
    for (int i = tid; i < qb * 64; i += 512) km[i] = ((const float*)(ws + WS_KMEAN))[(size_t)bh * NBLK * HD + i];
    if (tid < 32) lc[tid] = 0;
    __syncthreads();
    int sj[3] = {0, 0, 0}, srank[3] = {0, 0, 0};
    const int nsel = qb < 3 ? qb : 3;
    if (tid < 256) {
        const bf16_t* qp = (const bf16_t*)(ws + WS_QH) + ((size_t)bh * SEQ + qb * 256 + tid) * HD;
        float q[64];
#pragma unroll
        for (int c = 0; c < 8; ++c) { f32x4 a, b; unpk8(*(const u32x4*)(qp + c * 8), a, b);
#pragma unroll
            for (int j = 0; j < 4; ++j) { q[c * 8 + j] = a[j]; q[c * 8 + 4 + j] = b[j]; } }
        float b0 = -INFINITY, b1 = -INFINITY, b2 = -INFINITY; int i0 = 0, i1 = 0, i2 = 0;
        for (int j = 0; j < qb; ++j) {
            float s = 0.f;
#pragma unroll
            for (int d = 0; d < 64; ++d) s += q[d] * km[j * 64 + d];
            if (s > b0) { b2 = b1; i2 = i1; b1 = b0; i1 = i0; b0 = s; i0 = j; }
            else if (s > b1) { b2 = b1; i2 = i1; b1 = s; i1 = j; }
            else if (s > b2) { b2 = s; i2 = j; }
        }
        sj[0] = i0; sj[1] = i1; sj[2] = i2;
#pragma unroll
        for (int s = 0; s < 3; ++s) if (s < nsel) srank[s] = atomicAdd((int*)&lc[sj[s]], 1);
    }
    __syncthreads();
    if (tid < qb) lb[tid] = atomicAdd((int*)(ws + WS_CTL) + CW_LCNT + bh * NBLK + tid, lc[tid]);
    __syncthreads();
    if (tid < 256) {
        unsigned short* lists = (unsigned short*)(ws + WS_LISTS);
#pragma unroll
        for (int s = 0; s < 3; ++s) if (s < nsel) lists[(size_t)(bh * NBLK + sj[s]) * SEQ + lb[sj[s]] + srank[s]] = (unsigned short)((qb * 256 + tid) | (s << 13));
    }
    __syncthreads();
}

__device__ __forceinline__ void tg_expand(const Params& P, int G, const int tid) {
    unsigned char* ws = P.ws;
    const float* KC = (const float*)(ws + WS_KC); bf16_t* TG = (bf16_t*)(ws + WS_TG);
    for (int idx = blockIdx.x * 512 + tid; idx < NG * NTC * CL; idx += G * 512) {
        const int s = idx & 31, row = (idx >> 5) & 511, g = idx >> 14, t = row >> 4, c = row & 15;
        u32x4 w0 = {0u, 0u, 0u, 0u}, w1 = {0u, 0u, 0u, 0u};
        if (s <= t) { const f32x4* kp = (const f32x4*)(KC + ((size_t)(g * 32 + (t - s)) * 16 + c) * 16); w0 = pk8(kp[0], kp[1]); w1 = pk8(kp[2], kp[3]); }
        bf16_t* d = TG + ((size_t)(g * NTC + row)) * KU + 128 + s * 16;
        *(u32x4*)d = w0; *(u32x4*)(d + 8) = w1;
        if (s < 16) *(u32x4*)(TG + ((size_t)(g * NTC + row)) * KU + s * 8) = *(const u32x4*)((const bf16_t*)(ws + WS_MOUT) + ((size_t)(g * NTC + row)) * 128 + s * 8);
    }
}

__device__ __forceinline__ void carry_scan(const Params& P, LAS unsigned char* lds, int vb, int tid) {
    unsigned char* ws = P.ws;
    LAS f32x2* tot = (LAS f32x2*)lds;
    const int pair = vb >> 1, g = pair >> 2, b = pair & 3, nl = tid & 31, n = (vb & 1) * 32 + nl, seg = tid >> 5;
    const f32x2 a = ((const f32x2*)(ws + WS_A32))[g * NS + n];
    const float* EL = (const float*)(ws + WS_ELOC) + ((size_t)(g * CROWS + b * NCH + seg * 16)) * 128;
    float er[16], ei[16];
#pragma unroll
    for (int i = 0; i < 16; ++i) { er[i] = EL[(size_t)i * 128 + n]; ei[i] = EL[(size_t)i * 128 + 64 + n]; }
    float pr[16], pi[16]; float sr = 0.f, si = 0.f;
#pragma unroll
    for (int i = 0; i < 16; ++i) { pr[i] = sr; pi[i] = si; const float tr = a.x * sr - a.y * si + er[i], ti = a.x * si + a.y * sr + ei[i]; sr = tr; si = ti; }
    tot[seg * 32 + nl] = (f32x2){sr, si};
    __syncthreads();
    f32x2 a16 = a;
#pragma unroll
    for (int k = 0; k < 4; ++k) a16 = (f32x2){a16.x * a16.x - a16.y * a16.y, 2.f * a16.x * a16.y};
    float cr = 0.f, ci = 0.f;
    for (int j = 0; j < seg; ++j) { const f32x2 tj = tot[j * 32 + nl]; const float tr = a16.x * cr - a16.y * ci + tj.x, ti = a16.x * ci + a16.y * cr + tj.y; cr = tr; ci = ti; }
    bf16_t* U = (bf16_t*)(ws + WS_UGS) + ((size_t)(g * CROWS + b * NCH + seg * 16)) * KU;
#pragma unroll
    for (int i = 0; i < 16; ++i) {
        U[(size_t)i * KU + n] = f2bf(cr + pr[i]); U[(size_t)i * KU + 64 + n] = f2bf(ci + pi[i]);
        const float tr = a.x * cr - a.y * ci, ti = a.x * ci + a.y * cr; cr = tr; ci = ti;
    }
    __syncthreads();
}

__device__ __forceinline__ int crow(int r, int hi) { return (r & 3) + 8 * (r >> 2) + 4 * hi; }
template <bool DIAG>
__device__ __forceinline__ void attn_unit(const Params& P, LAS unsigned char* lds, int bh, int j, int row0, int nrows, int tid) {
    unsigned char* ws = P.ws;
    LAS unsigned char* Ks = lds;
    LAS unsigned char* Vs = lds + 36864;
    const size_t blkoff = ((size_t)bh * SEQ + j * 256) * HD;
    {
        const u32x4* ksrc = (const u32x4*)((const bf16_t*)(ws + WS_KH) + blkoff);
        const u32x4* vsrc = (const u32x4*)((const bf16_t*)(ws + WS_VT) + blkoff);
        u32x4 kw[4], vw[4];
#pragma unroll
        for (int i = 0; i < 4; ++i) { kw[i] = ksrc[tid + 512 * i]; vw[i] = vsrc[tid + 512 * i]; }
#pragma unroll
        for (int i = 0; i < 4; ++i) { const int p = tid + 512 * i; *(LAS u32x4*)(Ks + (p >> 3) * 144 + (p & 7) * 16) = kw[i];
            LAS u32x2* dv = (LAS u32x2*)(Vs + (p >> 5) * 520 + (p & 31) * 16); dv[0] = (u32x2){vw[i].x, vw[i].y}; dv[1] = (u32x2){vw[i].z, vw[i].w}; }
    }
    __syncthreads();
    const int lane = tid & 63, wid = __builtin_amdgcn_readfirstlane(tid >> 6), r32 = lane & 31, hi = lane >> 5;
    const int rq = wid * 32 + r32; const bool valid = rq < nrows;
    int spos, slot;
    if (DIAG) { spos = j * 256 + rq; slot = 3; }
    else { const unsigned e = valid ? ((const unsigned short*)(ws + WS_LISTS))[(size_t)(bh * NBLK + j) * SEQ + row0 + rq] : 0u; spos = e & 0x1fff; slot = e >> 13; }
    bf16x8 qf[4];
    { const bf16_t* qp = (const bf16_t*)(ws + WS_QH) + ((size_t)bh * SEQ + spos) * HD + hi * 8;
#pragma unroll
      for (int d0 = 0; d0 < 4; ++d0) qf[d0] = *(const bf16x8*)(qp + d0 * 16); }
    f32x16 st[8];
#pragma unroll
    for (int kt = 0; kt < 8; ++kt) {
#pragma unroll
        for (int r = 0; r < 16; ++r) st[kt][r] = 0.f;
        if (!DIAG || kt <= wid) {
#pragma unroll
            for (int d0 = 0; d0 < 4; ++d0) { const bf16x8 kf = *(const LAS bf16x8*)(Ks + (kt * 32 + r32) * 144 + (d0 * 2 + hi) * 16); st[kt] = __builtin_amdgcn_mfma_f32_32x32x16_bf16(kf, qf[d0], st[kt], 0, 0, 0); }
        }
    }
    float m = -INFINITY;
#pragma unroll
    for (int kt = 0; kt < 8; ++kt) {
        if (!DIAG || kt <= wid) {
            if (DIAG && kt == wid) {
#pragma unroll
                for (int r = 0; r < 16; ++r) if (kt * 32 + crow(r, hi) > rq) st[kt][r] = -INFINITY;
            }
#pragma unroll
            for (int r = 0; r < 16; ++r) m = fmaxf(m, st[kt][r]);
        }
    }
    m = fmaxf(m, shx(m, 32, lane));
    float l = 0.f;
#pragma unroll
    for (int kt = 0; kt < 8; ++kt) {
        if (!DIAG || kt <= wid) {
#pragma unroll
            for (int r = 0; r < 16; ++r) { const float p = __builtin_amdgcn_exp2f(st[kt][r] - m); st[kt][r] = p; l += p; }
        }
    }
    l += shx(l, 32, lane);
    f32x16 ot[2];
#pragma unroll
    for (int r = 0; r < 16; ++r) { ot[0][r] = 0.f; ot[1][r] = 0.f; }
#pragma unroll
    for (int kt = 0; kt < 8; ++kt) {
        if (!DIAG || kt <= wid) {
#pragma unroll
            for (int s2 = 0; s2 < 2; ++s2) {
                u32x4 pw; pw.x = pk2(st[kt][8 * s2 + 0], st[kt][8 * s2 + 1]); pw.y = pk2(st[kt][8 * s2 + 2], st[kt][8 * s2 + 3]); pw.z = pk2(st[kt][8 * s2 + 4], st[kt][8 * s2 + 5]); pw.w = pk2(st[kt][8 * s2 + 6], st[kt][8 * s2 + 7]);
                const bf16x8 pf = __builtin_bit_cast(bf16x8, pw);
#pragma unroll
                for (int dt = 0; dt < 2; ++dt) {
                    const LAS unsigned char* vb = Vs + (dt * 32 + r32) * 520 + (kt * 32 + s2 * 16 + 4 * hi) * 2;
                    const u32x2 lo = *(const LAS u32x2*)vb, hh = *(const LAS u32x2*)(vb + 16);
                    const u32x4 vw = {lo.x, lo.y, hh.x, hh.y};
                    ot[dt] = __builtin_amdgcn_mfma_f32_32x32x16_bf16(__builtin_bit_cast(bf16x8, vw), pf, ot[dt], 0, 0, 0);
                }
            }
        }
    }
    if (valid) {
        const size_t prow = ((size_t)((bh >> 3) * SEQ + spos) * NH + (bh & 7)) * 4 + slot;
        const float inv = 1.0f / l;
        bf16_t* po = (bf16_t*)P.out + prow * HD + 4 * hi;
#pragma unroll
        for (int dt = 0; dt < 2; ++dt)
#pragma unroll
            for (int g4 = 0; g4 < 4; ++g4) { u32x2 w; w.x = pk2(ot[dt][4 * g4] * inv, ot[dt][4 * g4 + 1] * inv); w.y = pk2(ot[dt][4 * g4 + 2] * inv, ot[dt][4 * g4 + 3] * inv);
                *(u32x2*)(po + dt * 32 + g4 * 8) = w; }
        if (hi == 0) ((f32x2*)(ws + WS_PML))[prow] = (f32x2){m, l};
    }
    __syncthreads();
}

template <class F> __device__ __forceinline__ void block_prefix_1024(LAS int* pre, LAS int* wt, int tid, const F& val) {
    const int lane = tid & 63, wid = tid >> 6;
    const int a = val(2 * tid), b = val(2 * tid + 1), s = a + b;
    int inc = s;
#pragma unroll
    for (int o = 1; o < 64; o <<= 1) { const int v = shup(inc, o, lane); if (lane >= o) inc += v; }
    if (lane == 63) wt[wid] = inc;
    __syncthreads();
    int woff = 0;
    for (int w = 0; w < wid; ++w) woff += wt[w];
    const int ex = inc - s + woff;
    pre[2 * tid] = ex; pre[2 * tid + 1] = ex + a;
    if (tid == 511) pre[1024] = ex + s;
    __syncthreads();
}

__device__ __forceinline__ void attn_phase(const Params& P, LAS unsigned char* lds, int G, const int tid) {
    LAS int* pre = (LAS int*)(lds + MISC_OFF);
    LAS int* wt = pre + 1032;
    const int* lcnt = (const int*)(P.ws + WS_CTL) + CW_LCNT;
    block_prefix_1024(pre, wt, tid, [&](int i) { return (lcnt[i] + 255) >> 8; });
    const int total = pre[1024], nunits = total + NBH * NBLK;
    for (int u = blockIdx.x; u < nunits; u += G) {
        if (u < total) {
            int lo = 0, hi = 1023;
            while (lo < hi) { const int mid = (lo + hi + 1) >> 1; if (pre[mid] <= u) lo = mid; else hi = mid - 1; }
            const int L = __builtin_amdgcn_readfirstlane(lo), tile = u - __builtin_amdgcn_readfirstlane(pre[L]);
            const int cnt = __builtin_amdgcn_readfirstlane(lcnt[L]);
            attn_unit<false>(P, lds, L >> 5, L & 31, tile * 256, min(256, cnt - tile * 256), tid);
        } else {
            const int d = u - total;
            attn_unit<true>(P, lds, d >> 5, d & 31, 0, 256, tid);
        }
    }
}

__device__ __forceinline__ void combine_phase(const Params& P, int G, const int tid) {
    unsigned char* ws = P.ws;
    const f32x2* PML = (const f32x2*)(ws + WS_PML); const bf16_t* PO = (const bf16_t*)P.out; bf16_t* ATT = (bf16_t*)(ws + WS_ATT);
    for (int idx = blockIdx.x * 512 + tid; idx < T * NH * 4; idx += G * 512) {
        const int qd = idx & 3, th = idx >> 2, token = th >> 3, head = th & 7, qblk = (token & (SEQ - 1)) >> 8, nv = qblk < 3 ? qblk : 3;
        float mm[4], ll[4]; float M = -INFINITY;
#pragma unroll
        for (int s = 0; s < 4; ++s) { const bool v = (s < nv) || (s == 3); f32x2 ml = {-INFINITY, 0.f}; if (v) ml = PML[(size_t)th * 4 + s]; mm[s] = ml.x; ll[s] = ml.y; M = fmaxf(M, ml.x); }
        float o[16];
#pragma unroll
        for (int i = 0; i < 16; ++i) o[i] = 0.f;
        float W = 0.f;
#pragma unroll
        for (int s = 0; s < 4; ++s) {
            const bool v = (s < nv) || (s == 3);
            if (v) {
                const float w = ll[s] * __builtin_amdgcn_exp2f(mm[s] - M); W += w;
                const u32x4* pp = (const u32x4*)(PO + ((size_t)th * 4 + s) * HD + qd * 16);
                f32x4 a, b, c, d; unpk8(pp[0], a, b); unpk8(pp[1], c, d);
#pragma unroll
                for (int i = 0; i < 4; ++i) { o[i] += w * a[i]; o[4 + i] += w * b[i]; o[8 + i] += w * c[i]; o[12 + i] += w * d[i]; }
            }
        }
        const float inv = 1.0f / W;
        u32x4 w0, w1;
        w0.x = pk2(o[0] * inv, o[1] * inv); w0.y = pk2(o[2] * inv, o[3] * inv); w0.z = pk2(o[4] * inv, o[5] * inv); w0.w = pk2(o[6] * inv, o[7] * inv);
        w1.x = pk2(o[8] * inv, o[9] * inv); w1.y = pk2(o[10] * inv, o[11] * inv); w1.z = pk2(o[12] * inv, o[13] * inv); w1.w = pk2(o[14] * inv, o[15] * inv);
        u32x4* dp = (u32x4*)(ATT + (size_t)token * SSMW + head * HD + qd * 16);
        dp[0] = w0; dp[1] = w1;
    }
}

__device__ __forceinline__ void route_phase(const Params& P, LAS unsigned char* lds, int G, const int tid) {
    unsigned char* ws = P.ws;
    const int lane = tid & 63, wid = __builtin_amdgcn_readfirstlane(tid >> 6), rr = lane & 15, kq = lane >> 4;
    LAS float* lg = (LAS float*)(lds + wid * 4096);
    LAS int* he = (LAS int*)(lds + MISC_OFF);
    LAS int* hp = he + 32;
    LAS int* be = hp + 112;
    LAS int* bp = be + 32;
    int* gcnt = (int*)(ws + WS_CTL);
    const bf16_t* HI = (const bf16_t*)(ws + WS_WRT); const bf16_t* LO = HI + 48 * DM;
    for (int base = 0; base < T / 16; base += G * 8) {
        const int tile = base + blockIdx.x * 8 + wid; const bool active = tile < T / 16;
        if (tid < 144) he[tid] = 0;
        __syncthreads();
        int E0 = 0, E1 = 0, pp = 0, sl0 = 0, re0 = 0, re1 = 0, rp = 0; float w0 = 0.f, w1 = 0.f, r2 = 0.f;
        if (active) {
            const float* xrow = P.out + (size_t)(tile * 16 + rr) * DM + kq * 8;
            f32x4 acc[3]; float ssq = 0.f;
#pragma unroll
            for (int ct = 0; ct < 3; ++ct) acc[ct] = (f32x4){0.f, 0.f, 0.f, 0.f};
            for (int ks = 0; ks < 32; ++ks) {
                const f32x4 a0 = *(const f32x4*)(xrow + ks * 32), a1 = *(const f32x4*)(xrow + ks * 32 + 4);
                ssq += (a0.x * a0.x + a0.y * a0.y) + (a0.z * a0.z + a0.w * a0.w) + (a1.x * a1.x + a1.y * a1.y) + (a1.z * a1.z + a1.w * a1.w);
                const u32x4 hw = pk8(a0, a1); f32x4 h0, h1; unpk8(hw, h0, h1); const u32x4 lw = pk8(a0 - h0, a1 - h1);
                const bf16x8 ah = __builtin_bit_cast(bf16x8, hw), al = __builtin_bit_cast(bf16x8, lw);
#pragma unroll
                for (int ct = 0; ct < 3; ++ct) {
                    const bf16_t* bpw = HI + (size_t)(ct * 16 + rr) * DM + ks * 32 + kq * 8;
                    const bf16x8 bh = *(const bf16x8*)bpw, bl = *(const bf16x8*)(bpw + 48 * DM);
                    acc[ct] = __builtin_amdgcn_mfma_f32_16x16x32_bf16(ah, bh, acc[ct], 0, 0, 0);
                    acc[ct] = __builtin_amdgcn_mfma_f32_16x16x32_bf16(ah, bl, acc[ct], 0, 0, 0);
                    acc[ct] = __builtin_amdgcn_mfma_f32_16x16x32_bf16(al, bh, acc[ct], 0, 0, 0);
                }
            }
            ssq += shx(ssq, 16, lane); ssq += shx(ssq, 32, lane);
#pragma unroll
            for (int ct = 0; ct < 3; ++ct)
#pragma unroll
                for (int rg = 0; rg < 4; ++rg) lg[(kq * 4 + rg) * 49 + ct * 16 + rr] = acc[ct][rg];
            asm volatile("s_waitcnt lgkmcnt(0)" ::: "memory"); __builtin_amdgcn_wave_barrier();
            if (lane < 16) {
                r2 = 1.0f / sqrtf(ssq * (1.f / DM) + EPS);
                const LAS float* row = lg + lane * 49;
                float gl[4]; int gi = 0; float gmax = -INFINITY;
#pragma unroll
                for (int c = 0; c < 4; ++c) { gl[c] = row[c] * r2 + P.in[I_BRG][c]; if (gl[c] > gmax) { gmax = gl[c]; gi = c; } }
                float den = 0.f;
#pragma unroll
                for (int c = 0; c < 4; ++c) den += __expf(gl[c] - gmax);
                const float gp = 1.0f / den;
                float ev[8];
#pragma unroll
                for (int e = 0; e < 8; ++e) ev[e] = row[4 + gi * 8 + e] * r2 + P.in[I_BREX][gi * 8 + e];
                int i0 = 0; float v0 = -INFINITY;
#pragma unroll
                for (int e = 0; e < 8; ++e) if (ev[e] > v0) { v0 = ev[e]; i0 = e; }
                int i1 = 0; float v1 = -INFINITY;
#pragma unroll
                for (int e = 0; e < 8; ++e) if (e != i0 && ev[e] > v1) { v1 = ev[e]; i1 = e; }
                const float tt = __expf(v1 - v0);
                w0 = gp / (1.0f + tt); w1 = gp * tt / (1.0f + tt);
                const int lo = i0 < i1 ? i0 : i1, hh = i0 < i1 ? i1 : i0;
                pp = gi * 28 + (lo * (15 - lo)) / 2 + (hh - lo - 1);
                sl0 = (i0 == lo) ? 0 : 1;
                E0 = gi * 8 + i0; E1 = gi * 8 + i1;
                re0 = atomicAdd((int*)&he[E0], 1); re1 = atomicAdd((int*)&he[E1], 1); rp = atomicAdd((int*)&hp[pp], 1);
            }
        }
        __syncthreads();
        if (tid < 144) { const int h = he[tid]; be[tid] = h ? atomicAdd(gcnt + (tid < 32 ? CW_ECNT + tid : CW_PCNT + tid - 32), h) : 0; }
        __syncthreads();
        if (active && lane < 16) {
            const int token = tile * 16 + lane;
            const int rankp = bp[pp] + rp;
            const size_t i0x = (size_t)E0 * T + be[E0] + re0, i1x = (size_t)E1 * T + be[E1] + re1;
            ((int*)(ws + WS_ELTOK))[i0x] = token; ((int*)(ws + WS_ELDST))[i0x] = (pp << 17) | (sl0 << 16) | rankp; ((float*)(ws + WS_ELW))[i0x] = w0; ((float*)(ws + WS_ELR2))[i0x] = r2;
            ((int*)(ws + WS_ELTOK))[i1x] = token; ((int*)(ws + WS_ELDST))[i1x] = (pp << 17) | ((1 - sl0) << 16) | rankp; ((float*)(ws + WS_ELW))[i1x] = w1; ((float*)(ws + WS_ELR2))[i1x] = r2;
            ((int*)(ws + WS_PLTOK))[(size_t)pp * T + rankp] = token;
        }
        __syncthreads();
    }
}

struct MoeTables { LAS int *ecnt, *epre, *pcnt, *ppre, *pairoff; };
__device__ __forceinline__ MoeTables moe_tables(const Params& P, LAS unsigned char* lds, int tid) {
    MoeTables M;
    M.ecnt = (LAS int*)(lds + MISC_OFF); M.epre = M.ecnt + 32; M.pcnt = M.epre + 40; M.ppre = M.pcnt + 112; M.pairoff = M.ppre + 120;
    const int* gcnt = (const int*)(P.ws + WS_CTL);
    if (tid < 32) M.ecnt[tid] = gcnt[CW_ECNT + tid];
    if (tid >= 64 && tid < 64 + NPAIR) M.pcnt[tid - 64] = gcnt[CW_PCNT + tid - 64];
    __syncthreads();
    if (tid == 0) { int s = 0; for (int e = 0; e < NE; ++e) { M.epre[e] = s; s += (M.ecnt[e] + 255) >> 8; } M.epre[NE] = s; }
    if (tid == 64) { int s = 0, r = 0; for (int p = 0; p < NPAIR; ++p) { M.ppre[p] = s; M.pairoff[p] = r; const int tl = (M.pcnt[p] + 255) >> 8; s += tl * 4; r += tl * 256; } M.ppre[NPAIR] = s; M.pairoff[NPAIR] = r; }
    __syncthreads();
    return M;
}

#ifndef N_PHASES
#define N_PHASES 11
#endif
__global__ void __launch_bounds__(512, 2) hybrid_fwd(Params P) {
    extern __shared__ __attribute__((aligned(16))) unsigned char lds_raw[];
    LAS unsigned char* lds = (LAS unsigned char*)lds_raw;
    cg::grid_group grid = cg::this_grid();
    const int G = gridDim.x, c = blockIdx.x, wave = __builtin_amdgcn_readfirstlane(threadIdx.x >> 6);
#define FT fresh_tid(wave)
    unsigned char* ws = P.ws;
#define BF(off) ((bf16_t*)(ws + (off)))
    phase0(P, lds, G, FT);
    grid.sync();
    { gk::GridOrder S; S.init(T / 256, NIN / 256, DM, DM, DM, G, c);
      EpiProj E{BF(WS_UGS), BF(WS_QH), BF(WS_KH), BF(WS_VT), BF(WS_SGS), BF(WS_SGA)};
      gk::gemm_phase<EpiProj, gk::GridOrder, false, false>(lds, FT, BF(WS_XN), DM, BF(WS_WIN), DM, S, E); }
    grid.sync();
    for (int u = c; u < NBH * NBLK; u += G) qkv_unit(P, lds, u >> 5, u & 31, FT);
    { ElocOrder S{G, c}; EpiEloc E{(float*)(ws + WS_ELOC)};
      gk::gemm_phase<EpiEloc, ElocOrder, false, false>(lds, FT, BF(WS_UGS), KU, BF(WS_MIN), NTC, S, E); }
    grid.sync();
    for (int u = c; u < NBH * NBLK; u += G) { const int qb = u & 31; if (qb > 0) select_unit(P, lds, u >> 5, qb, FT); }
    tg_expand(P, G, FT);
    for (int vb = c; vb < 256; vb += G) carry_scan(P, lds, vb, FT);
    grid.sync();
    { SsmOrder S{G, c}; EpiSsm E{BF(WS_Z)};
      gk::gemm_phase<EpiSsm, SsmOrder, false, false>(lds, FT, BF(WS_UGS), KU, BF(WS_TG), KU, S, E); }
    attn_phase(P, lds, G, FT);
    grid.sync();
    combine_phase(P, G, FT);
    { gk::GridOrder S; S.init(T / 256, SSMW / 256, SSMW, SSMW, SSMW, G, c);
      EpiGlu E{BF(WS_Z), P.in[I_BGLU], BF(WS_OS)};
      gk::gemm_phase<EpiGlu, gk::GridOrder, false, false>(lds, FT, BF(WS_Z), SSMW, BF(WS_WGLU), SSMW, S, E); }
    grid.sync();
    { gk::GridOrder S; S.init(T / 256, DM / 256, SSMW, SSMW, SSMW, G, c);
      EpiMerge<false> Ea{BF(WS_SGS), BF(WS_MG)};
      gk::gemm_phase<EpiMerge<false>, gk::GridOrder, false, false>(lds, FT, BF(WS_OS), SSMW, BF(WS_WPS), SSMW, S, Ea);
      EpiMerge<true> Eb{BF(WS_SGA), BF(WS_MG)};
      gk::gemm_phase<EpiMerge<true>, gk::GridOrder, false, false>(lds, FT, BF(WS_ATT), SSMW, BF(WS_WPA), SSMW, S, Eb); }
    grid.sync();
    { gk::GridOrder S; S.init(T / 256, DM / 256, DM, DM, DM, G, c);
      EpiOut E{P.in[I_X], P.out, BF(WS_X1B)};
      gk::gemm_phase<EpiOut, gk::GridOrder, false, false>(lds, FT, BF(WS_MG), DM, BF(WS_WOUT), DM, S, E); }
    grid.sync();
    route_phase(P, lds, G, FT);
    grid.sync();
    MoeTables M = moe_tables(P, lds, FT);
    { GUOrder S{M.epre, M.ecnt, (const int*)(ws + WS_ELTOK), G, c};
      EpiGU E{(const int*)(ws + WS_ELDST), (const float*)(ws + WS_ELW), (const float*)(ws + WS_ELR2), BF(WS_ACT), M.pairoff};
      gk::gemm_phase<EpiGU, GUOrder, true, false>(lds, FT, BF(WS_X1B), DM, BF(WS_WGU), DM, S, E); }
    grid.sync();
    { DNOrder S{M.ppre, M.pcnt, M.pairoff, G, c};
      EpiDN E{(const int*)(ws + WS_PLTOK), P.out};
      gk::gemm_phase<EpiDN, DNOrder, false, true>(lds, FT, BF(WS_ACT), 256, BF(WS_WDN), NE * DE, S, E); }
#undef BF
#undef FT
}

extern "C" void kernel_launch(void* const* d_in, const int* in_sizes, int n_in, void* d_out, int out_size, void* d_ws, size_t ws_size, hipStream_t stream) {
    static int grid = 0;
    if (grid == 0) {
        if (n_in != 26 || in_sizes[0] != T * DM || out_size != T * DM || ws_size < WS_END) {
            fprintf(stderr, "kernel_launch: unexpected shapes (n_in %d, in0 %d, out %d, ws %zu)\n", n_in, n_in > 0 ? in_sizes[0] : -1, out_size, ws_size); grid = -1; return; }
        int dev = 0, cus = 0, per_cu = 0;
        (void)hipGetDevice(&dev);
        (void)hipDeviceGetAttribute(&cus, hipDeviceAttributeMultiprocessorCount, dev);
        (void)hipFuncSetAttribute((const void*)hybrid_fwd, hipFuncAttributeMaxDynamicSharedMemorySize, LDS_BYTES);
        (void)hipOccupancyMaxActiveBlocksPerMultiprocessor(&per_cu, (const void*)hybrid_fwd, 512, LDS_BYTES);
        if (per_cu < 1) { fprintf(stderr, "kernel_launch: occupancy query says %d blocks/CU\n", per_cu); grid = -1; return; }
        grid = cus * (per_cu > 1 ? 1 : per_cu);
        (void)hipGetLastError();
    }
    if (grid < 0) return;
    (void)hipMemsetAsync((char*)d_ws + WS_CTL, 0, 1 * MiB, stream);
    Params p{};
    for (int i = 0; i < 26; ++i) p.in[i] = (const float*)d_in[i];
    p.out = (float*)d_out; p.ws = (unsigned char*)d_ws;
    void* args[] = {&p};
    hipError_t e = hipLaunchCooperativeKernel((const void*)hybrid_fwd, dim3(grid), dim3(512), args, LDS_BYTES, stream);
    if (e != hipSuccess) fprintf(stderr, "cooperative launch failed: %s (grid %d)\n", hipGetErrorString(e), grid);
}
```

```cpp
#include <hip/hip_runtime.h>
#include <hip/hip_cooperative_groups.h>
#include <cstdio>
#include <cstdint>
namespace cg = cooperative_groups;

#define LAS __attribute__((address_space(3)))
typedef unsigned short bf16_t;
typedef short bf16x8 __attribute__((ext_vector_type(8)));
typedef float f32x2 __attribute__((ext_vector_type(2)));
typedef float f32x4 __attribute__((ext_vector_type(4)));
typedef float f32x16 __attribute__((ext_vector_type(16)));
typedef unsigned u32x2 __attribute__((ext_vector_type(2)));
typedef unsigned u32x4 __attribute__((ext_vector_type(4)));
typedef __bf16 bf16x2_t __attribute__((ext_vector_type(2)));

constexpr int NB = 4, SEQ = 8192, T = NB * SEQ, DM = 1024, NIN = 4096;
constexpr int NH = 8, HD = 64, NBH = NB * NH, NBLK = 32, BLK = 256;
constexpr int SSMW = 512, NG = 32, GC = 16, NS = 64;
constexpr int CL = 32, NCH = SEQ / CL, CROWS = NB * NCH  , KU = 128 + CL * GC  , NTC = CL * GC  ;
constexpr int NE = 32, DE = 128, NPAIR = 112;
constexpr float EPS = 1e-6f;
constexpr float QSCALE = 0.125f * 1.4426950408889634f;

constexpr size_t MiB = 1u << 20;
constexpr size_t WS_CTL = 0;
constexpr size_t WS_KMEAN = 1 * MiB;
constexpr size_t WS_A32 = WS_KMEAN + 256 * 1024;
constexpr size_t WS_WRT = WS_A32 + 64 * 1024;
constexpr size_t WS_KC = 2 * MiB;
constexpr size_t WS_MIN = 3 * MiB;
constexpr size_t WS_WIN = 8 * MiB;
constexpr size_t WS_WGLU = 16 * MiB;
constexpr size_t WS_WPS = 17 * MiB;
constexpr size_t WS_WPA = 18 * MiB;
constexpr size_t WS_WOUT = 19 * MiB;
constexpr size_t WS_WGU = 21 * MiB;
constexpr size_t WS_WDN = 37 * MiB;
constexpr size_t WS_MOUT = 46 * MiB;
constexpr size_t WS_A = 50 * MiB;
constexpr size_t WS_XN = WS_A;
constexpr size_t WS_LISTS = WS_A;
constexpr size_t WS_TG = WS_A + 16 * MiB;
constexpr size_t WS_ELOC = WS_A + 40 * MiB;
constexpr size_t WS_ATT = WS_A;
constexpr size_t WS_OS = WS_A + 32 * MiB;
constexpr size_t WS_B = 114 * MiB;
constexpr size_t WS_QH = WS_B, WS_KH = WS_B + 32 * MiB, WS_VT = WS_B + 64 * MiB;
constexpr size_t WS_MG = WS_B;
constexpr size_t WS_ACT = WS_B;
constexpr size_t WS_ELTOK = WS_B + 64 * MiB;
constexpr size_t WS_ELDST = WS_B + 68 * MiB;
constexpr size_t WS_ELW = WS_B + 72 * MiB;
constexpr size_t WS_ELR2 = WS_B + 76 * MiB;
constexpr size_t WS_PLTOK = WS_B + 80 * MiB;
constexpr size_t WS_C = 210 * MiB;
constexpr size_t WS_SGS = WS_C, WS_SGA = WS_C + 64 * MiB;
constexpr size_t WS_X1B = WS_C;
constexpr size_t WS_UGS = 338 * MiB;
constexpr size_t WS_Z = 380 * MiB;
constexpr size_t WS_PML = 412 * MiB;
constexpr size_t WS_END = 420 * MiB;
constexpr int CW_LCNT = 1024;
constexpr int CW_ECNT = 4096;
constexpr int CW_PCNT = 4224;

constexpr int RING_BYTES = 131072;
constexpr int MISC_OFF = RING_BYTES;
constexpr int LDS_BYTES = 147456;

__device__ __forceinline__ unsigned pk2(float lo, float hi) { f32x2 v = {lo, hi}; bf16x2_t b = __builtin_convertvector(v, bf16x2_t); return __builtin_bit_cast(unsigned, b); }
__device__ __forceinline__ bf16_t f2bf(float f) { return (bf16_t)(pk2(f, 0.f) & 0xffffu); }
__device__ __forceinline__ float bflo(unsigned w) { return __uint_as_float(w << 16); }
__device__ __forceinline__ float bfhi(unsigned w) { return __uint_as_float(w & 0xffff0000u); }
__device__ __forceinline__ float bf2f(bf16_t b) { return __uint_as_float(((unsigned)b) << 16); }
__device__ __forceinline__ u32x4 pk8(f32x4 a, f32x4 b) { u32x4 w; w.x = pk2(a[0], a[1]); w.y = pk2(a[2], a[3]); w.z = pk2(b[0], b[1]); w.w = pk2(b[2], b[3]); return w; }
__device__ __forceinline__ void unpk8(u32x4 w, f32x4& a, f32x4& b) { a = (f32x4){bflo(w.x), bfhi(w.x), bflo(w.y), bfhi(w.y)}; b = (f32x4){bflo(w.z), bfhi(w.z), bflo(w.w), bfhi(w.w)}; }
__device__ __forceinline__ float sigmoidf_(float x) { return 1.0f / (1.0f + __expf(-x)); }
__device__ __forceinline__ float gelu_tanh(float x) { const float u = 0.7978845608028654f * (x + 0.044715f * x * x * x); const float e = __expf(-2.0f * u); return x / (1.0f + e); }
__device__ __forceinline__ int lane_id() { int l = __builtin_amdgcn_mbcnt_hi(~0u, __builtin_amdgcn_mbcnt_lo(~0u, 0u)); asm volatile("" : "+v"(l)); return l; }
__device__ __forceinline__ float shx(float v, int mask, int lane) { return __uint_as_float(__builtin_amdgcn_ds_bpermute((lane ^ mask) << 2, __float_as_uint(v))); }
__device__ __forceinline__ int shup(int v, int o, int lane) { return __builtin_amdgcn_ds_bpermute((lane - o) << 2, v); }
__device__ __forceinline__ int fresh_tid(int wave) { int t = wave * 64 + lane_id(); asm volatile("" : "+v"(t)); return t; }
__device__ __forceinline__ float wave_sum(float v) {
    const int lane = lane_id();
#pragma unroll
    for (int o = 1; o < 64; o <<= 1) v += shx(v, o, lane);
    return v;
}

namespace gk {
constexpr int BM = 256, BK = 64, HALF = 128, HTB = HALF * BK * 2, STAGE_BYTES = 8 * HTB;
__device__ __forceinline__ int lds_byte(int r, int c) { const int st = (r >> 4) * 2 + (c >> 5), rr = r & 15, cc = c & 31, ob = rr * 64 + cc * 2; return st * 1024 + (ob ^ (((ob >> 9) & 1) << 5)); }
__device__ __forceinline__ void stage_rc(int b, int& R, int& C) { const int st = b / 1024, sb = b % 1024, swz = sb ^ (((sb >> 9) & 1) << 5); R = (st >> 1) * 16 + swz / 64; C = (st & 1) * 32 + (swz % 64) / 2; }
__device__ __forceinline__ int perm32(int rho) { const int n = rho >> 4, i = rho & 15; return 8 * (i >> 2) + 4 * n + (i & 3); }

struct Unit {
    int pm, pn;
    long aoff, boff;
    int nt;
    int nvalid;
    const int* rows;
    int bsplit; long bjump;
    int aux0, aux1;
};

template <class F> __device__ __forceinline__ void epi_rows(const f32x4 (&acc)[2][2][4][2], int wr, int wc, int fr, int fq, const F& f) {
#pragma unroll
    for (int ai = 0; ai < 2; ++ai)
#pragma unroll
        for (int m = 0; m < 4; ++m) {
            const int rl = ai * HALF + wr * 64 + m * 16 + fr;
#pragma unroll
            for (int bj = 0; bj < 2; ++bj) f(rl, bj * HALF + wc * 32 + 8 * fq, acc[ai][bj][m][0], acc[ai][bj][m][1]);
        }
}

template <class Epi, class Sched, bool GATHER, bool BSPLIT>
__device__ __forceinline__ void gemm_phase(LAS unsigned char* lds, const int tid, const bf16_t* A, int lda, const bf16_t* Bt, int ldb, const Sched& S, const Epi& E) {
    const int wid = __builtin_amdgcn_readfirstlane(tid >> 6), lane = tid & 63, wr = wid >> 2, wc = wid & 3, fr = lane & 15, fq = lane >> 4;
    int Rr[2], Cc[2];
    unsigned voffA[2][2], voffB[2][2], voffN[2][2];
#pragma unroll
    for (int i = 0; i < 2; ++i) {
        stage_rc(tid * 16 + i * 8192, Rr[i], Cc[i]);
        const int Rb = (Rr[i] & ~31) + perm32(Rr[i] & 31);
#pragma unroll
        for (int h = 0; h < 2; ++h) {
            voffA[h][i] = (unsigned)((h * HALF + Rr[i]) * lda + Cc[i]) * 2u;
            voffB[h][i] = (unsigned)((h * HALF + Rb) * ldb + Cc[i]) * 2u;
            voffN[h][i] = voffA[h][i];
        }
    }
    constexpr size_t kstep = (size_t)(BK * 2);
    const unsigned ldsw = (unsigned)wid * 1024u;
    const int aoff = lds_byte(wr * 64 + fr, fq * 8), boff = lds_byte(wc * 32 + fr, fq * 8);
#define GK_SA(b, h) (((b) * 2 + (h)) * HTB)
#define GK_SB(b, h) ((4 + (b) * 2 + (h)) * HTB)
#define GK_STAGE(bufoff, gbase, voff) do { _Pragma("unroll") for (int _i = 0; _i < 2; ++_i) \
        __builtin_amdgcn_global_load_lds((const unsigned*)((const char*)(gbase) + (voff)[_i]), (LAS unsigned*)(lds + (bufoff) + ldsw + _i * 8192), 16, 0, 0); } while (0)
#define GK_LDA(dst, b, h) do { _Pragma("unroll") for (int m = 0; m < 4; ++m) _Pragma("unroll") for (int k = 0; k < 2; ++k) dst[m][k] = *(const LAS bf16x8*)(lds + GK_SA(b, h) + aoff + m * 2048 + k * 1024); } while (0)
#define GK_LDB(dst, b, h) do { _Pragma("unroll") for (int n = 0; n < 2; ++n) _Pragma("unroll") for (int k = 0; k < 2; ++k) dst[n][k] = *(const LAS bf16x8*)(lds + GK_SB(b, h) + boff + n * 2048 + k * 1024); } while (0)
#define GK_MMA(ai, bj, At, Bt_) do { __builtin_amdgcn_s_setprio(1); _Pragma("unroll") for (int m = 0; m < 4; ++m) _Pragma("unroll") for (int n = 0; n < 2; ++n) _Pragma("unroll") for (int k = 0; k < 2; ++k) \
        acc[ai][bj][m][n] = __builtin_amdgcn_mfma_f32_16x16x32_bf16(Bt_[n][k], At[m][k], acc[ai][bj][m][n], 0, 0, 0); __builtin_amdgcn_s_setprio(0); } while (0)
#define GK_WAIT_V(n) asm volatile("s_waitcnt vmcnt(" #n ")" ::: "memory")
#define GK_WAIT_L(n) asm volatile("s_waitcnt lgkmcnt(" #n ")" ::: "memory")
#define GK_BAR __builtin_amdgcn_s_barrier()
#define GK_SCHED __builtin_amdgcn_sched_barrier(0)
#define GK_GATHER(u, vo) do { if constexpr (GATHER) { _Pragma("unroll") for (int _h = 0; _h < 2; ++_h) _Pragma("unroll") for (int _i = 0; _i < 2; ++_i) { \
        const int _r = _h * HALF + Rr[_i]; const int _t = (_r < (u).nvalid) ? (u).rows[_r] : 0; vo[_h][_i] = (unsigned)(_t * lda + Cc[_i]) * 2u; } } } while (0)
#define GK_BP(u, base, t) ((base) + (size_t)(t) * kstep + ((BSPLIT && (t) >= (u).bsplit) ? (u).bjump : 0l))
    Unit cur, nxt; int ui = 0;
    if (!S.next(0, cur)) return;
    f32x4 acc[2][2][4][2];
#pragma unroll
    for (int a = 0; a < 2; ++a)
#pragma unroll
        for (int b = 0; b < 2; ++b)
#pragma unroll
            for (int m = 0; m < 4; ++m)
#pragma unroll
                for (int n = 0; n < 2; ++n) acc[a][b][m][n] = (f32x4){0.f, 0.f, 0.f, 0.f};
    bf16x8 At[4][2], B0[2][2], B1[2][2];
    const char* cA = (const char*)A + cur.aoff; const char* cB = (const char*)Bt + cur.boff;
    GK_GATHER(cur, voffA);
    GK_STAGE(GK_SB(0, 0), GK_BP(cur, cB, 0), voffB[0]); GK_STAGE(GK_SB(0, 1), GK_BP(cur, cB, 0), voffB[1]); GK_STAGE(GK_SA(0, 0), cA, voffA[0]); GK_STAGE(GK_SA(0, 1), cA, voffA[1]);
    if (wr == 1) GK_BAR;
    GK_WAIT_V(2); GK_BAR;
    GK_STAGE(GK_SB(1, 0), GK_BP(cur, cB, 1), voffB[0]); GK_STAGE(GK_SA(1, 0), cA + kstep, voffA[0]); GK_STAGE(GK_SB(1, 1), GK_BP(cur, cB, 1), voffB[1]);
    GK_WAIT_V(6); GK_BAR;
    for (;;) {
        const bool has_next = S.next(ui + 1, nxt);
        if (!has_next) nxt = cur;
        const char* nA = has_next ? (const char*)A + nxt.aoff : cA; const char* nB = has_next ? (const char*)Bt + nxt.boff : cB;
        if constexpr (GATHER) { if (has_next) { GK_GATHER(nxt, voffN); } else {
#pragma unroll
            for (int h = 0; h < 2; ++h)
#pragma unroll
                for (int i = 0; i < 2; ++i) voffN[h][i] = voffA[h][i]; } }
        const int nt = cur.nt;
        for (int t = 0; t < nt; t += 2) {
            const bool last = (t == nt - 2);
            const char* a1 = cA + (size_t)(t + 1) * kstep;
            const char* a2 = last ? nA : cA + (size_t)(t + 2) * kstep; const char* a3 = a2 + kstep;
            const char* b2 = last ? GK_BP(nxt, nB, 0) : GK_BP(cur, cB, t + 2);
            const char* b3 = last ? GK_BP(nxt, nB, 1) : GK_BP(cur, cB, t + 3);
            unsigned vA2[2][2];
#pragma unroll
            for (int h = 0; h < 2; ++h)
#pragma unroll
                for (int i = 0; i < 2; ++i) vA2[h][i] = (GATHER && last) ? voffN[h][i] : voffA[h][i];
            GK_LDB(B0, 0, 0); GK_LDB(B1, 0, 1); GK_SCHED; GK_LDA(At, 0, 0); GK_STAGE(GK_SA(1, 1), a1, voffA[1]);
            GK_WAIT_V(8); GK_WAIT_L(0); GK_BAR; GK_MMA(0, 0, At, B0); GK_MMA(0, 1, At, B1); GK_BAR; GK_SCHED;
            GK_LDA(At, 0, 1); GK_STAGE(GK_SB(0, 0), b2, voffB[0]); GK_STAGE(GK_SB(0, 1), b2, voffB[1]); GK_STAGE(GK_SA(0, 0), a2, vA2[0]);
            GK_WAIT_V(8); GK_WAIT_L(0); GK_BAR; GK_MMA(1, 0, At, B0); GK_MMA(1, 1, At, B1); GK_BAR; GK_SCHED;
            GK_LDB(B0, 1, 0); GK_LDB(B1, 1, 1); GK_SCHED; GK_LDA(At, 1, 0); GK_STAGE(GK_SA(0, 1), a2, vA2[1]);
            GK_WAIT_V(8); GK_WAIT_L(0); GK_BAR; GK_MMA(0, 0, At, B0); GK_MMA(0, 1, At, B1); GK_BAR; GK_SCHED;
            GK_LDA(At, 1, 1); GK_STAGE(GK_SB(1, 0), b3, voffB[0]); GK_STAGE(GK_SB(1, 1), b3, voffB[1]); GK_STAGE(GK_SA(1, 0), a3, vA2[0]);
            GK_WAIT_V(8); GK_WAIT_L(0); GK_BAR; GK_MMA(1, 0, At, B0); GK_MMA(1, 1, At, B1); GK_BAR; GK_SCHED;
        }
        if (wr == 0) GK_BAR;
        E(acc, cur, wr, wc, fr, fq);
        if (!has_next) break;
#pragma unroll
        for (int a = 0; a < 2; ++a)
#pragma unroll
            for (int b = 0; b < 2; ++b)
#pragma unroll
                for (int m = 0; m < 4; ++m)
#pragma unroll
                    for (int n = 0; n < 2; ++n) acc[a][b][m][n] = (f32x4){0.f, 0.f, 0.f, 0.f};
        cur = nxt; cA = nA; cB = nB; ++ui;
        if constexpr (GATHER) {
#pragma unroll
            for (int h = 0; h < 2; ++h)
#pragma unroll
                for (int i = 0; i < 2; ++i) voffA[h][i] = voffN[h][i]; }
        if (wr == 1) GK_BAR;
    }
    GK_WAIT_V(0);
    GK_BAR;
#undef GK_SA
#undef GK_SB
#undef GK_STAGE
#undef GK_LDA
#undef GK_LDB
#undef GK_MMA
#undef GK_WAIT_V
#undef GK_WAIT_L
#undef GK_BAR
#undef GK_SCHED
#undef GK_GATHER
#undef GK_BP
}

struct GridOrder {
    int nM, nN, nwg, G, c, nt; long astep, bstep;
    __device__ void init(int nM_, int nN_, int K, int lda, int ldb, int G_, int c_) { nM = nM_; nN = nN_; nwg = nM * nN; G = G_; c = c_; nt = K / BK; astep = (long)BM * lda * 2; bstep = (long)BM * ldb * 2; }
    __device__ bool next(int i, Unit& u) const {
        const long L = (long)i * G + c; if (L >= nwg) return false;
        int wgid = (int)L; { const int q = nwg / 8, r = nwg % 8, xcd = wgid % 8, off = wgid / 8; wgid = (xcd < r ? xcd * (q + 1) : r * (q + 1) + (xcd - r) * q) + off; }
        const int WGM = 8, nig = WGM * nN, gid = wgid / nig, fm = gid * WGM, gsz = (nM - fm) < WGM ? (nM - fm) : WGM;
        u.pm = fm + ((wgid % nig) % gsz); u.pn = (wgid % nig) / gsz;
        u.aoff = u.pm * astep; u.boff = u.pn * bstep; u.nt = nt; u.nvalid = 256; u.rows = nullptr; u.bsplit = 1 << 30; u.bjump = 0; u.aux0 = 0; u.aux1 = 0;
        return true;
    }
};
}

struct Params { const float* in[26]; float* out; unsigned char* ws; };
enum { I_X = 0, I_N1G, I_WIN, I_LAMRE, I_LAMIM, I_LOGDT, I_BRE, I_BIM, I_CRE, I_CIM, I_SSMD, I_WGLU, I_BGLU, I_QG, I_KG, I_WPS, I_WPA, I_WOUT, I_N2G, I_WRG, I_BRG, I_WRE, I_BREX, I_WGATE, I_WUP, I_WDOWN };

using gk::Unit; using gk::epi_rows;
typedef f32x4 Acc[2][2][4][2];

struct EpiProj {
    bf16_t *UGS, *QH, *KH, *VH, *SGS, *SGA;
    __device__ __forceinline__ void operator()(const Acc& acc, const Unit& u, int wr, int wc, int fr, int fq) const {
        const int pn = u.pn, row0 = u.pm * 256;
        epi_rows(acc, wr, wc, fr, fq, [&](int rl, int cl, f32x4 v0, f32x4 v1) {
            const int row = row0 + rl, col = pn * 256 + cl, b = row >> 13, s = row & 8191;
            if (pn < 2) {
                const int g = col >> 4, ch0 = col & 15, chunk = s >> 5, t = s & 31;
                *(u32x4*)(UGS + ((size_t)(g * CROWS + b * NCH + chunk) * KU + 128 + t * 16 + ch0)) = pk8(v0, v1);
            } else if (pn < 8) {
                const int which = (pn - 2) >> 1, c = col - 512 - which * 512, h = c >> 6, d = c & 63;
                bf16_t* base = QH + (size_t)which * (16u << 20);
                *(u32x4*)(base + ((size_t)((b * NH + h) * SEQ + s) * HD + d)) = pk8(v0, v1);
            } else {
                const int which = pn >= 12, c = col - 2048 - which * 1024;
                f32x4 a, bb;
#pragma unroll
                for (int j = 0; j < 4; ++j) { a[j] = sigmoidf_(v0[j]); bb[j] = sigmoidf_(v1[j]); }
                *(u32x4*)(SGS + (size_t)which * (32u << 20) + (size_t)row * DM + c) = pk8(a, bb);
            }
        });
    }
};
struct EpiEloc {
    float* ELOC;
    __device__ __forceinline__ void operator()(const Acc& acc, const Unit& u, int wr, int wc, int fr, int fq) const {
        const int rowbase = u.aux0 * CROWS + u.pm * 256;
        epi_rows(acc, wr, wc, fr, fq, [&](int rl, int cl, f32x4 v0, f32x4 v1) {
            if (cl < 128) { float* d = ELOC + (size_t)(rowbase + rl) * 128 + cl; *(f32x4*)d = v0; *(f32x4*)(d + 4) = v1; }
        });
    }
};
struct EpiSsm {
    bf16_t* Z;
    __device__ __forceinline__ void operator()(const Acc& acc, const Unit& u, int wr, int wc, int fr, int fq) const {
        const int g = u.aux0, r0 = u.pm * 256, c0 = u.pn * 256;
        epi_rows(acc, wr, wc, fr, fq, [&](int rl, int cl, f32x4 v0, f32x4 v1) {
            const int col = c0 + cl, t = col >> 4, ch0 = col & 15; const size_t tok = (size_t)(r0 + rl) * CL + t;
            f32x4 a, bb;
#pragma unroll
            for (int j = 0; j < 4; ++j) { a[j] = gelu_tanh(v0[j]); bb[j] = gelu_tanh(v1[j]); }
            *(u32x4*)(Z + tok * SSMW + g * GC + ch0) = pk8(a, bb);
        });
    }
};
struct EpiGlu {
    const bf16_t* Z; const float* bias; bf16_t* OS;
    __device__ __forceinline__ void operator()(const Acc& acc, const Unit& u, int wr, int wc, int fr, int fq) const {
        const int r0 = u.pm * 256, c0 = u.pn * 256;
        epi_rows(acc, wr, wc, fr, fq, [&](int rl, int cl, f32x4 v0, f32x4 v1) {
            const size_t off = (size_t)(r0 + rl) * SSMW + c0 + cl;
            f32x4 z0, z1; unpk8(*(const u32x4*)(Z + off), z0, z1);
            const f32x4 b0 = *(const f32x4*)(bias + c0 + cl), b1 = *(const f32x4*)(bias + c0 + cl + 4);
            f32x4 a, bb;
#pragma unroll
            for (int j = 0; j < 4; ++j) { a[j] = z0[j] * sigmoidf_(v0[j] + b0[j]); bb[j] = z1[j] * sigmoidf_(v1[j] + b1[j]); }
            *(u32x4*)(OS + off) = pk8(a, bb);
        });
    }
};
template <bool ACCUM> struct EpiMerge {
    const bf16_t* SG; bf16_t* MG;
    __device__ __forceinline__ void operator()(const Acc& acc, const Unit& u, int wr, int wc, int fr, int fq) const {
        const int r0 = u.pm * 256, c0 = u.pn * 256;
        epi_rows(acc, wr, wc, fr, fq, [&](int rl, int cl, f32x4 v0, f32x4 v1) {
            const size_t off = (size_t)(r0 + rl) * DM + c0 + cl;
            f32x4 s0, s1; unpk8(*(const u32x4*)(SG + off), s0, s1);
            f32x4 a = s0 * v0, bb = s1 * v1;
            if (ACCUM) { f32x4 m0, m1; unpk8(*(const u32x4*)(MG + off), m0, m1); a += m0; bb += m1; }
            *(u32x4*)(MG + off) = pk8(a, bb);
        });
    }
};
struct EpiOut {
    const float* X; float* X1; bf16_t* X1B;
    __device__ __forceinline__ void operator()(const Acc& acc, const Unit& u, int wr, int wc, int fr, int fq) const {
        const int r0 = u.pm * 256, c0 = u.pn * 256;
        epi_rows(acc, wr, wc, fr, fq, [&](int rl, int cl, f32x4 v0, f32x4 v1) {
            const size_t off = (size_t)(r0 + rl) * DM + c0 + cl;
            const f32x4 a = *(const f32x4*)(X + off) + v0, bb = *(const f32x4*)(X + off + 4) + v1;
            *(f32x4*)(X1 + off) = a; *(f32x4*)(X1 + off + 4) = bb;
            *(u32x4*)(X1B + off) = pk8(a, bb);
        });
    }
};
struct EpiGU {
    const int* ELDST; const float* ELW; const float* ELR2; bf16_t* ACT; const LAS int* pairoff;
    __device__ __forceinline__ void operator()(const Acc& acc, const Unit& u, int wr, int wc, int fr, int fq) const {
        const int e = u.aux0, tile = u.pm;
#pragma unroll
        for (int ai = 0; ai < 2; ++ai)
#pragma unroll
            for (int m = 0; m < 4; ++m) {
                const int rl = ai * 128 + wr * 64 + m * 16 + fr;
                if (rl < u.nvalid) {
                    const size_t idx = (size_t)e * T + tile * 256 + rl;
                    const int dst = ELDST[idx]; const float w = ELW[idx], r2 = ELR2[idx];
                    const int p = dst >> 17, slot = (dst >> 16) & 1, rank = dst & 0xffff;
                    const size_t prow = (size_t)(pairoff[p] + rank);
                    f32x4 a[2];
#pragma unroll
                    for (int n = 0; n < 2; ++n)
#pragma unroll
                        for (int j = 0; j < 4; ++j) { const float gt = acc[ai][0][m][n][j] * r2, up = acc[ai][1][m][n][j] * r2; a[n][j] = gt * sigmoidf_(gt) * up * w; }
                    *(u32x4*)(ACT + prow * 256 + slot * 128 + wc * 32 + 8 * fq) = pk8(a[0], a[1]);
                }
            }
    }
};
struct EpiDN {
    const int* PLTOK; float* OUT;
    __device__ __forceinline__ void operator()(const Acc& acc, const Unit& u, int wr, int wc, int fr, int fq) const {
        const int p = u.aux0, tile = u.aux1, c0 = u.pn * 256, nv = u.nvalid;
        epi_rows(acc, wr, wc, fr, fq, [&](int rl, int cl, f32x4 v0, f32x4 v1) {
            if (rl < nv) {
                const int tok = PLTOK[(size_t)p * T + tile * 256 + rl];
                float* d = OUT + (size_t)tok * DM + c0 + cl;
                const f32x4 a = *(const f32x4*)d + v0, bb = *(const f32x4*)(d + 4) + v1;
                *(f32x4*)d = a; *(f32x4*)(d + 4) = bb;
            }
        });
    }
};

struct ElocOrder {
    int G, c;
    __device__ bool next(int i, Unit& u) const {
        const int L = i * G + c; if (L >= NG * 4) return false;
        const int g = L >> 2, pm = L & 3;
        u.pm = pm; u.pn = 0; u.aoff = ((long)(g * CROWS + pm * 256) * KU + 128) * 2; u.boff = (long)g * 128 * NTC * 2; u.nt = NTC / 64;
        u.nvalid = 256; u.rows = nullptr; u.bsplit = 1 << 30; u.bjump = 0; u.aux0 = g; u.aux1 = 0; return true;
    }
};
struct SsmOrder {
    int G, c;
    __device__ bool next(int i, Unit& u) const {
        const int L = i * G + c; if (L >= NG * 8) return false;
        const int g = L >> 3, pm = (L >> 1) & 3, pn = L & 1;
        u.pm = pm; u.pn = pn; u.aoff = (long)(g * CROWS + pm * 256) * KU * 2; u.boff = (long)(g * NTC + pn * 256) * KU * 2; u.nt = pn ? 10 : 6;
        u.nvalid = 256; u.rows = nullptr; u.bsplit = 1 << 30; u.bjump = 0; u.aux0 = g; u.aux1 = 0; return true;
    }
};
struct GUOrder {
    const LAS int* epre; const LAS int* ecnt; const int* ELTOK; int G, c;
    __device__ bool next(int i, Unit& u) const {
        const int L = i * G + c; if (L >= epre[NE]) return false;
        int e = 0; while (epre[e + 1] <= L) ++e;
        e = __builtin_amdgcn_readfirstlane(e);
        const int tile = L - __builtin_amdgcn_readfirstlane(epre[e]), cnt = __builtin_amdgcn_readfirstlane(ecnt[e]);
        u.pm = tile; u.pn = 0; u.aoff = 0; u.boff = (long)e * 256 * DM * 2; u.nt = DM / 64;
        u.nvalid = min(256, cnt - tile * 256); u.rows = ELTOK + (size_t)e * T + tile * 256; u.bsplit = 1 << 30; u.bjump = 0; u.aux0 = e; u.aux1 = 0; return true;
    }
};
struct DNOrder {
    const LAS int* ppre; const LAS int* pcnt; const LAS int* pairoff; int G, c;
    __device__ bool next(int i, Unit& u) const {
        const int L = i * G + c; if (L >= ppre[NPAIR]) return false;
        int p = 0; while (ppre[p + 1] <= L) ++p;
        p = __builtin_amdgcn_readfirstlane(p);
        const int loc = L - __builtin_amdgcn_readfirstlane(ppre[p]), tile = loc >> 2, pn = loc & 3, cnt = __builtin_amdgcn_readfirstlane(pcnt[p]), po = __builtin_amdgcn_readfirstlane(pairoff[p]);
        const int g = p / 28; int q = p % 28, lo = 0; while (q >= 7 - lo) { q -= 7 - lo; ++lo; } const int hi = lo + 1 + q;
        u.pm = 0; u.pn = pn; u.aoff = (long)(po + tile * 256) * 256 * 2; u.boff = ((long)pn * 256 * (NE * DE) + (g * 8 + lo) * DE) * 2; u.nt = 4;
        u.nvalid = min(256, cnt - tile * 256); u.rows = nullptr; u.bsplit = 2; u.bjump = (long)(hi - lo) * DE * 2 - 2 * 128; u.aux0 = p; u.aux1 = tile; return true;
    }
};

__device__ __forceinline__ void p0_transpose_item(const float* W, int N, const float* kscale, bf16_t* WT, int ldt, LAS float* scr, int item, int lane) {
    const int nblk = N / 32, kb = item / nblk, nb = item % nblk, k0 = 64 * kb, n0 = 32 * nb;
#pragma unroll 8
    for (int i = 0; i < 32; ++i) { const int kk = 2 * i + (lane >> 5); float v = W[(size_t)(k0 + kk) * N + n0 + (lane & 31)]; if (kscale) v *= kscale[k0 + kk]; scr[kk * 33 + (lane & 31)] = v; }
    asm volatile("s_waitcnt lgkmcnt(0)" ::: "memory");
    const int c = lane & 7;
#pragma unroll
    for (int j = 0; j < 4; ++j) { const int n = (lane >> 3) + 8 * j; const LAS float* s = scr + (8 * c) * 33 + n;
        u32x4 o; o.x = pk2(s[0 * 33], s[1 * 33]); o.y = pk2(s[2 * 33], s[3 * 33]); o.z = pk2(s[4 * 33], s[5 * 33]); o.w = pk2(s[6 * 33], s[7 * 33]);
        *(u32x4*)(WT + (size_t)(n0 + n) * ldt + k0 + 8 * c) = o; }
    asm volatile("s_waitcnt lgkmcnt(0)" ::: "memory");
}

__device__ __forceinline__ void p0_ssm_tables(const Params& P, LAS unsigned char* lds, int g, int tid) {
    unsigned char* ws = P.ws;
    LAS double* xs = (LAS double*)lds;
    LAS double* ys = xs + 64;
    LAS float* cfr = (LAS float*)(ys + 64);
    LAS float* cfi = cfr + 64;
    LAS f32x2* AP = (LAS f32x2*)(cfi + 64);
    LAS f32x2* BB = AP + 33 * 64;
    LAS f32x2* CC = BB + 64 * 16;
    if (tid < 64) {
        const int n = tid;
        const double dt = exp((double)P.in[I_LOGDT][g]);
        const float lrf = fminf(P.in[I_LAMRE][g * NS + n], -1e-4f);
        const double lr = lrf, li = P.in[I_LAMIM][g * NS + n];
        const double x = lr * dt, y = li * dt, mag = exp(x), ar = mag * cos(y), ai = mag * sin(y);
        const double den = lr * lr + li * li, nr = ar - 1.0, ni = ai;
        xs[n] = x; ys[n] = y; cfr[n] = (float)((nr * lr + ni * li) / den); cfi[n] = (float)((ni * lr - nr * li) / den);
        const double m32 = exp(32.0 * x);
        ((f32x2*)(ws + WS_A32))[g * NS + n] = (f32x2){(float)(m32 * cos(32.0 * y)), (float)(m32 * sin(32.0 * y))};
    }
    __syncthreads();
#pragma unroll 1
    for (int idx = tid; idx < 33 * 64; idx += 512) { const int tau = idx >> 6, n = idx & 63; const double m = exp(xs[n] * tau), a = ys[n] * tau; AP[idx] = (f32x2){(float)(m * cos(a)), (float)(m * sin(a))}; }
#pragma unroll 1
    for (int idx = tid; idx < 1024; idx += 512) {
        { const int n = idx >> 4; const float br = P.in[I_BRE][(size_t)g * 1024 + idx], bi = P.in[I_BIM][(size_t)g * 1024 + idx]; BB[idx] = (f32x2){cfr[n] * br - cfi[n] * bi, cfr[n] * bi + cfi[n] * br}; }
        CC[idx] = (f32x2){P.in[I_CRE][(size_t)g * 1024 + idx], P.in[I_CIM][(size_t)g * 1024 + idx]};
    }
    __syncthreads();
    float* KC = (float*)(ws + WS_KC) + (size_t)g * 32 * 256;
#pragma unroll 1
    for (int idx = tid; idx < 32 * 256; idx += 512) {
        const int tau = idx >> 8, c = (idx >> 4) & 15, cp = idx & 15; float s = 0.f;
#pragma unroll 4
        for (int n = 0; n < 64; ++n) { const f32x2 cc = CC[c * 64 + n], ap = AP[tau * 64 + n], bb = BB[n * 16 + cp];
            const float xr = cc.x * ap.x - cc.y * ap.y, xi = cc.x * ap.y + cc.y * ap.x; s += xr * bb.x - xi * bb.y; }
        if (tau == 0 && c == cp) s += P.in[I_SSMD][g * GC + c];
        KC[idx] = s;
    }
    bf16_t* MO = (bf16_t*)(ws + WS_MOUT) + (size_t)g * NTC * 128;
#pragma unroll 1
    for (int idx = tid; idx < NTC * 128; idx += 512) {
        const int row = idx >> 7, np = idx & 127, n = np & 63, t = row >> 4, c = row & 15;
        const f32x2 cc = CC[c * 64 + n], ap = AP[(t + 1) * 64 + n];
        const float zr = cc.x * ap.x - cc.y * ap.y, zi = cc.x * ap.y + cc.y * ap.x;
        MO[idx] = f2bf(np < 64 ? zr : -zi);
    }
    bf16_t* MIN = (bf16_t*)(ws + WS_MIN) + (size_t)g * 128 * NTC;
#pragma unroll 1
    for (int idx = tid; idx < 128 * NTC; idx += 512) {
        const int np = idx >> 9, k = idx & 511, n = np & 63, s = k >> 4, cp = k & 15;
        const f32x2 ap = AP[(31 - s) * 64 + n], bb = BB[n * 16 + cp];
        const float wr_ = ap.x * bb.x - ap.y * bb.y, wi_ = ap.x * bb.y + ap.y * bb.x;
        MIN[idx] = f2bf(np < 64 ? wr_ : wi_);
    }
    __syncthreads();
}

__device__ __forceinline__ void phase0(const Params& P, LAS unsigned char* lds, int G, const int tid) {
    unsigned char* ws = P.ws;
    const int lane = tid & 63, wid = __builtin_amdgcn_readfirstlane(tid >> 6), bid = blockIdx.x;
    if (bid < NG) p0_ssm_tables(P, lds, bid, tid);
    {
        LAS float* scr = (LAS float*)(lds + wid * 16384);
        const int gw = bid * 8 + wid, NGW = G * 8;
        constexpr int I_IN = 16 * 128, I_GLU = 8 * 16, I_P = 8 * 32, I_O = 16 * 32, I_E = 64 * NE;
        constexpr int NIT = I_IN + I_GLU + 2 * I_P + I_O + 3 * I_E;
        bf16_t* WGU = (bf16_t*)(ws + WS_WGU); bf16_t* WDN = (bf16_t*)(ws + WS_WDN);
        for (int it = gw; it < NIT; it += NGW) {
            int r = it;
            if (r < I_IN) { p0_transpose_item(P.in[I_WIN], NIN, nullptr, (bf16_t*)(ws + WS_WIN), DM, scr, r, lane); continue; } r -= I_IN;
            if (r < I_GLU) { p0_transpose_item(P.in[I_WGLU], SSMW, nullptr, (bf16_t*)(ws + WS_WGLU), SSMW, scr, r, lane); continue; } r -= I_GLU;
            if (r < I_P) { p0_transpose_item(P.in[I_WPS], DM, nullptr, (bf16_t*)(ws + WS_WPS), SSMW, scr, r, lane); continue; } r -= I_P;
            if (r < I_P) { p0_transpose_item(P.in[I_WPA], DM, nullptr, (bf16_t*)(ws + WS_WPA), SSMW, scr, r, lane); continue; } r -= I_P;
            if (r < I_O) { p0_transpose_item(P.in[I_WOUT], DM, nullptr, (bf16_t*)(ws + WS_WOUT), DM, scr, r, lane); continue; } r -= I_O;
            if (r < I_E) { const int e = r >> 6; p0_transpose_item(P.in[I_WGATE] + (size_t)e * DM * DE, DE, P.in[I_N2G], WGU + (size_t)e * 256 * DM, DM, scr, r & 63, lane); continue; } r -= I_E;
            if (r < I_E) { const int e = r >> 6; p0_transpose_item(P.in[I_WUP] + (size_t)e * DM * DE, DE, P.in[I_N2G], WGU + (size_t)(e * 256 + 128) * DM, DM, scr, r & 63, lane); continue; } r -= I_E;
            { const int e = r >> 6; p0_transpose_item(P.in[I_WDOWN] + (size_t)e * DE * DM, DM, nullptr, WDN + e * DE, NE * DE, scr, r & 63, lane); }
        }
    }
    {
        bf16_t* HI = (bf16_t*)(ws + WS_WRT); bf16_t* LO = HI + 48 * DM;
        for (int idx = bid * 512 + tid; idx < 48 * DM; idx += G * 512) {
            const int col = idx >> 10, k = idx & 1023;
            float v = 0.f;
            if (col < 4) v = P.in[I_WRG][k * 4 + col]; else if (col < 36) v = P.in[I_WRE][k * 32 + col - 4];
            v *= P.in[I_N2G][k];
            const bf16_t h = f2bf(v); HI[idx] = h; LO[idx] = f2bf(v - bf2f(h));
        }
    }
    {
        const int gw = bid * 8 + wid, NGW = G * 8;
        const f32x4* gp = (const f32x4*)P.in[I_N1G] + lane;
        f32x4 gv[4];
#pragma unroll
        for (int j = 0; j < 4; ++j) gv[j] = gp[64 * j];
        for (int m = gw; m < T; m += NGW) {
            const f32x4* xr = (const f32x4*)(P.in[I_X] + (size_t)m * DM) + lane;
            f32x4 v[4]; float s = 0.f;
#pragma unroll
            for (int j = 0; j < 4; ++j) { v[j] = xr[64 * j]; s += (v[j].x * v[j].x + v[j].y * v[j].y) + (v[j].z * v[j].z + v[j].w * v[j].w); }
            const float rs = 1.0f / sqrtf(wave_sum(s) * (1.f / DM) + EPS);
            u32x2* o8 = (u32x2*)((bf16_t*)(ws + WS_XN) + (size_t)m * DM) + lane;
#pragma unroll
            for (int j = 0; j < 4; ++j) { const f32x4 y = v[j] * rs * gv[j]; u32x2 w; w.x = pk2(y.x, y.y); w.y = pk2(y.z, y.w); o8[64 * j] = w; }
        }
    }
}

__device__ __forceinline__ void qkv_unit(const Params& P, LAS unsigned char* lds, int bh, int blk, int tid) {
    unsigned char* ws = P.ws;
    LAS float* kbuf = (LAS float*)lds;
    LAS float* part = kbuf + 256 * 65;
    LAS bf16_t* vbuf = (LAS bf16_t*)(part + 512);
    const size_t blkoff = ((size_t)bh * SEQ + blk * 256) * HD;
    {
        const bool isk = tid >= 256; const int r = tid & 255, pos = blk * 256 + r;
        bf16_t* rowp = (bf16_t*)(ws + (isk ? WS_KH : WS_QH)) + blkoff + (size_t)r * HD;
        const float* gn = P.in[isk ? I_KG : I_QG];
        float x[64]; float ss = 0.f;
#pragma unroll
        for (int c = 0; c < 8; ++c) { const u32x4 w = *(const u32x4*)(rowp + c * 8); f32x4 a, b; unpk8(w, a, b);
#pragma unroll
            for (int j = 0; j < 4; ++j) { x[c * 8 + j] = a[j]; x[c * 8 + 4 + j] = b[j]; ss += a[j] * a[j] + b[j] * b[j]; } }
        const float rs = 1.0f / sqrtf(ss * (1.f / HD) + EPS);
#pragma unroll
        for (int d = 0; d < 64; ++d) x[d] = x[d] * rs * gn[d];
        const float invf[8] = {1.0f, 0.1939227432012558f, 0.03760603070259094f, 0.007292664609849453f, 0.0014142135623842478f, 0.00027424818836152554f, 5.318296098266728e-05f, 1.0313386155758053e-05f};
#pragma unroll
        for (int i = 0; i < 8; ++i) { const float ang = (float)pos * invf[i]; const float cs = cosf(ang), sn = sinf(ang); const float x1 = x[i], x2 = x[i + 8]; x[i] = x1 * cs - x2 * sn; x[i + 8] = x2 * cs + x1 * sn; }
        if (isk) {
#pragma unroll
            for (int d = 0; d < 64; ++d) kbuf[r * 65 + d] = x[d];
        }
        const float osc = isk ? 1.0f : QSCALE;
#pragma unroll
        for (int c = 0; c < 8; ++c) { u32x4 w; w.x = pk2(x[c * 8] * osc, x[c * 8 + 1] * osc); w.y = pk2(x[c * 8 + 2] * osc, x[c * 8 + 3] * osc); w.z = pk2(x[c * 8 + 4] * osc, x[c * 8 + 5] * osc); w.w = pk2(x[c * 8 + 6] * osc, x[c * 8 + 7] * osc);
            *(u32x4*)(rowp + c * 8) = w; }
    }
    {
        const int r = tid >> 1, half = tid & 1;
        const bf16_t* vp = (const bf16_t*)(ws + WS_VT) + blkoff + (size_t)r * HD + half * 32;
        u32x4 w[4];
#pragma unroll
        for (int c = 0; c < 4; ++c) w[c] = *(const u32x4*)(vp + c * 8);
#pragma unroll
        for (int c = 0; c < 4; ++c) { const unsigned q[4] = {w[c].x, w[c].y, w[c].z, w[c].w};
#pragma unroll
            for (int j = 0; j < 4; ++j) { const int d = half * 32 + c * 8 + 2 * j; vbuf[d * 264 + r] = (bf16_t)(q[j] & 0xffffu); vbuf[(d + 1) * 264 + r] = (bf16_t)(q[j] >> 16); } }
    }
    __syncthreads();
    {
        const int d = tid & 63, pt = tid >> 6; float s = 0.f;
        for (int r = 0; r < 32; ++r) s += kbuf[(pt * 32 + r) * 65 + d];
        part[pt * 64 + d] = s;
    }
    {
        const int d = tid >> 3, seg = tid & 7;
        bf16_t* op = (bf16_t*)(ws + WS_VT) + blkoff + (size_t)d * 256 + seg * 32;
#pragma unroll
        for (int c = 0; c < 4; ++c) *(u32x4*)(op + c * 8) = *(const LAS u32x4*)(vbuf + d * 264 + seg * 32 + c * 8);
    }
    __syncthreads();
    if (tid < 64) { float s = 0.f;
#pragma unroll
        for (int pt = 0; pt < 8; ++pt) s += part[pt * 64 + tid];
        ((float*)(ws + WS_KMEAN))[((size_t)bh * NBLK + blk) * HD + tid] = s * (1.f / 256.f); }
    __syncthreads();
}

__device__ __forceinline__ void select_unit(const Params& P, LAS unsigned char* lds, int bh, int qb, int tid) {
    unsigned char* ws = P.ws;
    LAS float* km = (LAS float*)lds;
    LAS int* lc = (LAS int*)(km + 32 * 64);
    LAS int* lb = lc + 32;
    for (int i = tid; i < qb * 64; i += 512) km[i] = ((const float*)(ws + WS_KMEAN))[(size_t)bh * NBLK * HD + i];
    if (tid < 32) lc[tid] = 0;
    __syncthreads();
    int sj[3] = {0, 0, 0}, srank[3] = {0, 0, 0};
    const int nsel = qb < 3 ? qb : 3;
    if (tid < 256) {
        const bf16_t* qp = (const bf16_t*)(ws + WS_QH) + ((size_t)bh * SEQ + qb * 256 + tid) * HD;
        float q[64];
#pragma unroll
        for (int c = 0; c < 8; ++c) { f32x4 a, b; unpk8(*(const u32x4*)(qp + c * 8), a, b);
#pragma unroll
            for (int j = 0; j < 4; ++j) { q[c * 8 + j] = a[j]; q[c * 8 + 4 + j] = b[j]; } }
        float b0 = -INFINITY, b1 = -INFINITY, b2 = -INFINITY; int i0 = 0, i1 = 0, i2 = 0;
        for (int j = 0; j < qb; ++j) {
            float s = 0.f;
#pragma unroll
            for (int d = 0; d < 64; ++d) s += q[d] * km[j * 64 + d];
            if (s > b0) { b2 = b1; i2 = i1; b1 = b0; i1 = i0; b0 = s; i0 = j; }
            else if (s > b1) { b2 = b1; i2 = i1; b1 = s; i1 = j; }
            else if (s > b2) { b2 = s; i2 = j; }
        }
        sj[0] = i0; sj[1] = i1; sj[2] = i2;
#pragma unroll
        for (int s = 0; s < 3; ++s) if (s < nsel) srank[s] = atomicAdd((int*)&lc[sj[s]], 1);
    }
    __syncthreads();
    if (tid < qb) lb[tid] = atomicAdd((int*)(ws + WS_CTL) + CW_LCNT + bh * NBLK + tid, lc[tid]);
    __syncthreads();
    if (tid < 256) {
        unsigned short* lists = (unsigned short*)(ws + WS_LISTS);
#pragma unroll
        for (int s = 0; s < 3; ++s) if (s < nsel) lists[(size_t)(bh * NBLK + sj[s]) * SEQ + lb[sj[s]] + srank[s]] = (unsigned short)((qb * 256 + tid) | (s << 13));
    }
    __syncthreads();
}

__device__ __forceinline__ void tg_expand(const Params& P, int G, const int tid) {
    unsigned char* ws = P.ws;
    const float* KC = (const float*)(ws + WS_KC); bf16_t* TG = (bf16_t*)(ws + WS_TG);
    for (int idx = blockIdx.x * 512 + tid; idx < NG * NTC * CL; idx += G * 512) {
        const int s = idx & 31, row = (idx >> 5) & 511, g = idx >> 14, t = row >> 4, c = row & 15;
        u32x4 w0 = {0u, 0u, 0u, 0u}, w1 = {0u, 0u, 0u, 0u};
        if (s <= t) { const f32x4* kp = (const f32x4*)(KC + ((size_t)(g * 32 + (t - s)) * 16 + c) * 16); w0 = pk8(kp[0], kp[1]); w1 = pk8(kp[2], kp[3]); }
        bf16_t* d = TG + ((size_t)(g * NTC + row)) * KU + 128 + s * 16;
        *(u32x4*)d = w0; *(u32x4*)(d + 8) = w1;
        if (s < 16) *(u32x4*)(TG + ((size_t)(g * NTC + row)) * KU + s * 8) = *(const u32x4*)((const bf16_t*)(ws + WS_MOUT) + ((size_t)(g * NTC + row)) * 128 + s * 8);
    }
}

__device__ __forceinline__ void carry_scan(const Params& P, LAS unsigned char* lds, int vb, int tid) {
    unsigned char* ws = P.ws;
    LAS f32x2* tot = (LAS f32x2*)lds;
    const int pair = vb >> 1, g = pair >> 2, b = pair & 3, nl = tid & 31, n = (vb & 1) * 32 + nl, seg = tid >> 5;
    const f32x2 a = ((const f32x2*)(ws + WS_A32))[g * NS + n];
    const float* EL = (const float*)(ws + WS_ELOC) + ((size_t)(g * CROWS + b * NCH + seg * 16)) * 128;
    float er[16], ei[16];
#pragma unroll
    for (int i = 0; i < 16; ++i) { er[i] = EL[(size_t)i * 128 + n]; ei[i] = EL[(size_t)i * 128 + 64 + n]; }
    float pr[16], pi[16]; float sr = 0.f, si = 0.f;
#pragma unroll
    for (int i = 0; i < 16; ++i) { pr[i] = sr; pi[i] = si; const float tr = a.x * sr - a.y * si + er[i], ti = a.x * si + a.y * sr + ei[i]; sr = tr; si = ti; }
    tot[seg * 32 + nl] = (f32x2){sr, si};
    __syncthreads();
    f32x2 a16 = a;
#pragma unroll
    for (int k = 0; k < 4; ++k) a16 = (f32x2){a16.x * a16.x - a16.y * a16.y, 2.f * a16.x * a16.y};
    float cr = 0.f, ci = 0.f;
    for (int j = 0; j < seg; ++j) { const f32x2 tj = tot[j * 32 + nl]; const float tr = a16.x * cr - a16.y * ci + tj.x, ti = a16.x * ci + a16.y * cr + tj.y; cr = tr; ci = ti; }
    bf16_t* U = (bf16_t*)(ws + WS_UGS) + ((size_t)(g * CROWS + b * NCH + seg * 16)) * KU;
#pragma unroll
    for (int i = 0; i < 16; ++i) {
        U[(size_t)i * KU + n] = f2bf(cr + pr[i]); U[(size_t)i * KU + 64 + n] = f2bf(ci + pi[i]);
        const float tr = a.x * cr - a.y * ci, ti = a.x * ci + a.y * cr; cr = tr; ci = ti;
    }
    __syncthreads();
}

__device__ __forceinline__ int crow(int r, int hi) { return (r & 3) + 8 * (r >> 2) + 4 * hi; }
template <bool DIAG>
__device__ __forceinline__ void attn_unit(const Params& P, LAS unsigned char* lds, int bh, int j, int row0, int nrows, int tid) {
    unsigned char* ws = P.ws;
    LAS unsigned char* Ks = lds;
    LAS unsigned char* Vs = lds + 36864;
    const size_t blkoff = ((size_t)bh * SEQ + j * 256) * HD;
    {
        const u32x4* ksrc = (const u32x4*)((const bf16_t*)(ws + WS_KH) + blkoff);
        const u32x4* vsrc = (const u32x4*)((const bf16_t*)(ws + WS_VT) + blkoff);
        u32x4 kw[4], vw[4];
#pragma unroll
        for (int i = 0; i < 4; ++i) { kw[i] = ksrc[tid + 512 * i]; vw[i] = vsrc[tid + 512 * i]; }
#pragma unroll
        for (int i = 0; i < 4; ++i) { const int p = tid + 512 * i; *(LAS u32x4*)(Ks + (p >> 3) * 144 + (p & 7) * 16) = kw[i];
            LAS u32x2* dv = (LAS u32x2*)(Vs + (p >> 5) * 520 + (p & 31) * 16); dv[0] = (u32x2){vw[i].x, vw[i].y}; dv[1] = (u32x2){vw[i].z, vw[i].w}; }
    }
    __syncthreads();
    const int lane = tid & 63, wid = __builtin_amdgcn_readfirstlane(tid >> 6), r32 = lane & 31, hi = lane >> 5;
    const int rq = wid * 32 + r32; const bool valid = rq < nrows;
    int spos, slot;
    if (DIAG) { spos = j * 256 + rq; slot = 3; }
    else { const unsigned e = valid ? ((const unsigned short*)(ws + WS_LISTS))[(size_t)(bh * NBLK + j) * SEQ + row0 + rq] : 0u; spos = e & 0x1fff; slot = e >> 13; }
    bf16x8 qf[4];
    { const bf16_t* qp = (const bf16_t*)(ws + WS_QH) + ((size_t)bh * SEQ + spos) * HD + hi * 8;
#pragma unroll
      for (int d0 = 0; d0 < 4; ++d0) qf[d0] = *(const bf16x8*)(qp + d0 * 16); }
    f32x16 st[8];
#pragma unroll
    for (int kt = 0; kt < 8; ++kt) {
#pragma unroll
        for (int r = 0; r < 16; ++r) st[kt][r] = 0.f;
        if (!DIAG || kt <= wid) {
#pragma unroll
            for (int d0 = 0; d0 < 4; ++d0) { const bf16x8 kf = *(const LAS bf16x8*)(Ks + (kt * 32 + r32) * 144 + (d0 * 2 + hi) * 16); st[kt] = __builtin_amdgcn_mfma_f32_32x32x16_bf16(kf, qf[d0], st[kt], 0, 0, 0); }
        }
    }
    float m = -INFINITY;
#pragma unroll
    for (int kt = 0; kt < 8; ++kt) {
        if (!DIAG || kt <= wid) {
            if (DIAG && kt == wid) {
#pragma unroll
                for (int r = 0; r < 16; ++r) if (kt * 32 + crow(r, hi) > rq) st[kt][r] = -INFINITY;
            }
#pragma unroll
            for (int r = 0; r < 16; ++r) m = fmaxf(m, st[kt][r]);
        }
    }
    m = fmaxf(m, shx(m, 32, lane));
    float l = 0.f;
#pragma unroll
    for (int kt = 0; kt < 8; ++kt) {
        if (!DIAG || kt <= wid) {
#pragma unroll
            for (int r = 0; r < 16; ++r) { const float p = __builtin_amdgcn_exp2f(st[kt][r] - m); st[kt][r] = p; l += p; }
        }
    }
    l += shx(l, 32, lane);
    f32x16 ot[2];
#pragma unroll
    for (int r = 0; r < 16; ++r) { ot[0][r] = 0.f; ot[1][r] = 0.f; }
#pragma unroll
    for (int kt = 0; kt < 8; ++kt) {
        if (!DIAG || kt <= wid) {
#pragma unroll
            for (int s2 = 0; s2 < 2; ++s2) {
                u32x4 pw; pw.x = pk2(st[kt][8 * s2 + 0], st[kt][8 * s2 + 1]); pw.y = pk2(st[kt][8 * s2 + 2], st[kt][8 * s2 + 3]); pw.z = pk2(st[kt][8 * s2 + 4], st[kt][8 * s2 + 5]); pw.w = pk2(st[kt][8 * s2 + 6], st[kt][8 * s2 + 7]);
                const bf16x8 pf = __builtin_bit_cast(bf16x8, pw);
#pragma unroll
                for (int dt = 0; dt < 2; ++dt) {
                    const LAS unsigned char* vb = Vs + (dt * 32 + r32) * 520 + (kt * 32 + s2 * 16 + 4 * hi) * 2;
                    const u32x2 lo = *(const LAS u32x2*)vb, hh = *(const LAS u32x2*)(vb + 16);
                    const u32x4 vw = {lo.x, lo.y, hh.x, hh.y};
                    ot[dt] = __builtin_amdgcn_mfma_f32_32x32x16_bf16(__builtin_bit_cast(bf16x8, vw), pf, ot[dt], 0, 0, 0);
                }
            }
        }
    }
    if (valid) {
        const size_t prow = ((size_t)((bh >> 3) * SEQ + spos) * NH + (bh & 7)) * 4 + slot;
        const float inv = 1.0f / l;
        bf16_t* po = (bf16_t*)P.out + prow * HD + 4 * hi;
#pragma unroll
        for (int dt = 0; dt < 2; ++dt)
#pragma unroll
            for (int g4 = 0; g4 < 4; ++g4) { u32x2 w; w.x = pk2(ot[dt][4 * g4] * inv, ot[dt][4 * g4 + 1] * inv); w.y = pk2(ot[dt][4 * g4 + 2] * inv, ot[dt][4 * g4 + 3] * inv);
                *(u32x2*)(po + dt * 32 + g4 * 8) = w; }
        if (hi == 0) ((f32x2*)(ws + WS_PML))[prow] = (f32x2){m, l};
    }
    __syncthreads();
}

template <class F> __device__ __forceinline__ void block_prefix_1024(LAS int* pre, LAS int* wt, int tid, const F& val) {
    const int lane = tid & 63, wid = tid >> 6;
    const int a = val(2 * tid), b = val(2 * tid + 1), s = a + b;
    int inc = s;
#pragma unroll
    for (int o = 1; o < 64; o <<= 1) { const int v = shup(inc, o, lane); if (lane >= o) inc += v; }
    if (lane == 63) wt[wid] = inc;
    __syncthreads();
    int woff = 0;
    for (int w = 0; w < wid; ++w) woff += wt[w];
    const int ex = inc - s + woff;
    pre[2 * tid] = ex; pre[2 * tid + 1] = ex + a;
    if (tid == 511) pre[1024] = ex + s;
    __syncthreads();
}

__device__ __forceinline__ void attn_phase(const Params& P, LAS unsigned char* lds, int G, const int tid) {
    LAS int* pre = (LAS int*)(lds + MISC_OFF);
    LAS int* wt = pre + 1032;
    const int* lcnt = (const int*)(P.ws + WS_CTL) + CW_LCNT;
    block_prefix_1024(pre, wt, tid, [&](int i) { return (lcnt[i] + 255) >> 8; });
    const int total = pre[1024], nunits = total + NBH * NBLK;
    for (int u = blockIdx.x; u < nunits; u += G) {
        if (u < total) {
            int lo = 0, hi = 1023;
            while (lo < hi) { const int mid = (lo + hi + 1) >> 1; if (pre[mid] <= u) lo = mid; else hi = mid - 1; }
            const int L = __builtin_amdgcn_readfirstlane(lo), tile = u - __builtin_amdgcn_readfirstlane(pre[L]);
            const int cnt = __builtin_amdgcn_readfirstlane(lcnt[L]);
            attn_unit<false>(P, lds, L >> 5, L & 31, tile * 256, min(256, cnt - tile * 256), tid);
        } else {
            const int d = u - total;
            attn_unit<true>(P, lds, d >> 5, d & 31, 0, 256, tid);
        }
    }
}

__device__ __forceinline__ void combine_phase(const Params& P, int G, const int tid) {
    unsigned char* ws = P.ws;
    const f32x2* PML = (const f32x2*)(ws + WS_PML); const bf16_t* PO = (const bf16_t*)P.out; bf16_t* ATT = (bf16_t*)(ws + WS_ATT);
    for (int idx = blockIdx.x * 512 + tid; idx < T * NH * 4; idx += G * 512) {
        const int qd = idx & 3, th = idx >> 2, token = th >> 3, head = th & 7, qblk = (token & (SEQ - 1)) >> 8, nv = qblk < 3 ? qblk : 3;
        float mm[4], ll[4]; float M = -INFINITY;
#pragma unroll
        for (int s = 0; s < 4; ++s) { const bool v = (s < nv) || (s == 3); f32x2 ml = {-INFINITY, 0.f}; if (v) ml = PML[(size_t)th * 4 + s]; mm[s] = ml.x; ll[s] = ml.y; M = fmaxf(M, ml.x); }
        float o[16];
#pragma unroll
        for (int i = 0; i < 16; ++i) o[i] = 0.f;
        float W = 0.f;
#pragma unroll
        for (int s = 0; s < 4; ++s) {
            const bool v = (s < nv) || (s == 3);
            if (v) {
                const float w = ll[s] * __builtin_amdgcn_exp2f(mm[s] - M); W += w;
                const u32x4* pp = (const u32x4*)(PO + ((size_t)th * 4 + s) * HD + qd * 16);
                f32x4 a, b, c, d; unpk8(pp[0], a, b); unpk8(pp[1], c, d);
#pragma unroll
                for (int i = 0; i < 4; ++i) { o[i] += w * a[i]; o[4 + i] += w * b[i]; o[8 + i] += w * c[i]; o[12 + i] += w * d[i]; }
            }
        }
        const float inv = 1.0f / W;
        u32x4 w0, w1;
        w0.x = pk2(o[0] * inv, o[1] * inv); w0.y = pk2(o[2] * inv, o[3] * inv); w0.z = pk2(o[4] * inv, o[5] * inv); w0.w = pk2(o[6] * inv, o[7] * inv);
        w1.x = pk2(o[8] * inv, o[9] * inv); w1.y = pk2(o[10] * inv, o[11] * inv); w1.z = pk2(o[12] * inv, o[13] * inv); w1.w = pk2(o[14] * inv, o[15] * inv);
        u32x4* dp = (u32x4*)(ATT + (size_t)token * SSMW + head * HD + qd * 16);
        dp[0] = w0; dp[1] = w1;
    }
}

__device__ __forceinline__ void route_phase(const Params& P, LAS unsigned char* lds, int G, const int tid) {
    unsigned char* ws = P.ws;
    const int lane = tid & 63, wid = __builtin_amdgcn_readfirstlane(tid >> 6), rr = lane & 15, kq = lane >> 4;
    LAS float* lg = (LAS float*)(lds + wid * 4096);
    LAS int* he = (LAS int*)(lds + MISC_OFF);
    LAS int* hp = he + 32;
    LAS int* be = hp + 112;
    LAS int* bp = be + 32;
    int* gcnt = (int*)(ws + WS_CTL);
    const bf16_t* HI = (const bf16_t*)(ws + WS_WRT); const bf16_t* LO = HI + 48 * DM;
    for (int base = 0; base < T / 16; base += G * 8) {
        const int tile = base + blockIdx.x * 8 + wid; const bool active = tile < T / 16;
        if (tid < 144) he[tid] = 0;
        __syncthreads();
        int E0 = 0, E1 = 0, pp = 0, sl0 = 0, re0 = 0, re1 = 0, rp = 0; float w0 = 0.f, w1 = 0.f, r2 = 0.f;
        if (active) {
            const float* xrow = P.out + (size_t)(tile * 16 + rr) * DM + kq * 8;
            f32x4 acc[3]; float ssq = 0.f;
#pragma unroll
            for (int ct = 0; ct < 3; ++ct) acc[ct] = (f32x4){0.f, 0.f, 0.f, 0.f};
            for (int ks = 0; ks < 32; ++ks) {
                const f32x4 a0 = *(const f32x4*)(xrow + ks * 32), a1 = *(const f32x4*)(xrow + ks * 32 + 4);
                ssq += (a0.x * a0.x + a0.y * a0.y) + (a0.z * a0.z + a0.w * a0.w) + (a1.x * a1.x + a1.y * a1.y) + (a1.z * a1.z + a1.w * a1.w);
                const u32x4 hw = pk8(a0, a1); f32x4 h0, h1; unpk8(hw, h0, h1); const u32x4 lw = pk8(a0 - h0, a1 - h1);
                const bf16x8 ah = __builtin_bit_cast(bf16x8, hw), al = __builtin_bit_cast(bf16x8, lw);
#pragma unroll
                for (int ct = 0; ct < 3; ++ct) {
                    const bf16_t* bpw = HI + (size_t)(ct * 16 + rr) * DM + ks * 32 + kq * 8;
                    const bf16x8 bh = *(const bf16x8*)bpw, bl = *(const bf16x8*)(bpw + 48 * DM);
                    acc[ct] = __builtin_amdgcn_mfma_f32_16x16x32_bf16(ah, bh, acc[ct], 0, 0, 0);
                    acc[ct] = __builtin_amdgcn_mfma_f32_16x16x32_bf16(ah, bl, acc[ct], 0, 0, 0);
                    acc[ct] = __builtin_amdgcn_mfma_f32_16x16x32_bf16(al, bh, acc[ct], 0, 0, 0);
                }
            }
            ssq += shx(ssq, 16, lane); ssq += shx(ssq, 32, lane);
#pragma unroll
            for (int ct = 0; ct < 3; ++ct)
#pragma unroll
                for (int rg = 0; rg < 4; ++rg) lg[(kq * 4 + rg) * 49 + ct * 16 + rr] = acc[ct][rg];
            asm volatile("s_waitcnt lgkmcnt(0)" ::: "memory"); __builtin_amdgcn_wave_barrier();
            if (lane < 16) {
                r2 = 1.0f / sqrtf(ssq * (1.f / DM) + EPS);
                const LAS float* row = lg + lane * 49;
                float gl[4]; int gi = 0; float gmax = -INFINITY;
#pragma unroll
                for (int c = 0; c < 4; ++c) { gl[c] = row[c] * r2 + P.in[I_BRG][c]; if (gl[c] > gmax) { gmax = gl[c]; gi = c; } }
                float den = 0.f;
#pragma unroll
                for (int c = 0; c < 4; ++c) den += __expf(gl[c] - gmax);
                const float gp = 1.0f / den;
                float ev[8];
#pragma unroll
                for (int e = 0; e < 8; ++e) ev[e] = row[4 + gi * 8 + e] * r2 + P.in[I_BREX][gi * 8 + e];
                int i0 = 0; float v0 = -INFINITY;
#pragma unroll
                for (int e = 0; e < 8; ++e) if (ev[e] > v0) { v0 = ev[e]; i0 = e; }
                int i1 = 0; float v1 = -INFINITY;
#pragma unroll
                for (int e = 0; e < 8; ++e) if (e != i0 && ev[e] > v1) { v1 = ev[e]; i1 = e; }
                const float tt = __expf(v1 - v0);
                w0 = gp / (1.0f + tt); w1 = gp * tt / (1.0f + tt);
                const int lo = i0 < i1 ? i0 : i1, hh = i0 < i1 ? i1 : i0;
                pp = gi * 28 + (lo * (15 - lo)) / 2 + (hh - lo - 1);
                sl0 = (i0 == lo) ? 0 : 1;
                E0 = gi * 8 + i0; E1 = gi * 8 + i1;
                re0 = atomicAdd((int*)&he[E0], 1); re1 = atomicAdd((int*)&he[E1], 1); rp = atomicAdd((int*)&hp[pp], 1);
            }
        }
        __syncthreads();
        if (tid < 144) { const int h = he[tid]; be[tid] = h ? atomicAdd(gcnt + (tid < 32 ? CW_ECNT + tid : CW_PCNT + tid - 32), h) : 0; }
        __syncthreads();
        if (active && lane < 16) {
            const int token = tile * 16 + lane;
            const int rankp = bp[pp] + rp;
            const size_t i0x = (size_t)E0 * T + be[E0] + re0, i1x = (size_t)E1 * T + be[E1] + re1;
            ((int*)(ws + WS_ELTOK))[i0x] = token; ((int*)(ws + WS_ELDST))[i0x] = (pp << 17) | (sl0 << 16) | rankp; ((float*)(ws + WS_ELW))[i0x] = w0; ((float*)(ws + WS_ELR2))[i0x] = r2;
            ((int*)(ws + WS_ELTOK))[i1x] = token; ((int*)(ws + WS_ELDST))[i1x] = (pp << 17) | ((1 - sl0) << 16) | rankp; ((float*)(ws + WS_ELW))[i1x] = w1; ((float*)(ws + WS_ELR2))[i1x] = r2;
            ((int*)(ws + WS_PLTOK))[(size_t)pp * T + rankp] = token;
        }
        __syncthreads();
    }
}

struct MoeTables { LAS int *ecnt, *epre, *pcnt, *ppre, *pairoff; };
__device__ __forceinline__ MoeTables moe_tables(const Params& P, LAS unsigned char* lds, int tid) {
    MoeTables M;
    M.ecnt = (LAS int*)(lds + MISC_OFF); M.epre = M.ecnt + 32; M.pcnt = M.epre + 40; M.ppre = M.pcnt + 112; M.pairoff = M.ppre + 120;
    const int* gcnt = (const int*)(P.ws + WS_CTL);
    if (tid < 32) M.ecnt[tid] = gcnt[CW_ECNT + tid];
    if (tid >= 64 && tid < 64 + NPAIR) M.pcnt[tid - 64] = gcnt[CW_PCNT + tid - 64];
    __syncthreads();
    if (tid == 0) { int s = 0; for (int e = 0; e < NE; ++e) { M.epre[e] = s; s += (M.ecnt[e] + 255) >> 8; } M.epre[NE] = s; }
    if (tid == 64) { int s = 0, r = 0; for (int p = 0; p < NPAIR; ++p) { M.ppre[p] = s; M.pairoff[p] = r; const int tl = (M.pcnt[p] + 255) >> 8; s += tl * 4; r += tl * 256; } M.ppre[NPAIR] = s; M.pairoff[NPAIR] = r; }
    __syncthreads();
    return M;
}


constexpr int CW_BAR = 8192;
#define XB_TMO      128
#define XB_XCNT(j)  (256  + 64 * (j))
#define XB_XSUB(j)  (1280 + 64 * (j))
#define XB_XGEN(j)  (2304 + 64 * (j))
#define XB_TOP      3328
#define XB_TOPGEN   3392
#define XCD_BAR_WORDS 3456
#define XB_SPIN_CAP (1u << 18)
__device__ __forceinline__ unsigned xb_ld(unsigned* p)              { return __hip_atomic_load(p, __ATOMIC_RELAXED, __HIP_MEMORY_SCOPE_AGENT); }
__device__ __forceinline__ unsigned xb_add(unsigned* p, unsigned v) { return __hip_atomic_fetch_add(p, v, __ATOMIC_RELAXED, __HIP_MEMORY_SCOPE_AGENT); }
__device__ __forceinline__ unsigned xb_xcc_id() { return (unsigned)__builtin_amdgcn_s_getreg((3 << 11) | 20) & 0xFu; }
#define XB_SPIN(cond, bar) do { unsigned _sp = 0; while (cond) { __builtin_amdgcn_s_sleep(1); \
    if ((++_sp & 255u) == 0u) { if (xb_ld(&(bar)[XB_TMO])) break; if (_sp > XB_SPIN_CAP) { atomicAdd(&(bar)[XB_TMO], 1u); break; } } } } while (0)
struct XcdBarrier { unsigned* bar; unsigned x; volatile LAS unsigned* st; };
__device__ __forceinline__ XcdBarrier xcd_barrier_post(unsigned* bar, volatile LAS unsigned* st) {
    XcdBarrier b; b.bar = bar; b.x = xb_xcc_id(); b.st = st;
    if (threadIdx.x == 0) (void)xb_add(&bar[XB_XCNT(b.x)], 1u);
    return b;
}
__device__ __forceinline__ void xcd_barrier_complete(unsigned* bar, unsigned x, unsigned& nloc, unsigned& nx) {
    const unsigned G = gridDim.x * gridDim.y * gridDim.z;
    unsigned sum, cnt, mine, sp = 0u;
    for (;;) {
        sum = 0u; cnt = 0u; mine = 0u;
#pragma unroll
        for (unsigned j = 0; j < 16; ++j) { const unsigned c = xb_ld(&bar[XB_XCNT(j)]); sum += c; cnt += (c > 0u) ? 1u : 0u; mine = (j == x) ? c : mine; }
        if (sum == G) break;
        __builtin_amdgcn_s_sleep(1);
        if ((++sp & 255u) == 0u) { if (xb_ld(&bar[XB_TMO])) break; if (sp > XB_SPIN_CAP) { atomicAdd(&bar[XB_TMO], 1u); break; } }
    }
    nloc = mine > 0u ? mine : 1u; nx = cnt > 0u ? cnt : 1u;
}
__device__ __forceinline__ void xcd_barrier(const XcdBarrier& b, const int tid) {
    asm volatile("s_waitcnt vmcnt(0)" ::: "memory");
    __syncthreads();
    if (tid == 0) {
        unsigned* bar = b.bar;
        __builtin_amdgcn_s_waitcnt(0);
        unsigned nloc = b.st[0], nx = b.st[1];
        if (nloc == 0u) { xcd_barrier_complete(bar, b.x, nloc, nx); b.st[0] = nloc; b.st[1] = nx; }
        const unsigned old = xb_add(&bar[XB_XSUB(b.x)], 1u);
        const unsigned gen = old / nloc;
        if (old + 1u == (gen + 1u) * nloc) {
            __builtin_amdgcn_fence(__ATOMIC_RELEASE, "agent");
            asm volatile("s_waitcnt vmcnt(0)" ::: "memory");
            const unsigned og = xb_add(&bar[XB_TOP], 1u);
            const unsigned tg = og / nx;
            if (og + 1u == (tg + 1u) * nx) xb_add(&bar[XB_TOPGEN], 1u);
            else XB_SPIN(xb_ld(&bar[XB_TOPGEN]) == tg, bar);
            __builtin_amdgcn_fence(__ATOMIC_ACQUIRE, "agent");
            xb_add(&bar[XB_XGEN(b.x)], 1u);
            asm volatile("s_waitcnt vmcnt(0)" ::: "memory");
        } else {
            XB_SPIN(xb_ld(&bar[XB_XGEN(b.x)]) == gen, bar);
            __builtin_amdgcn_fence(__ATOMIC_ACQUIRE, "agent");
            asm volatile("s_waitcnt vmcnt(0)" ::: "memory");
        }
    }
    __syncthreads();
}

#ifndef N_PHASES
#define N_PHASES 11
#endif
__global__ void __launch_bounds__(512, 2) hybrid_fwd(Params P) {
    extern __shared__ __attribute__((aligned(16))) unsigned char lds_raw[];
    LAS unsigned char* lds = (LAS unsigned char*)lds_raw;
    const int G = gridDim.x, c = blockIdx.x, wave = __builtin_amdgcn_readfirstlane(threadIdx.x >> 6);
#define FT fresh_tid(wave)
    volatile LAS unsigned* bst = (volatile LAS unsigned*)(lds + LDS_BYTES - 16);
    if (threadIdx.x == 0) { bst[0] = 0u; bst[1] = 0u; }
    __syncthreads();
    const XcdBarrier bar = xcd_barrier_post((unsigned*)(P.ws + WS_CTL) + CW_BAR, bst);
#define GRID_SYNC() xcd_barrier(bar, FT)
    unsigned char* ws = P.ws;
#define BF(off) ((bf16_t*)(ws + (off)))
    phase0(P, lds, G, FT);
    GRID_SYNC();
    { gk::GridOrder S; S.init(T / 256, NIN / 256, DM, DM, DM, G, c);
      EpiProj E{BF(WS_UGS), BF(WS_QH), BF(WS_KH), BF(WS_VT), BF(WS_SGS), BF(WS_SGA)};
      gk::gemm_phase<EpiProj, gk::GridOrder, false, false>(lds, FT, BF(WS_XN), DM, BF(WS_WIN), DM, S, E); }
    GRID_SYNC();
    for (int u = c; u < NBH * NBLK; u += G) qkv_unit(P, lds, u >> 5, u & 31, FT);
    { ElocOrder S{G, c}; EpiEloc E{(float*)(ws + WS_ELOC)};
      gk::gemm_phase<EpiEloc, ElocOrder, false, false>(lds, FT, BF(WS_UGS), KU, BF(WS_MIN), NTC, S, E); }
    GRID_SYNC();
    for (int u = c; u < NBH * NBLK; u += G) { const int qb = u & 31; if (qb > 0) select_unit(P, lds, u >> 5, qb, FT); }
    tg_expand(P, G, FT);
    for (int vb = c; vb < 256; vb += G) carry_scan(P, lds, vb, FT);
    GRID_SYNC();
    { SsmOrder S{G, c}; EpiSsm E{BF(WS_Z)};
      gk::gemm_phase<EpiSsm, SsmOrder, false, false>(lds, FT, BF(WS_UGS), KU, BF(WS_TG), KU, S, E); }
    attn_phase(P, lds, G, FT);
    GRID_SYNC();
    combine_phase(P, G, FT);
    { gk::GridOrder S; S.init(T / 256, SSMW / 256, SSMW, SSMW, SSMW, G, c);
      EpiGlu E{BF(WS_Z), P.in[I_BGLU], BF(WS_OS)};
      gk::gemm_phase<EpiGlu, gk::GridOrder, false, false>(lds, FT, BF(WS_Z), SSMW, BF(WS_WGLU), SSMW, S, E); }
    GRID_SYNC();
    { gk::GridOrder S; S.init(T / 256, DM / 256, SSMW, SSMW, SSMW, G, c);
      EpiMerge<false> Ea{BF(WS_SGS), BF(WS_MG)};
      gk::gemm_phase<EpiMerge<false>, gk::GridOrder, false, false>(lds, FT, BF(WS_OS), SSMW, BF(WS_WPS), SSMW, S, Ea);
      EpiMerge<true> Eb{BF(WS_SGA), BF(WS_MG)};
      gk::gemm_phase<EpiMerge<true>, gk::GridOrder, false, false>(lds, FT, BF(WS_ATT), SSMW, BF(WS_WPA), SSMW, S, Eb); }
    GRID_SYNC();
    { gk::GridOrder S; S.init(T / 256, DM / 256, DM, DM, DM, G, c);
      EpiOut E{P.in[I_X], P.out, BF(WS_X1B)};
      gk::gemm_phase<EpiOut, gk::GridOrder, false, false>(lds, FT, BF(WS_MG), DM, BF(WS_WOUT), DM, S, E); }
    GRID_SYNC();
    route_phase(P, lds, G, FT);
    GRID_SYNC();
    MoeTables M = moe_tables(P, lds, FT);
    { GUOrder S{M.epre, M.ecnt, (const int*)(ws + WS_ELTOK), G, c};
      EpiGU E{(const int*)(ws + WS_ELDST), (const float*)(ws + WS_ELW), (const float*)(ws + WS_ELR2), BF(WS_ACT), M.pairoff};
      gk::gemm_phase<EpiGU, GUOrder, true, false>(lds, FT, BF(WS_X1B), DM, BF(WS_WGU), DM, S, E); }
    GRID_SYNC();
    { DNOrder S{M.ppre, M.pcnt, M.pairoff, G, c};
      EpiDN E{(const int*)(ws + WS_PLTOK), P.out};
      gk::gemm_phase<EpiDN, DNOrder, false, true>(lds, FT, BF(WS_ACT), 256, BF(WS_WDN), NE * DE, S, E); }
#undef BF
#undef FT
#undef GRID_SYNC
}

extern "C" void kernel_launch(void* const* d_in, const int* in_sizes, int n_in, void* d_out, int out_size, void* d_ws, size_t ws_size, hipStream_t stream) {
    static int grid = 0;
    if (grid == 0) {
        if (n_in != 26 || in_sizes[0] != T * DM || out_size != T * DM || ws_size < WS_END) {
            fprintf(stderr, "kernel_launch: unexpected shapes (n_in %d, in0 %d, out %d, ws %zu)\n", n_in, n_in > 0 ? in_sizes[0] : -1, out_size, ws_size); grid = -1; return; }
        int dev = 0, cus = 0, per_cu = 0;
        (void)hipGetDevice(&dev);
        (void)hipDeviceGetAttribute(&cus, hipDeviceAttributeMultiprocessorCount, dev);
        (void)hipFuncSetAttribute((const void*)hybrid_fwd, hipFuncAttributeMaxDynamicSharedMemorySize, LDS_BYTES);
        (void)hipOccupancyMaxActiveBlocksPerMultiprocessor(&per_cu, (const void*)hybrid_fwd, 512, LDS_BYTES);
        if (per_cu < 1) { fprintf(stderr, "kernel_launch: occupancy query says %d blocks/CU\n", per_cu); grid = -1; return; }
        grid = cus * (per_cu > 1 ? 1 : per_cu);
        (void)hipGetLastError();
    }
    if (grid < 0) return;
    (void)hipMemsetAsync((char*)d_ws + WS_CTL, 0, 1 * MiB, stream);
    Params p{};
    for (int i = 0; i < 26; ++i) p.in[i] = (const float*)d_in[i];
    p.out = (float*)d_out; p.ws = (unsigned char*)d_ws;
    void* args[] = {&p};
    hipError_t e = hipLaunchCooperativeKernel((const void*)hybrid_fwd, dim3(grid), dim3(512), args, LDS_BYTES, stream);
    if (e != hipSuccess) fprintf(stderr, "cooperative launch failed: %s (grid %d)\n", hipGetErrorString(e), grid);
}
```

```cpp
#include <hip/hip_runtime.h>
#include <hip/hip_cooperative_groups.h>
#include <cstdio>
#include <cstdint>
namespace cg = cooperative_groups;

#define LAS __attribute__((address_space(3)))
typedef unsigned short bf16_t;
typedef short bf16x8 __attribute__((ext_vector_type(8)));
typedef float f32x2 __attribute__((ext_vector_type(2)));
typedef float f32x4 __attribute__((ext_vector_type(4)));
typedef float f32x16 __attribute__((ext_vector_type(16)));
typedef unsigned u32x2 __attribute__((ext_vector_type(2)));
typedef unsigned u32x4 __attribute__((ext_vector_type(4)));
typedef __bf16 bf16x2_t __attribute__((ext_vector_type(2)));

constexpr int NB = 4, SEQ = 8192, T = NB * SEQ, DM = 1024, NIN = 4096;
constexpr int NH = 8, HD = 64, NBH = NB * NH, NBLK = 32, BLK = 256;
constexpr int SSMW = 512, NG = 32, GC = 16, NS = 64;
constexpr int CL = 32, NCH = SEQ / CL, CROWS = NB * NCH  , KU = 128 + CL * GC  , NTC = CL * GC  ;
constexpr int NE = 32, DE = 128, NPAIR = 112;
constexpr float EPS = 1e-6f;
constexpr float QSCALE = 0.125f * 1.4426950408889634f;

constexpr size_t MiB = 1u << 20;
constexpr size_t WS_CTL = 0;
constexpr size_t WS_KMEAN = 1 * MiB;
constexpr size_t WS_A32 = WS_KMEAN + 256 * 1024;
constexpr size_t WS_WRT = WS_A32 + 64 * 1024;
constexpr size_t WS_KC = 2 * MiB;
constexpr size_t WS_MIN = 3 * MiB;
constexpr size_t WS_WIN = 8 * MiB;
constexpr size_t WS_WGLU = 16 * MiB;
constexpr size_t WS_WPS = 17 * MiB;
constexpr size_t WS_WPA = 18 * MiB;
constexpr size_t WS_WOUT = 19 * MiB;
constexpr size_t WS_WGU = 21 * MiB;
constexpr size_t WS_WDN = 37 * MiB;
constexpr size_t WS_MOUT = 46 * MiB;
constexpr size_t WS_A = 50 * MiB;
constexpr size_t WS_XN = WS_A;
constexpr size_t WS_LISTS = WS_A;
constexpr size_t WS_TG = WS_A + 16 * MiB;
constexpr size_t WS_ELOC = WS_A + 40 * MiB;
constexpr size_t WS_ATT = WS_A;
constexpr size_t WS_OS = WS_A + 32 * MiB;
constexpr size_t WS_B = 114 * MiB;
constexpr size_t WS_QH = WS_B, WS_KH = WS_B + 32 * MiB, WS_VT = WS_B + 64 * MiB;
constexpr size_t WS_MG = WS_B;
constexpr size_t WS_ACT = WS_B;
constexpr size_t WS_ELTOK = WS_B + 64 * MiB;
constexpr size_t WS_ELDST = WS_B + 68 * MiB;
constexpr size_t WS_ELW = WS_B + 72 * MiB;
constexpr size_t WS_ELR2 = WS_B + 76 * MiB;
constexpr size_t WS_PLTOK = WS_B + 80 * MiB;
constexpr size_t WS_C = 210 * MiB;
constexpr size_t WS_SGS = WS_C, WS_SGA = WS_C + 64 * MiB;
constexpr size_t WS_X1B = WS_C;
constexpr size_t WS_UGS = 338 * MiB;
constexpr size_t WS_Z = 380 * MiB;
constexpr size_t WS_PML = 412 * MiB;
constexpr size_t WS_END = 420 * MiB;
constexpr int CW_LCNT = 1024;
constexpr int CW_ECNT = 4096;
constexpr int CW_PCNT = 4224;

constexpr int RING_BYTES = 131072;
constexpr int MISC_OFF = RING_BYTES;
constexpr int LDS_BYTES = 147456;

__device__ __forceinline__ unsigned pk2(float lo, float hi) { f32x2 v = {lo, hi}; bf16x2_t b = __builtin_convertvector(v, bf16x2_t); return __builtin_bit_cast(unsigned, b); }
__device__ __forceinline__ bf16_t f2bf(float f) { return (bf16_t)(pk2(f, 0.f) & 0xffffu); }
__device__ __forceinline__ float bflo(unsigned w) { return __uint_as_float(w << 16); }
__device__ __forceinline__ float bfhi(unsigned w) { return __uint_as_float(w & 0xffff0000u); }
__device__ __forceinline__ float bf2f(bf16_t b) { return __uint_as_float(((unsigned)b) << 16); }
__device__ __forceinline__ u32x4 pk8(f32x4 a, f32x4 b) { u32x4 w; w.x = pk2(a[0], a[1]); w.y = pk2(a[2], a[3]); w.z = pk2(b[0], b[1]); w.w = pk2(b[2], b[3]); return w; }
__device__ __forceinline__ void unpk8(u32x4 w, f32x4& a, f32x4& b) { a = (f32x4){bflo(w.x), bfhi(w.x), bflo(w.y), bfhi(w.y)}; b = (f32x4){bflo(w.z), bfhi(w.z), bflo(w.w), bfhi(w.w)}; }
__device__ __forceinline__ float sigmoidf_(float x) { return 1.0f / (1.0f + __expf(-x)); }
__device__ __forceinline__ float gelu_tanh(float x) { const float u = 0.7978845608028654f * (x + 0.044715f * x * x * x); const float e = __expf(-2.0f * u); return x / (1.0f + e); }
__device__ __forceinline__ int lane_id() { int l = __builtin_amdgcn_mbcnt_hi(~0u, __builtin_amdgcn_mbcnt_lo(~0u, 0u)); asm volatile("" : "+v"(l)); return l; }
__device__ __forceinline__ float shx(float v, int mask, int lane) { return __uint_as_float(__builtin_amdgcn_ds_bpermute((lane ^ mask) << 2, __float_as_uint(v))); }
__device__ __forceinline__ int shup(int v, int o, int lane) { return __builtin_amdgcn_ds_bpermute((lane - o) << 2, v); }
__device__ __forceinline__ int fresh_tid(int wave) { int t = wave * 64 + lane_id(); asm volatile("" : "+v"(t)); return t; }
__device__ __forceinline__ float wave_sum(float v) {
    const int lane = lane_id();
#pragma unroll
    for (int o = 1; o < 64; o <<= 1) v += shx(v, o, lane);
    return v;
}

namespace gk {
constexpr int BM = 256, BK = 64, HALF = 128, HTB = HALF * BK * 2, STAGE_BYTES = 8 * HTB;
__device__ __forceinline__ int lds_byte(int r, int c) { const int st = (r >> 4) * 2 + (c >> 5), rr = r & 15, cc = c & 31, ob = rr * 64 + cc * 2; return st * 1024 + (ob ^ (((ob >> 9) & 1) << 5)); }
__device__ __forceinline__ void stage_rc(int b, int& R, int& C) { const int st = b / 1024, sb = b % 1024, swz = sb ^ (((sb >> 9) & 1) << 5); R = (st >> 1) * 16 + swz / 64; C = (st & 1) * 32 + (swz % 64) / 2; }
__device__ __forceinline__ int perm32(int rho) { const int n = rho >> 4, i = rho & 15; return 8 * (i >> 2) + 4 * n + (i & 3); }

struct Unit {
    int pm, pn;
    long aoff, boff;
    int nt;
    int nvalid;
    const int* rows;
    int bsplit; long bjump;
    int aux0, aux1;
};

template <class F> __device__ __forceinline__ void epi_rows(const f32x4 (&acc)[2][2][4][2], int wr, int wc, int fr, int fq, const F& f) {
#pragma unroll
    for (int ai = 0; ai < 2; ++ai)
#pragma unroll
        for (int m = 0; m < 4; ++m) {
            const int rl = ai * HALF + wr * 64 + m * 16 + fr;
#pragma unroll
            for (int bj = 0; bj < 2; ++bj) f(rl, bj * HALF + wc * 32 + 8 * fq, acc[ai][bj][m][0], acc[ai][bj][m][1]);
        }
}

template <class Epi, class Sched, bool GATHER, bool BSPLIT>
__device__ __forceinline__ void gemm_phase(LAS unsigned char* lds, const int tid, const bf16_t* A, int lda, const bf16_t* Bt, int ldb, const Sched& S, const Epi& E) {
    const int wid = __builtin_amdgcn_readfirstlane(tid >> 6), lane = tid & 63, wr = wid >> 2, wc = wid & 3, fr = lane & 15, fq = lane >> 4;
    int Rr[2], Cc[2];
    unsigned voffA[2][2], voffB[2][2], voffN[2][2];
#pragma unroll
    for (int i = 0; i < 2; ++i) {
        stage_rc(tid * 16 + i * 8192, Rr[i], Cc[i]);
        const int Rb = (Rr[i] & ~31) + perm32(Rr[i] & 31);
#pragma unroll
        for (int h = 0; h < 2; ++h) {
            voffA[h][i] = (unsigned)((h * HALF + Rr[i]) * lda + Cc[i]) * 2u;
            voffB[h][i] = (unsigned)((h * HALF + Rb) * ldb + Cc[i]) * 2u;
            voffN[h][i] = voffA[h][i];
        }
    }
    constexpr size_t kstep = (size_t)(BK * 2);
    const unsigned ldsw = (unsigned)wid * 1024u;
    const int aoff = lds_byte(wr * 64 + fr, fq * 8), boff = lds_byte(wc * 32 + fr, fq * 8);
#define GK_SA(b, h) (((b) * 2 + (h)) * HTB)
#define GK_SB(b, h) ((4 + (b) * 2 + (h)) * HTB)
#define GK_STAGE(bufoff, gbase, voff) do { _Pragma("unroll") for (int _i = 0; _i < 2; ++_i) \
        __builtin_amdgcn_global_load_lds((const unsigned*)((const char*)(gbase) + (voff)[_i]), (LAS unsigned*)(lds + (bufoff) + ldsw + _i * 8192), 16, 0, 0); } while (0)
#define GK_LDA(dst, b, h) do { _Pragma("unroll") for (int m = 0; m < 4; ++m) _Pragma("unroll") for (int k = 0; k < 2; ++k) dst[m][k] = *(const LAS bf16x8*)(lds + GK_SA(b, h) + aoff + m * 2048 + k * 1024); } while (0)
#define GK_LDB(dst, b, h) do { _Pragma("unroll") for (int n = 0; n < 2; ++n) _Pragma("unroll") for (int k = 0; k < 2; ++k) dst[n][k] = *(const LAS bf16x8*)(lds + GK_SB(b, h) + boff + n * 2048 + k * 1024); } while (0)
#define GK_MMA(ai, bj, At, Bt_) do { __builtin_amdgcn_s_setprio(1); _Pragma("unroll") for (int m = 0; m < 4; ++m) _Pragma("unroll") for (int n = 0; n < 2; ++n) _Pragma("unroll") for (int k = 0; k < 2; ++k) \
        acc[ai][bj][m][n] = __builtin_amdgcn_mfma_f32_16x16x32_bf16(Bt_[n][k], At[m][k], acc[ai][bj][m][n], 0, 0, 0); __builtin_amdgcn_s_setprio(0); } while (0)
#define GK_WAIT_V(n) asm volatile("s_waitcnt vmcnt(" #n ")" ::: "memory")
#define GK_WAIT_L(n) asm volatile("s_waitcnt lgkmcnt(" #n ")" ::: "memory")
#define GK_BAR __builtin_amdgcn_s_barrier()
#define GK_SCHED __builtin_amdgcn_sched_barrier(0)
#define GK_GATHER(u, vo) do { if constexpr (GATHER) { _Pragma("unroll") for (int _h = 0; _h < 2; ++_h) _Pragma("unroll") for (int _i = 0; _i < 2; ++_i) { \
        const int _r = _h * HALF + Rr[_i]; const int _t = (_r < (u).nvalid) ? (u).rows[_r] : 0; vo[_h][_i] = (unsigned)(_t * lda + Cc[_i]) * 2u; } } } while (0)
#define GK_BP(u, base, t) ((base) + (size_t)(t) * kstep + ((BSPLIT && (t) >= (u).bsplit) ? (u).bjump : 0l))
    Unit cur, nxt; int ui = 0;
    if (!S.next(0, cur)) return;
    f32x4 acc[2][2][4][2];
#pragma unroll
    for (int a = 0; a < 2; ++a)
#pragma unroll
        for (int b = 0; b < 2; ++b)
#pragma unroll
            for (int m = 0; m < 4; ++m)
#pragma unroll
                for (int n = 0; n < 2; ++n) acc[a][b][m][n] = (f32x4){0.f, 0.f, 0.f, 0.f};
    bf16x8 At[4][2], B0[2][2], B1[2][2];
    const char* cA = (const char*)A + cur.aoff; const char* cB = (const char*)Bt + cur.boff;
    GK_GATHER(cur, voffA);
    GK_STAGE(GK_SB(0, 0), GK_BP(cur, cB, 0), voffB[0]); GK_STAGE(GK_SB(0, 1), GK_BP(cur, cB, 0), voffB[1]); GK_STAGE(GK_SA(0, 0), cA, voffA[0]); GK_STAGE(GK_SA(0, 1), cA, voffA[1]);
    if (wr == 1) GK_BAR;
    GK_WAIT_V(2); GK_BAR;
    GK_STAGE(GK_SB(1, 0), GK_BP(cur, cB, 1), voffB[0]); GK_STAGE(GK_SA(1, 0), cA + kstep, voffA[0]); GK_STAGE(GK_SB(1, 1), GK_BP(cur, cB, 1), voffB[1]);
    GK_WAIT_V(6); GK_BAR;
    for (;;) {
        const bool has_next = S.next(ui + 1, nxt);
        if (!has_next) nxt = cur;
        const char* nA = has_next ? (const char*)A + nxt.aoff : cA; const char* nB = has_next ? (const char*)Bt + nxt.boff : cB;
        if constexpr (GATHER) { if (has_next) { GK_GATHER(nxt, voffN); } else {
#pragma unroll
            for (int h = 0; h < 2; ++h)
#pragma unroll
                for (int i = 0; i < 2; ++i) voffN[h][i] = voffA[h][i]; } }
        const int nt = cur.nt;
        for (int t = 0; t < nt; t += 2) {
            const bool last = (t == nt - 2);
            const char* a1 = cA + (size_t)(t + 1) * kstep;
            const char* a2 = last ? nA : cA + (size_t)(t + 2) * kstep; const char* a3 = a2 + kstep;
            const char* b2 = last ? GK_BP(nxt, nB, 0) : GK_BP(cur, cB, t + 2);
            const char* b3 = last ? GK_BP(nxt, nB, 1) : GK_BP(cur, cB, t + 3);
            unsigned vA2[2][2];
#pragma unroll
            for (int h = 0; h < 2; ++h)
#pragma unroll
                for (int i = 0; i < 2; ++i) vA2[h][i] = (GATHER && last) ? voffN[h][i] : voffA[h][i];
            GK_LDB(B0, 0, 0); GK_LDB(B1, 0, 1); GK_SCHED; GK_LDA(At, 0, 0); GK_STAGE(GK_SA(1, 1), a1, voffA[1]);
            GK_WAIT_V(8); GK_WAIT_L(0); GK_BAR; GK_MMA(0, 0, At, B0); GK_MMA(0, 1, At, B1); GK_BAR; GK_SCHED;
            GK_LDA(At, 0, 1); GK_STAGE(GK_SB(0, 0), b2, voffB[0]); GK_STAGE(GK_SB(0, 1), b2, voffB[1]); GK_STAGE(GK_SA(0, 0), a2, vA2[0]);
            GK_WAIT_V(8); GK_WAIT_L(0); GK_BAR; GK_MMA(1, 0, At, B0); GK_MMA(1, 1, At, B1); GK_BAR; GK_SCHED;
            GK_LDB(B0, 1, 0); GK_LDB(B1, 1, 1); GK_SCHED; GK_LDA(At, 1, 0); GK_STAGE(GK_SA(0, 1), a2, vA2[1]);
            GK_WAIT_V(8); GK_WAIT_L(0); GK_BAR; GK_MMA(0, 0, At, B0); GK_MMA(0, 1, At, B1); GK_BAR; GK_SCHED;
            GK_LDA(At, 1, 1); GK_STAGE(GK_SB(1, 0), b3, voffB[0]); GK_STAGE(GK_SB(1, 1), b3, voffB[1]); GK_STAGE(GK_SA(1, 0), a3, vA2[0]);
            GK_WAIT_V(8); GK_WAIT_L(0); GK_BAR; GK_MMA(1, 0, At, B0); GK_MMA(1, 1, At, B1); GK_BAR; GK_SCHED;
        }
        if (wr == 0) GK_BAR;
        E(acc, cur, wr, wc, fr, fq);
        if (!has_next) break;
#pragma unroll
        for (int a = 0; a < 2; ++a)
#pragma unroll
            for (int b = 0; b < 2; ++b)
#pragma unroll
                for (int m = 0; m < 4; ++m)
#pragma unroll
                    for (int n = 0; n < 2; ++n) acc[a][b][m][n] = (f32x4){0.f, 0.f, 0.f, 0.f};
        cur = nxt; cA = nA; cB = nB; ++ui;
        if constexpr (GATHER) {
#pragma unroll
            for (int h = 0; h < 2; ++h)
#pragma unroll
                for (int i = 0; i < 2; ++i) voffA[h][i] = voffN[h][i]; }
        if (wr == 1) GK_BAR;
    }
    GK_WAIT_V(0);
    GK_BAR;
#undef GK_SA
#undef GK_SB
#undef GK_STAGE
#undef GK_LDA
#undef GK_LDB
#undef GK_MMA
#undef GK_WAIT_V
#undef GK_WAIT_L
#undef GK_BAR
#undef GK_SCHED
#undef GK_GATHER
#undef GK_BP
}

struct GridOrder {
    int nM, nN, nwg, G, c, nt; long astep, bstep;
    __device__ void init(int nM_, int nN_, int K, int lda, int ldb, int G_, int c_) { nM = nM_; nN = nN_; nwg = nM * nN; G = G_; c = c_; nt = K / BK; astep = (long)BM * lda * 2; bstep = (long)BM * ldb * 2; }
    __device__ bool next(int i, Unit& u) const {
        const long L = (long)i * G + c; if (L >= nwg) return false;
        int wgid = (int)L; { const int q = nwg / 8, r = nwg % 8, xcd = wgid % 8, off = wgid / 8; wgid = (xcd < r ? xcd * (q + 1) : r * (q + 1) + (xcd - r) * q) + off; }
        const int WGM = 8, nig = WGM * nN, gid = wgid / nig, fm = gid * WGM, gsz = (nM - fm) < WGM ? (nM - fm) : WGM;
        u.pm = fm + ((wgid % nig) % gsz); u.pn = (wgid % nig) / gsz;
        u.aoff = u.pm * astep; u.boff = u.pn * bstep; u.nt = nt; u.nvalid = 256; u.rows = nullptr; u.bsplit = 1 << 30; u.bjump = 0; u.aux0 = 0; u.aux1 = 0;
        return true;
    }
};
}

struct Params { const float* in[26]; float* out; unsigned char* ws; };
enum { I_X = 0, I_N1G, I_WIN, I_LAMRE, I_LAMIM, I_LOGDT, I_BRE, I_BIM, I_CRE, I_CIM, I_SSMD, I_WGLU, I_BGLU, I_QG, I_KG, I_WPS, I_WPA, I_WOUT, I_N2G, I_WRG, I_BRG, I_WRE, I_BREX, I_WGATE, I_WUP, I_WDOWN };

using gk::Unit; using gk::epi_rows;
typedef f32x4 Acc[2][2][4][2];

struct EpiProj {
    bf16_t *UGS, *QH, *KH, *VH, *SGS, *SGA;
    __device__ __forceinline__ void operator()(const Acc& acc, const Unit& u, int wr, int wc, int fr, int fq) const {
        const int pn = u.pn, row0 = u.pm * 256;
        epi_rows(acc, wr, wc, fr, fq, [&](int rl, int cl, f32x4 v0, f32x4 v1) {
            const int row = row0 + rl, col = pn * 256 + cl, b = row >> 13, s = row & 8191;
            if (pn < 2) {
                const int g = col >> 4, ch0 = col & 15, chunk = s >> 5, t = s & 31;
                *(u32x4*)(UGS + ((size_t)(g * CROWS + b * NCH + chunk) * KU + 128 + t * 16 + ch0)) = pk8(v0, v1);
            } else if (pn < 8) {
                const int which = (pn - 2) >> 1, c = col - 512 - which * 512, h = c >> 6, d = c & 63;
                bf16_t* base = QH + (size_t)which * (16u << 20);
                *(u32x4*)(base + ((size_t)((b * NH + h) * SEQ + s) * HD + d)) = pk8(v0, v1);
            } else {
                const int which = pn >= 12, c = col - 2048 - which * 1024;
                f32x4 a, bb;
#pragma unroll
                for (int j = 0; j < 4; ++j) { a[j] = sigmoidf_(v0[j]); bb[j] = sigmoidf_(v1[j]); }
                *(u32x4*)(SGS + (size_t)which * (32u << 20) + (size_t)row * DM + c) = pk8(a, bb);
            }
        });
    }
};
struct EpiEloc {
    float* ELOC;
    __device__ __forceinline__ void operator()(const Acc& acc, const Unit& u, int wr, int wc, int fr, int fq) const {
        const int rowbase = u.aux0 * CROWS + u.pm * 256;
        epi_rows(acc, wr, wc, fr, fq, [&](int rl, int cl, f32x4 v0, f32x4 v1) {
            if (cl < 128) { float* d = ELOC + (size_t)(rowbase + rl) * 128 + cl; *(f32x4*)d = v0; *(f32x4*)(d + 4) = v1; }
        });
    }
};
struct EpiSsm {
    bf16_t* Z;
    __device__ __forceinline__ void operator()(const Acc& acc, const Unit& u, int wr, int wc, int fr, int fq) const {
        const int g = u.aux0, r0 = u.pm * 256, c0 = u.pn * 256;
        epi_rows(acc, wr, wc, fr, fq, [&](int rl, int cl, f32x4 v0, f32x4 v1) {
            const int col = c0 + cl, t = col >> 4, ch0 = col & 15; const size_t tok = (size_t)(r0 + rl) * CL + t;
            f32x4 a, bb;
#pragma unroll
            for (int j = 0; j < 4; ++j) { a[j] = gelu_tanh(v0[j]); bb[j] = gelu_tanh(v1[j]); }
            *(u32x4*)(Z + tok * SSMW + g * GC + ch0) = pk8(a, bb);
        });
    }
};
struct EpiGlu {
    const bf16_t* Z; const float* bias; bf16_t* OS;
    __device__ __forceinline__ void operator()(const Acc& acc, const Unit& u, int wr, int wc, int fr, int fq) const {
        const int r0 = u.pm * 256, c0 = u.pn * 256;
        epi_rows(acc, wr, wc, fr, fq, [&](int rl, int cl, f32x4 v0, f32x4 v1) {
            const size_t off = (size_t)(r0 + rl) * SSMW + c0 + cl;
            f32x4 z0, z1; unpk8(*(const u32x4*)(Z + off), z0, z1);
            const f32x4 b0 = *(const f32x4*)(bias + c0 + cl), b1 = *(const f32x4*)(bias + c0 + cl + 4);
            f32x4 a, bb;
#pragma unroll
            for (int j = 0; j < 4; ++j) { a[j] = z0[j] * sigmoidf_(v0[j] + b0[j]); bb[j] = z1[j] * sigmoidf_(v1[j] + b1[j]); }
            *(u32x4*)(OS + off) = pk8(a, bb);
        });
    }
};
template <bool ACCUM> struct EpiMerge {
    const bf16_t* SG; bf16_t* MG;
    __device__ __forceinline__ void operator()(const Acc& acc, const Unit& u, int wr, int wc, int fr, int fq) const {
        const int r0 = u.pm * 256, c0 = u.pn * 256;
        epi_rows(acc, wr, wc, fr, fq, [&](int rl, int cl, f32x4 v0, f32x4 v1) {
            const size_t off = (size_t)(r0 + rl) * DM + c0 + cl;
            f32x4 s0, s1; unpk8(*(const u32x4*)(SG + off), s0, s1);
            f32x4 a = s0 * v0, bb = s1 * v1;
            if (ACCUM) { f32x4 m0, m1; unpk8(*(const u32x4*)(MG + off), m0, m1); a += m0; bb += m1; }
            *(u32x4*)(MG + off) = pk8(a, bb);
        });
    }
};
struct EpiOut {
    const float* X; float* X1; bf16_t* X1B;
    __device__ __forceinline__ void operator()(const Acc& acc, const Unit& u, int wr, int wc, int fr, int fq) const {
        const int r0 = u.pm * 256, c0 = u.pn * 256;
        epi_rows(acc, wr, wc, fr, fq, [&](int rl, int cl, f32x4 v0, f32x4 v1) {
            const size_t off = (size_t)(r0 + rl) * DM + c0 + cl;
            const f32x4 a = *(const f32x4*)(X + off) + v0, bb = *(const f32x4*)(X + off + 4) + v1;
            *(f32x4*)(X1 + off) = a; *(f32x4*)(X1 + off + 4) = bb;
            *(u32x4*)(X1B + off) = pk8(a, bb);
        });
    }
};
struct EpiGU {
    const int* ELDST; const float* ELW; const float* ELR2; bf16_t* ACT; const LAS int* pairoff;
    __device__ __forceinline__ void operator()(const Acc& acc, const Unit& u, int wr, int wc, int fr, int fq) const {
        const int e = u.aux0, tile = u.pm;
#pragma unroll
        for (int ai = 0; ai < 2; ++ai)
#pragma unroll
            for (int m = 0; m < 4; ++m) {
                const int rl = ai * 128 + wr * 64 + m * 16 + fr;
                if (rl < u.nvalid) {
                    const size_t idx = (size_t)e * T + tile * 256 + rl;
                    const int dst = ELDST[idx]; const float w = ELW[idx], r2 = ELR2[idx];
                    const int p = dst >> 17, slot = (dst >> 16) & 1, rank = dst & 0xffff;
                    const size_t prow = (size_t)(pairoff[p] + rank);
                    f32x4 a[2];
#pragma unroll
                    for (int n = 0; n < 2; ++n)
#pragma unroll
                        for (int j = 0; j < 4; ++j) { const float gt = acc[ai][0][m][n][j] * r2, up = acc[ai][1][m][n][j] * r2; a[n][j] = gt * sigmoidf_(gt) * up * w; }
                    *(u32x4*)(ACT + prow * 256 + slot * 128 + wc * 32 + 8 * fq) = pk8(a[0], a[1]);
                }
            }
    }
};
struct EpiDN {
    const int* PLTOK; float* OUT;
    __device__ __forceinline__ void operator()(const Acc& acc, const Unit& u, int wr, int wc, int fr, int fq) const {
        const int p = u.aux0, tile = u.aux1, c0 = u.pn * 256, nv = u.nvalid;
        epi_rows(acc, wr, wc, fr, fq, [&](int rl, int cl, f32x4 v0, f32x4 v1) {
            if (rl < nv) {
                const int tok = PLTOK[(size_t)p * T + tile * 256 + rl];
                float* d = OUT + (size_t)tok * DM + c0 + cl;
                const f32x4 a = *(const f32x4*)d + v0, bb = *(const f32x4*)(d + 4) + v1;
                *(f32x4*)d = a; *(f32x4*)(d + 4) = bb;
            }
        });
    }
};

struct ElocOrder {
    int G, c;
    __device__ bool next(int i, Unit& u) const {
        const int L = i * G + c; if (L >= NG * 4) return false;
        const int g = L >> 2, pm = L & 3;
        u.pm = pm; u.pn = 0; u.aoff = ((long)(g * CROWS + pm * 256) * KU + 128) * 2; u.boff = (long)g * 128 * NTC * 2; u.nt = NTC / 64;
        u.nvalid = 256; u.rows = nullptr; u.bsplit = 1 << 30; u.bjump = 0; u.aux0 = g; u.aux1 = 0; return true;
    }
};
struct SsmOrder {
    int G, c;
    __device__ bool next(int i, Unit& u) const {
        const int L = i * G + c; if (L >= NG * 8) return false;
        const int g = L >> 3, pm = (L >> 1) & 3, pn = L & 1;
        u.pm = pm; u.pn = pn; u.aoff = (long)(g * CROWS + pm * 256) * KU * 2; u.boff = (long)(g * NTC + pn * 256) * KU * 2; u.nt = pn ? 10 : 6;
        u.nvalid = 256; u.rows = nullptr; u.bsplit = 1 << 30; u.bjump = 0; u.aux0 = g; u.aux1 = 0; return true;
    }
};
struct GUOrder {
    const LAS int* epre; const LAS int* ecnt; const int* ELTOK; int G, c;
    __device__ bool next(int i, Unit& u) const {
        const int L = i * G + c; if (L >= epre[NE]) return false;
        int e = 0; while (epre[e + 1] <= L) ++e;
        e = __builtin_amdgcn_readfirstlane(e);
        const int tile = L - __builtin_amdgcn_readfirstlane(epre[e]), cnt = __builtin_amdgcn_readfirstlane(ecnt[e]);
        u.pm = tile; u.pn = 0; u.aoff = 0; u.boff = (long)e * 256 * DM * 2; u.nt = DM / 64;
        u.nvalid = min(256, cnt - tile * 256); u.rows = ELTOK + (size_t)e * T + tile * 256; u.bsplit = 1 << 30; u.bjump = 0; u.aux0 = e; u.aux1 = 0; return true;
    }
};
struct DNOrder {
    const LAS int* ppre; const LAS int* pcnt; const LAS int* pairoff; int G, c;
    __device__ bool next(int i, Unit& u) const {
        const int L = i * G + c; if (L >= ppre[NPAIR]) return false;
        int p = 0; while (ppre[p + 1] <= L) ++p;
        p = __builtin_amdgcn_readfirstlane(p);
        const int loc = L - __builtin_amdgcn_readfirstlane(ppre[p]), tile = loc >> 2, pn = loc & 3, cnt = __builtin_amdgcn_readfirstlane(pcnt[p]), po = __builtin_amdgcn_readfirstlane(pairoff[p]);
        const int g = p / 28; int q = p % 28, lo = 0; while (q >= 7 - lo) { q -= 7 - lo; ++lo; } const int hi = lo + 1 + q;
        u.pm = 0; u.pn = pn; u.aoff = (long)(po + tile * 256) * 256 * 2; u.boff = ((long)pn * 256 * (NE * DE) + (g * 8 + lo) * DE) * 2; u.nt = 4;
        u.nvalid = min(256, cnt - tile * 256); u.rows = nullptr; u.bsplit = 2; u.bjump = (long)(hi - lo) * DE * 2 - 2 * 128; u.aux0 = p; u.aux1 = tile; return true;
    }
};

__device__ __forceinline__ void p0_transpose_item(const float* W, int N, const float* kscale, bf16_t* WT, int ldt, LAS float* scr, int item, int lane) {
    const int nblk = N / 32, kb = item / nblk, nb = item % nblk, k0 = 64 * kb, n0 = 32 * nb;
#pragma unroll 8
    for (int i = 0; i < 32; ++i) { const int kk = 2 * i + (lane >> 5); float v = W[(size_t)(k0 + kk) * N + n0 + (lane & 31)]; if (kscale) v *= kscale[k0 + kk]; scr[kk * 33 + (lane & 31)] = v; }
    asm volatile("s_waitcnt lgkmcnt(0)" ::: "memory");
    const int c = lane & 7;
#pragma unroll
    for (int j = 0; j < 4; ++j) { const int n = (lane >> 3) + 8 * j; const LAS float* s = scr + (8 * c) * 33 + n;
        u32x4 o; o.x = pk2(s[0 * 33], s[1 * 33]); o.y = pk2(s[2 * 33], s[3 * 33]); o.z = pk2(s[4 * 33], s[5 * 33]); o.w = pk2(s[6 * 33], s[7 * 33]);
        *(u32x4*)(WT + (size_t)(n0 + n) * ldt + k0 + 8 * c) = o; }
    asm volatile("s_waitcnt lgkmcnt(0)" ::: "memory");
}

__device__ __forceinline__ void p0_ssm_tables(const Params& P, LAS unsigned char* lds, int g, int part, int tid) {
    unsigned char* ws = P.ws;
    LAS double* xs = (LAS double*)lds;
    LAS double* ys = xs + 64;
    LAS float* cfr = (LAS float*)(ys + 64);
    LAS float* cfi = cfr + 64;
    LAS f32x2* AP = (LAS f32x2*)(cfi + 64);
    LAS f32x2* BB = AP + 33 * 64;
    LAS f32x2* CC = BB + 64 * 16;
    if (tid < 64) {
        const int n = tid;
        const double dt = exp((double)P.in[I_LOGDT][g]);
        const float lrf = fminf(P.in[I_LAMRE][g * NS + n], -1e-4f);
        const double lr = lrf, li = P.in[I_LAMIM][g * NS + n];
        const double x = lr * dt, y = li * dt, mag = exp(x), ar = mag * cos(y), ai = mag * sin(y);
        const double den = lr * lr + li * li, nr = ar - 1.0, ni = ai;
        xs[n] = x; ys[n] = y; cfr[n] = (float)((nr * lr + ni * li) / den); cfi[n] = (float)((ni * lr - nr * li) / den);
        const double m32 = exp(32.0 * x);
        if (part == 0) ((f32x2*)(ws + WS_A32))[g * NS + n] = (f32x2){(float)(m32 * cos(32.0 * y)), (float)(m32 * sin(32.0 * y))};
    }
    __syncthreads();
#pragma unroll 1
    for (int idx = tid; idx < 33 * 64; idx += 512) { const int tau = idx >> 6, n = idx & 63; const double m = exp(xs[n] * tau), a = ys[n] * tau; AP[idx] = (f32x2){(float)(m * cos(a)), (float)(m * sin(a))}; }
#pragma unroll 1
    for (int idx = tid; idx < 1024; idx += 512) {
        { const int n = idx >> 4; const float br = P.in[I_BRE][(size_t)g * 1024 + idx], bi = P.in[I_BIM][(size_t)g * 1024 + idx]; BB[idx] = (f32x2){cfr[n] * br - cfi[n] * bi, cfr[n] * bi + cfi[n] * br}; }
        CC[idx] = (f32x2){P.in[I_CRE][(size_t)g * 1024 + idx], P.in[I_CIM][(size_t)g * 1024 + idx]};
    }
    __syncthreads();
    float* KC = (float*)(ws + WS_KC) + (size_t)g * 32 * 256;
#pragma unroll 1
    for (int idx = part * 1024 + tid; idx < (part + 1) * 1024; idx += 512) {
        const int tau = idx >> 8, c = (idx >> 4) & 15, cp = idx & 15; float s = 0.f;
#pragma unroll 4
        for (int n = 0; n < 64; ++n) { const f32x2 cc = CC[c * 64 + n], ap = AP[tau * 64 + n], bb = BB[n * 16 + cp];
            const float xr = cc.x * ap.x - cc.y * ap.y, xi = cc.x * ap.y + cc.y * ap.x; s += xr * bb.x - xi * bb.y; }
        if (tau == 0 && c == cp) s += P.in[I_SSMD][g * GC + c];
        KC[idx] = s;
    }
    bf16_t* MO = (bf16_t*)(ws + WS_MOUT) + (size_t)g * NTC * 128;
#pragma unroll 1
    for (int idx = part * (NTC * 16) + tid; idx < (part + 1) * (NTC * 16); idx += 512) {
        const int row = idx >> 7, np = idx & 127, n = np & 63, t = row >> 4, c = row & 15;
        const f32x2 cc = CC[c * 64 + n], ap = AP[(t + 1) * 64 + n];
        const float zr = cc.x * ap.x - cc.y * ap.y, zi = cc.x * ap.y + cc.y * ap.x;
        MO[idx] = f2bf(np < 64 ? zr : -zi);
    }
    bf16_t* MIN = (bf16_t*)(ws + WS_MIN) + (size_t)g * 128 * NTC;
#pragma unroll 1
    for (int idx = part * (NTC * 16) + tid; idx < (part + 1) * (NTC * 16); idx += 512) {
        const int np = idx >> 9, k = idx & 511, n = np & 63, s = k >> 4, cp = k & 15;
        const f32x2 ap = AP[(31 - s) * 64 + n], bb = BB[n * 16 + cp];
        const float wr_ = ap.x * bb.x - ap.y * bb.y, wi_ = ap.x * bb.y + ap.y * bb.x;
        MIN[idx] = f2bf(np < 64 ? wr_ : wi_);
    }
    __syncthreads();
}

__device__ __forceinline__ void phase0(const Params& P, LAS unsigned char* lds, int G, const int tid) {
    unsigned char* ws = P.ws;
    const int lane = tid & 63, wid = __builtin_amdgcn_readfirstlane(tid >> 6), bid = blockIdx.x;
    for (int u = bid; u < NG * 8; u += G) p0_ssm_tables(P, lds, u >> 3, u & 7, tid);
    {
        LAS float* scr = (LAS float*)(lds + wid * 16384);
        const int gw = bid * 8 + wid, NGW = G * 8;
        constexpr int I_IN = 16 * 128, I_GLU = 8 * 16, I_P = 8 * 32, I_O = 16 * 32, I_E = 64 * NE;
        constexpr int NIT = I_IN + I_GLU + 2 * I_P + I_O + 3 * I_E;
        bf16_t* WGU = (bf16_t*)(ws + WS_WGU); bf16_t* WDN = (bf16_t*)(ws + WS_WDN);
        for (int it = gw; it < NIT; it += NGW) {
            int r = it;
            if (r < I_IN) { p0_transpose_item(P.in[I_WIN], NIN, nullptr, (bf16_t*)(ws + WS_WIN), DM, scr, r, lane); continue; } r -= I_IN;
            if (r < I_GLU) { p0_transpose_item(P.in[I_WGLU], SSMW, nullptr, (bf16_t*)(ws + WS_WGLU), SSMW, scr, r, lane); continue; } r -= I_GLU;
            if (r < I_P) { p0_transpose_item(P.in[I_WPS], DM, nullptr, (bf16_t*)(ws + WS_WPS), SSMW, scr, r, lane); continue; } r -= I_P;
            if (r < I_P) { p0_transpose_item(P.in[I_WPA], DM, nullptr, (bf16_t*)(ws + WS_WPA), SSMW, scr, r, lane); continue; } r -= I_P;
            if (r < I_O) { p0_transpose_item(P.in[I_WOUT], DM, nullptr, (bf16_t*)(ws + WS_WOUT), DM, scr, r, lane); continue; } r -= I_O;
            if (r < I_E) { const int e = r >> 6; p0_transpose_item(P.in[I_WGATE] + (size_t)e * DM * DE, DE, P.in[I_N2G], WGU + (size_t)e * 256 * DM, DM, scr, r & 63, lane); continue; } r -= I_E;
            if (r < I_E) { const int e = r >> 6; p0_transpose_item(P.in[I_WUP] + (size_t)e * DM * DE, DE, P.in[I_N2G], WGU + (size_t)(e * 256 + 128) * DM, DM, scr, r & 63, lane); continue; } r -= I_E;
            { const int e = r >> 6; p0_transpose_item(P.in[I_WDOWN] + (size_t)e * DE * DM, DM, nullptr, WDN + e * DE, NE * DE, scr, r & 63, lane); }
        }
    }
    {
        bf16_t* HI = (bf16_t*)(ws + WS_WRT); bf16_t* LO = HI + 48 * DM;
        for (int idx = bid * 512 + tid; idx < 48 * DM; idx += G * 512) {
            const int col = idx >> 10, k = idx & 1023;
            float v = 0.f;
            if (col < 4) v = P.in[I_WRG][k * 4 + col]; else if (col < 36) v = P.in[I_WRE][k * 32 + col - 4];
            v *= P.in[I_N2G][k];
            const bf16_t h = f2bf(v); HI[idx] = h; LO[idx] = f2bf(v - bf2f(h));
        }
    }
    {
        const int gw = bid * 8 + wid, NGW = G * 8;
        const f32x4* gp = (const f32x4*)P.in[I_N1G] + lane;
        f32x4 gv[4];
#pragma unroll
        for (int j = 0; j < 4; ++j) gv[j] = gp[64 * j];
        for (int m = gw; m < T; m += NGW) {
            const f32x4* xr = (const f32x4*)(P.in[I_X] + (size_t)m * DM) + lane;
            f32x4 v[4]; float s = 0.f;
#pragma unroll
            for (int j = 0; j < 4; ++j) { v[j] = xr[64 * j]; s += (v[j].x * v[j].x + v[j].y * v[j].y) + (v[j].z * v[j].z + v[j].w * v[j].w); }
            const float rs = 1.0f / sqrtf(wave_sum(s) * (1.f / DM) + EPS);
            u32x2* o8 = (u32x2*)((bf16_t*)(ws + WS_XN) + (size_t)m * DM) + lane;
#pragma unroll
            for (int j = 0; j < 4; ++j) { const f32x4 y = v[j] * rs * gv[j]; u32x2 w; w.x = pk2(y.x, y.y); w.y = pk2(y.z, y.w); o8[64 * j] = w; }
        }
    }
}

__device__ __forceinline__ void qkv_unit(const Params& P, LAS unsigned char* lds, int bh, int blk, int tid) {
    unsigned char* ws = P.ws;
    LAS float* kbuf = (LAS float*)lds;
    LAS float* part = kbuf + 256 * 65;
    LAS bf16_t* vbuf = (LAS bf16_t*)(part + 512);
    const size_t blkoff = ((size_t)bh * SEQ + blk * 256) * HD;
    {
        const bool isk = tid >= 256; const int r = tid & 255, pos = blk * 256 + r;
        bf16_t* rowp = (bf16_t*)(ws + (isk ? WS_KH : WS_QH)) + blkoff + (size_t)r * HD;
        const float* gn = P.in[isk ? I_KG : I_QG];
        float x[64]; float ss = 0.f;
#pragma unroll
        for (int c = 0; c < 8; ++c) { const u32x4 w = *(const u32x4*)(rowp + c * 8); f32x4 a, b; unpk8(w, a, b);
#pragma unroll
            for (int j = 0; j < 4; ++j) { x[c * 8 + j] = a[j]; x[c * 8 + 4 + j] = b[j]; ss += a[j] * a[j] + b[j] * b[j]; } }
        const float rs = 1.0f / sqrtf(ss * (1.f / HD) + EPS);
#pragma unroll
        for (int d = 0; d < 64; ++d) x[d] = x[d] * rs * gn[d];
        const float invf[8] = {1.0f, 0.1939227432012558f, 0.03760603070259094f, 0.007292664609849453f, 0.0014142135623842478f, 0.00027424818836152554f, 5.318296098266728e-05f, 1.0313386155758053e-05f};
#pragma unroll
        for (int i = 0; i < 8; ++i) { const float ang = (float)pos * invf[i]; const float cs = cosf(ang), sn = sinf(ang); const float x1 = x[i], x2 = x[i + 8]; x[i] = x1 * cs - x2 * sn; x[i + 8] = x2 * cs + x1 * sn; }
        if (isk) {
#pragma unroll
            for (int d = 0; d < 64; ++d) kbuf[r * 65 + d] = x[d];
        }
        const float osc = isk ? 1.0f : QSCALE;
#pragma unroll
        for (int c = 0; c < 8; ++c) { u32x4 w; w.x = pk2(x[c * 8] * osc, x[c * 8 + 1] * osc); w.y = pk2(x[c * 8 + 2] * osc, x[c * 8 + 3] * osc); w.z = pk2(x[c * 8 + 4] * osc, x[c * 8 + 5] * osc); w.w = pk2(x[c * 8 + 6] * osc, x[c * 8 + 7] * osc);
            *(u32x4*)(rowp + c * 8) = w; }
    }
    {
        const int r = tid >> 1, half = tid & 1;
        const bf16_t* vp = (const bf16_t*)(ws + WS_VT) + blkoff + (size_t)r * HD + half * 32;
        u32x4 w[4];
#pragma unroll
        for (int c = 0; c < 4; ++c) w[c] = *(const u32x4*)(vp + c * 8);
#pragma unroll
        for (int c = 0; c < 4; ++c) { const unsigned q[4] = {w[c].x, w[c].y, w[c].z, w[c].w};
#pragma unroll
            for (int j = 0; j < 4; ++j) { const int d = half * 32 + c * 8 + 2 * j; vbuf[d * 264 + r] = (bf16_t)(q[j] & 0xffffu); vbuf[(d + 1) * 264 + r] = (bf16_t)(q[j] >> 16); } }
    }
    __syncthreads();
    {
        const int d = tid & 63, pt = tid >> 6; float s = 0.f;
        for (int r = 0; r < 32; ++r) s += kbuf[(pt * 32 + r) * 65 + d];
        part[pt * 64 + d] = s;
    }
    {
        const int d = tid >> 3, seg = tid & 7;
        bf16_t* op = (bf16_t*)(ws + WS_VT) + blkoff + (size_t)d * 256 + seg * 32;
#pragma unroll
        for (int c = 0; c < 4; ++c) *(u32x4*)(op + c * 8) = *(const LAS u32x4*)(vbuf + d * 264 + seg * 32 + c * 8);
    }
    __syncthreads();
    if (tid < 64) { float s = 0.f;
#pragma unroll
        for (int pt = 0; pt < 8; ++pt) s += part[pt * 64 + tid];
        ((float*)(ws + WS_KMEAN))[((size_t)bh * NBLK + blk) * HD + tid] = s * (1.f / 256.f); }
    __syncthreads();
}

__device__ __forceinline__ void select_unit(const Params& P, LAS unsigned char* lds, int bh, int qb, int tid) {
    unsigned char* ws = P.ws;
    LAS float* km = (LAS float*)lds;
    LAS int* lc = (LAS int*)(km + 32 * 64);
    LAS int* lb = lc + 32;
    LAS float* cs = (LAS float*)(lb + 32);
    LAS int* ci = (LAS int*)(cs + 768);
    for (int i = tid; i < qb * 64; i += 512) km[i] = ((const float*)(ws + WS_KMEAN))[(size_t)bh * NBLK * HD + i];
    if (tid < 32) lc[tid] = 0;
    __syncthreads();
    int sj[3] = {0, 0, 0}, srank[3] = {0, 0, 0};
    const int nsel = qb < 3 ? qb : 3;
    const int qr = tid & 255, par = tid >> 8;
    float b0 = -INFINITY, b1 = -INFINITY, b2 = -INFINITY; int i0 = 1 << 20, i1 = 1 << 20, i2 = 1 << 20;
    {
        const bf16_t* qp = (const bf16_t*)(ws + WS_QH) + ((size_t)bh * SEQ + qb * 256 + qr) * HD;
        float q[64];
#pragma unroll
        for (int c = 0; c < 8; ++c) { f32x4 a, b; unpk8(*(const u32x4*)(qp + c * 8), a, b);
#pragma unroll
            for (int j = 0; j < 4; ++j) { q[c * 8 + j] = a[j]; q[c * 8 + 4 + j] = b[j]; } }
        for (int j = par; j < qb; j += 2) {
            const LAS f32x4* kr = (const LAS f32x4*)(km + j * 64);
            float s = 0.f;
#pragma unroll
            for (int d = 0; d < 16; ++d) { const f32x4 kv = kr[d]; s += q[4 * d] * kv.x + q[4 * d + 1] * kv.y + q[4 * d + 2] * kv.z + q[4 * d + 3] * kv.w; }
            if (s > b0) { b2 = b1; i2 = i1; b1 = b0; i1 = i0; b0 = s; i0 = j; }
            else if (s > b1) { b2 = b1; i2 = i1; b1 = s; i1 = j; }
            else if (s > b2) { b2 = s; i2 = j; }
        }
    }
    if (par == 1) { cs[qr * 3] = b0; cs[qr * 3 + 1] = b1; cs[qr * 3 + 2] = b2; ci[qr * 3] = i0; ci[qr * 3 + 1] = i1; ci[qr * 3 + 2] = i2; }
    __syncthreads();
    if (par == 0) {
#pragma unroll
        for (int k = 0; k < 3; ++k) {
            const float s = cs[qr * 3 + k]; const int j = ci[qr * 3 + k];
            if (s > b0 || (s == b0 && j < i0)) { b2 = b1; i2 = i1; b1 = b0; i1 = i0; b0 = s; i0 = j; }
            else if (s > b1 || (s == b1 && j < i1)) { b2 = b1; i2 = i1; b1 = s; i1 = j; }
            else if (s > b2 || (s == b2 && j < i2)) { b2 = s; i2 = j; }
        }
        sj[0] = i0; sj[1] = i1; sj[2] = i2;
#pragma unroll
        for (int s = 0; s < 3; ++s) if (s < nsel) srank[s] = atomicAdd((int*)&lc[sj[s]], 1);
    }
    __syncthreads();
    if (tid < qb) lb[tid] = atomicAdd((int*)(ws + WS_CTL) + CW_LCNT + bh * NBLK + tid, lc[tid]);
    __syncthreads();
    if (par == 0) {
        unsigned short* lists = (unsigned short*)(ws + WS_LISTS);
#pragma unroll
        for (int s = 0; s < 3; ++s) if (s < nsel) lists[(size_t)(bh * NBLK + sj[s]) * SEQ + lb[sj[s]] + srank[s]] = (unsigned short)((qb * 256 + qr) | (s << 13));
    }
    __syncthreads();
}

__device__ __forceinline__ void tg_expand(const Params& P, int G, const int tid) {
    unsigned char* ws = P.ws;
    const float* KC = (const float*)(ws + WS_KC); bf16_t* TG = (bf16_t*)(ws + WS_TG);
    for (int idx = blockIdx.x * 512 + tid; idx < NG * NTC * CL; idx += G * 512) {
        const int s = idx & 31, row = (idx >> 5) & 511, g = idx >> 14, t = row >> 4, c = row & 15;
        u32x4 w0 = {0u, 0u, 0u, 0u}, w1 = {0u, 0u, 0u, 0u};
        if (s <= t) { const f32x4* kp = (const f32x4*)(KC + ((size_t)(g * 32 + (t - s)) * 16 + c) * 16); w0 = pk8(kp[0], kp[1]); w1 = pk8(kp[2], kp[3]); }
        bf16_t* d = TG + ((size_t)(g * NTC + row)) * KU + 128 + s * 16;
        *(u32x4*)d = w0; *(u32x4*)(d + 8) = w1;
        if (s < 16) *(u32x4*)(TG + ((size_t)(g * NTC + row)) * KU + s * 8) = *(const u32x4*)((const bf16_t*)(ws + WS_MOUT) + ((size_t)(g * NTC + row)) * 128 + s * 8);
    }
}

__device__ __forceinline__ void carry_scan(const Params& P, LAS unsigned char* lds, int vb, int tid) {
    unsigned char* ws = P.ws;
    LAS f32x2* tot = (LAS f32x2*)lds;
    const int pair = vb >> 1, g = pair >> 2, b = pair & 3, nl = tid & 31, n = (vb & 1) * 32 + nl, seg = tid >> 5;
    const f32x2 a = ((const f32x2*)(ws + WS_A32))[g * NS + n];
    const float* EL = (const float*)(ws + WS_ELOC) + ((size_t)(g * CROWS + b * NCH + seg * 16)) * 128;
    float er[16], ei[16];
#pragma unroll
    for (int i = 0; i < 16; ++i) { er[i] = EL[(size_t)i * 128 + n]; ei[i] = EL[(size_t)i * 128 + 64 + n]; }
    float pr[16], pi[16]; float sr = 0.f, si = 0.f;
#pragma unroll
    for (int i = 0; i < 16; ++i) { pr[i] = sr; pi[i] = si; const float tr = a.x * sr - a.y * si + er[i], ti = a.x * si + a.y * sr + ei[i]; sr = tr; si = ti; }
    tot[seg * 32 + nl] = (f32x2){sr, si};
    __syncthreads();
    f32x2 a16 = a;
#pragma unroll
    for (int k = 0; k < 4; ++k) a16 = (f32x2){a16.x * a16.x - a16.y * a16.y, 2.f * a16.x * a16.y};
    float cr = 0.f, ci = 0.f;
    for (int j = 0; j < seg; ++j) { const f32x2 tj = tot[j * 32 + nl]; const float tr = a16.x * cr - a16.y * ci + tj.x, ti = a16.x * ci + a16.y * cr + tj.y; cr = tr; ci = ti; }
    bf16_t* U = (bf16_t*)(ws + WS_UGS) + ((size_t)(g * CROWS + b * NCH + seg * 16)) * KU;
#pragma unroll
    for (int i = 0; i < 16; ++i) {
        U[(size_t)i * KU + n] = f2bf(cr + pr[i]); U[(size_t)i * KU + 64 + n] = f2bf(ci + pi[i]);
        const float tr = a.x * cr - a.y * ci, ti = a.x * ci + a.y * cr; cr = tr; ci = ti;
    }
    __syncthreads();
}

__device__ __forceinline__ int crow(int r, int hi) { return (r & 3) + 8 * (r >> 2) + 4 * hi; }
template <bool DIAG>
__device__ __forceinline__ void attn_unit(const Params& P, LAS unsigned char* lds, int bh, int j, int row0, int nrows, int tid) {
    unsigned char* ws = P.ws;
    LAS unsigned char* Ks = lds;
    LAS unsigned char* Vs = lds + 36864;
    const size_t blkoff = ((size_t)bh * SEQ + j * 256) * HD;
    {
        const u32x4* ksrc = (const u32x4*)((const bf16_t*)(ws + WS_KH) + blkoff);
        const u32x4* vsrc = (const u32x4*)((const bf16_t*)(ws + WS_VT) + blkoff);
        u32x4 kw[4], vw[4];
#pragma unroll
        for (int i = 0; i < 4; ++i) { kw[i] = ksrc[tid + 512 * i]; vw[i] = vsrc[tid + 512 * i]; }
#pragma unroll
        for (int i = 0; i < 4; ++i) { const int p = tid + 512 * i; *(LAS u32x4*)(Ks + (p >> 3) * 144 + (p & 7) * 16) = kw[i];
            LAS u32x2* dv = (LAS u32x2*)(Vs + (p >> 5) * 520 + (p & 31) * 16); dv[0] = (u32x2){vw[i].x, vw[i].y}; dv[1] = (u32x2){vw[i].z, vw[i].w}; }
    }
    __syncthreads();
    const int lane = tid & 63, wid = __builtin_amdgcn_readfirstlane(tid >> 6), r32 = lane & 31, hi = lane >> 5;
    const int rq = wid * 32 + r32; const bool valid = rq < nrows;
    int spos, slot;
    if (DIAG) { spos = j * 256 + rq; slot = 3; }
    else { const unsigned e = valid ? ((const unsigned short*)(ws + WS_LISTS))[(size_t)(bh * NBLK + j) * SEQ + row0 + rq] : 0u; spos = e & 0x1fff; slot = e >> 13; }
    bf16x8 qf[4];
    { const bf16_t* qp = (const bf16_t*)(ws + WS_QH) + ((size_t)bh * SEQ + spos) * HD + hi * 8;
#pragma unroll
      for (int d0 = 0; d0 < 4; ++d0) qf[d0] = *(const bf16x8*)(qp + d0 * 16); }
    f32x16 st[8];
#pragma unroll
    for (int kt = 0; kt < 8; ++kt) {
#pragma unroll
        for (int r = 0; r < 16; ++r) st[kt][r] = 0.f;
        if (!DIAG || kt <= wid) {
#pragma unroll
            for (int d0 = 0; d0 < 4; ++d0) { const bf16x8 kf = *(const LAS bf16x8*)(Ks + (kt * 32 + r32) * 144 + (d0 * 2 + hi) * 16); st[kt] = __builtin_amdgcn_mfma_f32_32x32x16_bf16(kf, qf[d0], st[kt], 0, 0, 0); }
        }
    }
    float m = -INFINITY;
#pragma unroll
    for (int kt = 0; kt < 8; ++kt) {
        if (!DIAG || kt <= wid) {
            if (DIAG && kt == wid) {
#pragma unroll
                for (int r = 0; r < 16; ++r) if (kt * 32 + crow(r, hi) > rq) st[kt][r] = -INFINITY;
            }
#pragma unroll
            for (int r = 0; r < 16; ++r) m = fmaxf(m, st[kt][r]);
        }
    }
    m = fmaxf(m, shx(m, 32, lane));
    float l = 0.f;
#pragma unroll
    for (int kt = 0; kt < 8; ++kt) {
        if (!DIAG || kt <= wid) {
#pragma unroll
            for (int r = 0; r < 16; ++r) { const float p = __builtin_amdgcn_exp2f(st[kt][r] - m); st[kt][r] = p; l += p; }
        }
    }
    l += shx(l, 32, lane);
    f32x16 ot[2];
#pragma unroll
    for (int r = 0; r < 16; ++r) { ot[0][r] = 0.f; ot[1][r] = 0.f; }
#pragma unroll
    for (int kt = 0; kt < 8; ++kt) {
        if (!DIAG || kt <= wid) {
#pragma unroll
            for (int s2 = 0; s2 < 2; ++s2) {
                u32x4 pw; pw.x = pk2(st[kt][8 * s2 + 0], st[kt][8 * s2 + 1]); pw.y = pk2(st[kt][8 * s2 + 2], st[kt][8 * s2 + 3]); pw.z = pk2(st[kt][8 * s2 + 4], st[kt][8 * s2 + 5]); pw.w = pk2(st[kt][8 * s2 + 6], st[kt][8 * s2 + 7]);
                const bf16x8 pf = __builtin_bit_cast(bf16x8, pw);
#pragma unroll
                for (int dt = 0; dt < 2; ++dt) {
                    const LAS unsigned char* vb = Vs + (dt * 32 + r32) * 520 + (kt * 32 + s2 * 16 + 4 * hi) * 2;
                    const u32x2 lo = *(const LAS u32x2*)vb, hh = *(const LAS u32x2*)(vb + 16);
                    const u32x4 vw = {lo.x, lo.y, hh.x, hh.y};
                    ot[dt] = __builtin_amdgcn_mfma_f32_32x32x16_bf16(__builtin_bit_cast(bf16x8, vw), pf, ot[dt], 0, 0, 0);
                }
            }
        }
    }
    if (valid) {
        const size_t prow = ((size_t)((bh >> 3) * SEQ + spos) * NH + (bh & 7)) * 4 + slot;
        const float inv = 1.0f / l;
        bf16_t* po = (bf16_t*)P.out + prow * HD + 4 * hi;
#pragma unroll
        for (int dt = 0; dt < 2; ++dt)
#pragma unroll
            for (int g4 = 0; g4 < 4; ++g4) { u32x2 w; w.x = pk2(ot[dt][4 * g4] * inv, ot[dt][4 * g4 + 1] * inv); w.y = pk2(ot[dt][4 * g4 + 2] * inv, ot[dt][4 * g4 + 3] * inv);
                *(u32x2*)(po + dt * 32 + g4 * 8) = w; }
        if (hi == 0) ((f32x2*)(ws + WS_PML))[prow] = (f32x2){m, l};
    }
    __syncthreads();
}

template <class F> __device__ __forceinline__ void block_prefix_1024(LAS int* pre, LAS int* wt, int tid, const F& val) {
    const int lane = tid & 63, wid = tid >> 6;
    const int a = val(2 * tid), b = val(2 * tid + 1), s = a + b;
    int inc = s;
#pragma unroll
    for (int o = 1; o < 64; o <<= 1) { const int v = shup(inc, o, lane); if (lane >= o) inc += v; }
    if (lane == 63) wt[wid] = inc;
    __syncthreads();
    int woff = 0;
    for (int w = 0; w < wid; ++w) woff += wt[w];
    const int ex = inc - s + woff;
    pre[2 * tid] = ex; pre[2 * tid + 1] = ex + a;
    if (tid == 511) pre[1024] = ex + s;
    __syncthreads();
}

__device__ __forceinline__ void attn_phase(const Params& P, LAS unsigned char* lds, int G, const int tid) {
    LAS int* pre = (LAS int*)(lds + MISC_OFF);
    LAS int* wt = pre + 1032;
    const int* lcnt = (const int*)(P.ws + WS_CTL) + CW_LCNT;
    block_prefix_1024(pre, wt, tid, [&](int i) { return (lcnt[i] + 255) >> 8; });
    const int total = pre[1024], nunits = total + NBH * NBLK;
    for (int u = blockIdx.x; u < nunits; u += G) {
        if (u < total) {
            int lo = 0, hi = 1023;
            while (lo < hi) { const int mid = (lo + hi + 1) >> 1; if (pre[mid] <= u) lo = mid; else hi = mid - 1; }
            const int L = __builtin_amdgcn_readfirstlane(lo), tile = u - __builtin_amdgcn_readfirstlane(pre[L]);
            const int cnt = __builtin_amdgcn_readfirstlane(lcnt[L]);
            attn_unit<false>(P, lds, L >> 5, L & 31, tile * 256, min(256, cnt - tile * 256), tid);
        } else {
            const int d = u - total;
            attn_unit<true>(P, lds, d >> 5, d & 31, 0, 256, tid);
        }
    }
}

__device__ __forceinline__ void combine_phase(const Params& P, int G, const int tid) {
    unsigned char* ws = P.ws;
    const f32x2* PML = (const f32x2*)(ws + WS_PML); const bf16_t* PO = (const bf16_t*)P.out; bf16_t* ATT = (bf16_t*)(ws + WS_ATT);
    for (int idx = blockIdx.x * 512 + tid; idx < T * NH * 4; idx += G * 512) {
        const int qd = idx & 3, th = idx >> 2, token = th >> 3, head = th & 7, qblk = (token & (SEQ - 1)) >> 8, nv = qblk < 3 ? qblk : 3;
        float mm[4], ll[4]; float M = -INFINITY;
#pragma unroll
        for (int s = 0; s < 4; ++s) { const bool v = (s < nv) || (s == 3); f32x2 ml = {-INFINITY, 0.f}; if (v) ml = PML[(size_t)th * 4 + s]; mm[s] = ml.x; ll[s] = ml.y; M = fmaxf(M, ml.x); }
        float o[16];
#pragma unroll
        for (int i = 0; i < 16; ++i) o[i] = 0.f;
        float W = 0.f;
#pragma unroll
        for (int s = 0; s < 4; ++s) {
            const bool v = (s < nv) || (s == 3);
            if (v) {
                const float w = ll[s] * __builtin_amdgcn_exp2f(mm[s] - M); W += w;
                const u32x4* pp = (const u32x4*)(PO + ((size_t)th * 4 + s) * HD + qd * 16);
                f32x4 a, b, c, d; unpk8(pp[0], a, b); unpk8(pp[1], c, d);
#pragma unroll
                for (int i = 0; i < 4; ++i) { o[i] += w * a[i]; o[4 + i] += w * b[i]; o[8 + i] += w * c[i]; o[12 + i] += w * d[i]; }
            }
        }
        const float inv = 1.0f / W;
        u32x4 w0, w1;
        w0.x = pk2(o[0] * inv, o[1] * inv); w0.y = pk2(o[2] * inv, o[3] * inv); w0.z = pk2(o[4] * inv, o[5] * inv); w0.w = pk2(o[6] * inv, o[7] * inv);
        w1.x = pk2(o[8] * inv, o[9] * inv); w1.y = pk2(o[10] * inv, o[11] * inv); w1.z = pk2(o[12] * inv, o[13] * inv); w1.w = pk2(o[14] * inv, o[15] * inv);
        u32x4* dp = (u32x4*)(ATT + (size_t)token * SSMW + head * HD + qd * 16);
        dp[0] = w0; dp[1] = w1;
    }
}

__device__ __forceinline__ void route_phase(const Params& P, LAS unsigned char* lds, int G, const int tid) {
    unsigned char* ws = P.ws;
    const int lane = tid & 63, wid = __builtin_amdgcn_readfirstlane(tid >> 6), rr = lane & 15, kq = lane >> 4;
    LAS float* lg = (LAS float*)(lds + wid * 4096);
    LAS int* he = (LAS int*)(lds + MISC_OFF);
    LAS int* hp = he + 32;
    LAS int* be = hp + 112;
    LAS int* bp = be + 32;
    int* gcnt = (int*)(ws + WS_CTL);
    const bf16_t* HI = (const bf16_t*)(ws + WS_WRT); const bf16_t* LO = HI + 48 * DM;
    for (int base = 0; base < T / 16; base += G * 8) {
        const int tile = base + blockIdx.x * 8 + wid; const bool active = tile < T / 16;
        if (tid < 144) he[tid] = 0;
        __syncthreads();
        int E0 = 0, E1 = 0, pp = 0, sl0 = 0, re0 = 0, re1 = 0, rp = 0; float w0 = 0.f, w1 = 0.f, r2 = 0.f;
        if (active) {
            const float* xrow = P.out + (size_t)(tile * 16 + rr) * DM + kq * 8;
            f32x4 acc[3]; float ssq = 0.f;
#pragma unroll
            for (int ct = 0; ct < 3; ++ct) acc[ct] = (f32x4){0.f, 0.f, 0.f, 0.f};
#pragma unroll 4
            for (int ks = 0; ks < 32; ++ks) {
                const f32x4 a0 = *(const f32x4*)(xrow + ks * 32), a1 = *(const f32x4*)(xrow + ks * 32 + 4);
                ssq += (a0.x * a0.x + a0.y * a0.y) + (a0.z * a0.z + a0.w * a0.w) + (a1.x * a1.x + a1.y * a1.y) + (a1.z * a1.z + a1.w * a1.w);
                const u32x4 hw = pk8(a0, a1); f32x4 h0, h1; unpk8(hw, h0, h1); const u32x4 lw = pk8(a0 - h0, a1 - h1);
                const bf16x8 ah = __builtin_bit_cast(bf16x8, hw), al = __builtin_bit_cast(bf16x8, lw);
#pragma unroll
                for (int ct = 0; ct < 3; ++ct) {
                    const bf16_t* bpw = HI + (size_t)(ct * 16 + rr) * DM + ks * 32 + kq * 8;
                    const bf16x8 bh = *(const bf16x8*)bpw, bl = *(const bf16x8*)(bpw + 48 * DM);
                    acc[ct] = __builtin_amdgcn_mfma_f32_16x16x32_bf16(ah, bh, acc[ct], 0, 0, 0);
                    acc[ct] = __builtin_amdgcn_mfma_f32_16x16x32_bf16(ah, bl, acc[ct], 0, 0, 0);
                    acc[ct] = __builtin_amdgcn_mfma_f32_16x16x32_bf16(al, bh, acc[ct], 0, 0, 0);
                }
            }
            ssq += shx(ssq, 16, lane); ssq += shx(ssq, 32, lane);
#pragma unroll
            for (int ct = 0; ct < 3; ++ct)
#pragma unroll
                for (int rg = 0; rg < 4; ++rg) lg[(kq * 4 + rg) * 49 + ct * 16 + rr] = acc[ct][rg];
            asm volatile("s_waitcnt lgkmcnt(0)" ::: "memory"); __builtin_amdgcn_wave_barrier();
            if (lane < 16) {
                r2 = 1.0f / sqrtf(ssq * (1.f / DM) + EPS);
                const LAS float* row = lg + lane * 49;
                float gl[4]; int gi = 0; float gmax = -INFINITY;
#pragma unroll
                for (int c = 0; c < 4; ++c) { gl[c] = row[c] * r2 + P.in[I_BRG][c]; if (gl[c] > gmax) { gmax = gl[c]; gi = c; } }
                float den = 0.f;
#pragma unroll
                for (int c = 0; c < 4; ++c) den += __expf(gl[c] - gmax);
                const float gp = 1.0f / den;
                float ev[8];
#pragma unroll
                for (int e = 0; e < 8; ++e) ev[e] = row[4 + gi * 8 + e] * r2 + P.in[I_BREX][gi * 8 + e];
                int i0 = 0; float v0 = -INFINITY;
#pragma unroll
                for (int e = 0; e < 8; ++e) if (ev[e] > v0) { v0 = ev[e]; i0 = e; }
                int i1 = 0; float v1 = -INFINITY;
#pragma unroll
                for (int e = 0; e < 8; ++e) if (e != i0 && ev[e] > v1) { v1 = ev[e]; i1 = e; }
                const float tt = __expf(v1 - v0);
                w0 = gp / (1.0f + tt); w1 = gp * tt / (1.0f + tt);
                const int lo = i0 < i1 ? i0 : i1, hh = i0 < i1 ? i1 : i0;
                pp = gi * 28 + (lo * (15 - lo)) / 2 + (hh - lo - 1);
                sl0 = (i0 == lo) ? 0 : 1;
                E0 = gi * 8 + i0; E1 = gi * 8 + i1;
                re0 = atomicAdd((int*)&he[E0], 1); re1 = atomicAdd((int*)&he[E1], 1); rp = atomicAdd((int*)&hp[pp], 1);
            }
        }
        __syncthreads();
        if (tid < 144) { const int h = he[tid]; be[tid] = h ? atomicAdd(gcnt + (tid < 32 ? CW_ECNT + tid : CW_PCNT + tid - 32), h) : 0; }
        __syncthreads();
        if (active && lane < 16) {
            const int token = tile * 16 + lane;
            const int rankp = bp[pp] + rp;
            const size_t i0x = (size_t)E0 * T + be[E0] + re0, i1x = (size_t)E1 * T + be[E1] + re1;
            ((int*)(ws + WS_ELTOK))[i0x] = token; ((int*)(ws + WS_ELDST))[i0x] = (pp << 17) | (sl0 << 16) | rankp; ((float*)(ws + WS_ELW))[i0x] = w0; ((float*)(ws + WS_ELR2))[i0x] = r2;
            ((int*)(ws + WS_ELTOK))[i1x] = token; ((int*)(ws + WS_ELDST))[i1x] = (pp << 17) | ((1 - sl0) << 16) | rankp; ((float*)(ws + WS_ELW))[i1x] = w1; ((float*)(ws + WS_ELR2))[i1x] = r2;
            ((int*)(ws + WS_PLTOK))[(size_t)pp * T + rankp] = token;
        }
        __syncthreads();
    }
}

struct MoeTables { LAS int *ecnt, *epre, *pcnt, *ppre, *pairoff; };
__device__ __forceinline__ MoeTables moe_tables(const Params& P, LAS unsigned char* lds, int tid) {
    MoeTables M;
    M.ecnt = (LAS int*)(lds + MISC_OFF); M.epre = M.ecnt + 32; M.pcnt = M.epre + 40; M.ppre = M.pcnt + 112; M.pairoff = M.ppre + 120;
    const int* gcnt = (const int*)(P.ws + WS_CTL);
    if (tid < 32) M.ecnt[tid] = gcnt[CW_ECNT + tid];
    if (tid >= 64 && tid < 64 + NPAIR) M.pcnt[tid - 64] = gcnt[CW_PCNT + tid - 64];
    __syncthreads();
    if (tid == 0) { int s = 0; for (int e = 0; e < NE; ++e) { M.epre[e] = s; s += (M.ecnt[e] + 255) >> 8; } M.epre[NE] = s; }
    if (tid == 64) { int s = 0, r = 0; for (int p = 0; p < NPAIR; ++p) { M.ppre[p] = s; M.pairoff[p] = r; const int tl = (M.pcnt[p] + 255) >> 8; s += tl * 4; r += tl * 256; } M.ppre[NPAIR] = s; M.pairoff[NPAIR] = r; }
    __syncthreads();
    return M;
}


constexpr int CW_BAR = 8192;
#define XB_TMO      128
#define XB_XCNT(j)  (256  + 64 * (j))
#define XB_XSUB(j)  (1280 + 64 * (j))
#define XB_XGEN(j)  (2304 + 64 * (j))
#define XB_TOP      3328
#define XB_TOPGEN   3392
#define XCD_BAR_WORDS 3456
#define XB_SPIN_CAP (1u << 18)
__device__ __forceinline__ unsigned xb_ld(unsigned* p)              { return __hip_atomic_load(p, __ATOMIC_RELAXED, __HIP_MEMORY_SCOPE_AGENT); }
__device__ __forceinline__ unsigned xb_add(unsigned* p, unsigned v) { return __hip_atomic_fetch_add(p, v, __ATOMIC_RELAXED, __HIP_MEMORY_SCOPE_AGENT); }
__device__ __forceinline__ unsigned xb_xcc_id() { return (unsigned)__builtin_amdgcn_s_getreg((3 << 11) | 20) & 0xFu; }
#define XB_SPIN(cond, bar) do { unsigned _sp = 0; while (cond) { __builtin_amdgcn_s_sleep(1); \
    if ((++_sp & 255u) == 0u) { if (xb_ld(&(bar)[XB_TMO])) break; if (_sp > XB_SPIN_CAP) { atomicAdd(&(bar)[XB_TMO], 1u); break; } } } } while (0)
struct XcdBarrier { unsigned* bar; unsigned x; volatile LAS unsigned* st; };
__device__ __forceinline__ XcdBarrier xcd_barrier_post(unsigned* bar, volatile LAS unsigned* st) {
    XcdBarrier b; b.bar = bar; b.x = xb_xcc_id(); b.st = st;
    if (threadIdx.x == 0) (void)xb_add(&bar[XB_XCNT(b.x)], 1u);
    return b;
}
__device__ __forceinline__ void xcd_barrier_complete(unsigned* bar, unsigned x, unsigned& nloc, unsigned& nx) {
    const unsigned G = gridDim.x * gridDim.y * gridDim.z;
    unsigned sum, cnt, mine, sp = 0u;
    for (;;) {
        sum = 0u; cnt = 0u; mine = 0u;
#pragma unroll
        for (unsigned j = 0; j < 16; ++j) { const unsigned c = xb_ld(&bar[XB_XCNT(j)]); sum += c; cnt += (c > 0u) ? 1u : 0u; mine = (j == x) ? c : mine; }
        if (sum == G) break;
        __builtin_amdgcn_s_sleep(1);
        if ((++sp & 255u) == 0u) { if (xb_ld(&bar[XB_TMO])) break; if (sp > XB_SPIN_CAP) { atomicAdd(&bar[XB_TMO], 1u); break; } }
    }
    nloc = mine > 0u ? mine : 1u; nx = cnt > 0u ? cnt : 1u;
}
__device__ __forceinline__ void xcd_barrier(const XcdBarrier& b, const int tid) {
    asm volatile("s_waitcnt vmcnt(0)" ::: "memory");
    __syncthreads();
    if (tid == 0) {
        unsigned* bar = b.bar;
        __builtin_amdgcn_s_waitcnt(0);
        unsigned nloc = b.st[0], nx = b.st[1];
        if (nloc == 0u) { xcd_barrier_complete(bar, b.x, nloc, nx); b.st[0] = nloc; b.st[1] = nx; }
        const unsigned old = xb_add(&bar[XB_XSUB(b.x)], 1u);
        const unsigned gen = old / nloc;
        if (old + 1u == (gen + 1u) * nloc) {
            __builtin_amdgcn_fence(__ATOMIC_RELEASE, "agent");
            asm volatile("s_waitcnt vmcnt(0)" ::: "memory");
            const unsigned og = xb_add(&bar[XB_TOP], 1u);
            const unsigned tg = og / nx;
            if (og + 1u == (tg + 1u) * nx) xb_add(&bar[XB_TOPGEN], 1u);
            else XB_SPIN(xb_ld(&bar[XB_TOPGEN]) == tg, bar);
            __builtin_amdgcn_fence(__ATOMIC_ACQUIRE, "agent");
            xb_add(&bar[XB_XGEN(b.x)], 1u);
            asm volatile("s_waitcnt vmcnt(0)" ::: "memory");
        } else {
            XB_SPIN(xb_ld(&bar[XB_XGEN(b.x)]) == gen, bar);
            __builtin_amdgcn_fence(__ATOMIC_ACQUIRE, "agent");
            asm volatile("s_waitcnt vmcnt(0)" ::: "memory");
        }
    }
    __syncthreads();
}

#ifndef N_PHASES
#define N_PHASES 11
#endif
__global__ void __launch_bounds__(512, 2) hybrid_fwd(Params P) {
    extern __shared__ __attribute__((aligned(16))) unsigned char lds_raw[];
    LAS unsigned char* lds = (LAS unsigned char*)lds_raw;
    const int G = gridDim.x, c = blockIdx.x, wave = __builtin_amdgcn_readfirstlane(threadIdx.x >> 6);
#define FT fresh_tid(wave)
    volatile LAS unsigned* bst = (volatile LAS unsigned*)(lds + LDS_BYTES - 16);
    if (threadIdx.x == 0) { bst[0] = 0u; bst[1] = 0u; }
    __syncthreads();
    const XcdBarrier bar = xcd_barrier_post((unsigned*)(P.ws + WS_CTL) + CW_BAR, bst);
#define GRID_SYNC() xcd_barrier(bar, FT)
    unsigned char* ws = P.ws;
#define BF(off) ((bf16_t*)(ws + (off)))
    phase0(P, lds, G, FT);
    GRID_SYNC();
    { gk::GridOrder S; S.init(T / 256, NIN / 256, DM, DM, DM, G, c);
      EpiProj E{BF(WS_UGS), BF(WS_QH), BF(WS_KH), BF(WS_VT), BF(WS_SGS), BF(WS_SGA)};
      gk::gemm_phase<EpiProj, gk::GridOrder, false, false>(lds, FT, BF(WS_XN), DM, BF(WS_WIN), DM, S, E); }
    GRID_SYNC();
    for (int u = c; u < NBH * NBLK; u += G) qkv_unit(P, lds, u >> 5, u & 31, FT);
    { ElocOrder S{G, c}; EpiEloc E{(float*)(ws + WS_ELOC)};
      gk::gemm_phase<EpiEloc, ElocOrder, false, false>(lds, FT, BF(WS_UGS), KU, BF(WS_MIN), NTC, S, E); }
    GRID_SYNC();
    for (int u = c; u < NBH * NBLK; u += G) { const int qb = u & 31; if (qb > 0) select_unit(P, lds, u >> 5, qb, FT); }
    tg_expand(P, G, FT);
    for (int vb = c; vb < 256; vb += G) carry_scan(P, lds, vb, FT);
    GRID_SYNC();
    { SsmOrder S{G, c}; EpiSsm E{BF(WS_Z)};
      gk::gemm_phase<EpiSsm, SsmOrder, false, false>(lds, FT, BF(WS_UGS), KU, BF(WS_TG), KU, S, E); }
    attn_phase(P, lds, G, FT);
    GRID_SYNC();
    combine_phase(P, G, FT);
    { gk::GridOrder S; S.init(T / 256, SSMW / 256, SSMW, SSMW, SSMW, G, c);
      EpiGlu E{BF(WS_Z), P.in[I_BGLU], BF(WS_OS)};
      gk::gemm_phase<EpiGlu, gk::GridOrder, false, false>(lds, FT, BF(WS_Z), SSMW, BF(WS_WGLU), SSMW, S, E); }
    GRID_SYNC();
    { gk::GridOrder S; S.init(T / 256, DM / 256, SSMW, SSMW, SSMW, G, c);
      EpiMerge<false> Ea{BF(WS_SGS), BF(WS_MG)};
      gk::gemm_phase<EpiMerge<false>, gk::GridOrder, false, false>(lds, FT, BF(WS_OS), SSMW, BF(WS_WPS), SSMW, S, Ea);
      EpiMerge<true> Eb{BF(WS_SGA), BF(WS_MG)};
      gk::gemm_phase<EpiMerge<true>, gk::GridOrder, false, false>(lds, FT, BF(WS_ATT), SSMW, BF(WS_WPA), SSMW, S, Eb); }
    GRID_SYNC();
    { gk::GridOrder S; S.init(T / 256, DM / 256, DM, DM, DM, G, c);
      EpiOut E{P.in[I_X], P.out, BF(WS_X1B)};
      gk::gemm_phase<EpiOut, gk::GridOrder, false, false>(lds, FT, BF(WS_MG), DM, BF(WS_WOUT), DM, S, E); }
    GRID_SYNC();
    route_phase(P, lds, G, FT);
    GRID_SYNC();
    MoeTables M = moe_tables(P, lds, FT);
    { GUOrder S{M.epre, M.ecnt, (const int*)(ws + WS_ELTOK), G, c};
      EpiGU E{(const int*)(ws + WS_ELDST), (const float*)(ws + WS_ELW), (const float*)(ws + WS_ELR2), BF(WS_ACT), M.pairoff};
      gk::gemm_phase<EpiGU, GUOrder, true, false>(lds, FT, BF(WS_X1B), DM, BF(WS_WGU), DM, S, E); }
    GRID_SYNC();
    { DNOrder S{M.ppre, M.pcnt, M.pairoff, G, c};
      EpiDN E{(const int*)(ws + WS_PLTOK), P.out};
      gk::gemm_phase<EpiDN, DNOrder, false, true>(lds, FT, BF(WS_ACT), 256, BF(WS_WDN), NE * DE, S, E); }
#undef BF
#undef FT
#undef GRID_SYNC
}

extern "C" void kernel_launch(void* const* d_in, const int* in_sizes, int n_in, void* d_out, int out_size, void* d_ws, size_t ws_size, hipStream_t stream) {
    static int grid = 0;
    if (grid == 0) {
        if (n_in != 26 || in_sizes[0] != T * DM || out_size != T * DM || ws_size < WS_END) {
            fprintf(stderr, "kernel_launch: unexpected shapes (n_in %d, in0 %d, out %d, ws %zu)\n", n_in, n_in > 0 ? in_sizes[0] : -1, out_size, ws_size); grid = -1; return; }
        int dev = 0, cus = 0, per_cu = 0;
        (void)hipGetDevice(&dev);
        (void)hipDeviceGetAttribute(&cus, hipDeviceAttributeMultiprocessorCount, dev);
        (void)hipFuncSetAttribute((const void*)hybrid_fwd, hipFuncAttributeMaxDynamicSharedMemorySize, LDS_BYTES);
        (void)hipOccupancyMaxActiveBlocksPerMultiprocessor(&per_cu, (const void*)hybrid_fwd, 512, LDS_BYTES);
        if (per_cu < 1) { fprintf(stderr, "kernel_launch: occupancy query says %d blocks/CU\n", per_cu); grid = -1; return; }
        grid = cus * (per_cu > 1 ? 1 : per_cu);
        (void)hipGetLastError();
    }
    if (grid < 0) return;
    (void)hipMemsetAsync((char*)d_ws + WS_CTL, 0, 1 * MiB, stream);
    Params p{};
    for (int i = 0; i < 26; ++i) p.in[i] = (const float*)d_in[i];
    p.out = (float*)d_out; p.ws = (unsigned char*)d_ws;
    void* args[] = {&p};
    hipError_t e = hipLaunchCooperativeKernel((const void*)hybrid_fwd, dim3(grid), dim3(512), args, LDS_BYTES, stream);
    if (e != hipSuccess) fprintf(stderr, "cooperative launch failed: %s (grid %d)\n", hipGetErrorString(e), grid);
}
```

```cpp
#include <hip/hip_runtime.h>
#include <hip/hip_cooperative_groups.h>
#include <cstdio>
#include <cstdint>
namespace cg = cooperative_groups;

#define LAS __attribute__((address_space(3)))
typedef unsigned short bf16_t;
typedef short bf16x8 __attribute__((ext_vector_type(8)));
typedef float f32x2 __attribute__((ext_vector_type(2)));
typedef float f32x4 __attribute__((ext_vector_type(4)));
typedef float f32x16 __attribute__((ext_vector_type(16)));
typedef unsigned u32x2 __attribute__((ext_vector_type(2)));
typedef unsigned u32x4 __attribute__((ext_vector_type(4)));
typedef __bf16 bf16x2_t __attribute__((ext_vector_type(2)));

constexpr int NB = 4, SEQ = 8192, T = NB * SEQ, DM = 1024, NIN = 4096;
constexpr int NH = 8, HD = 64, NBH = NB * NH, NBLK = 32, BLK = 256;
constexpr int SSMW = 512, NG = 32, GC = 16, NS = 64;
constexpr int CL = 32, NCH = SEQ / CL, CROWS = NB * NCH  , KU = 128 + CL * GC  , NTC = CL * GC  ;
constexpr int NE = 32, DE = 128, NPAIR = 112;
constexpr float EPS = 1e-6f;
constexpr float QSCALE = 0.125f * 1.4426950408889634f;

constexpr size_t MiB = 1u << 20;
constexpr size_t WS_CTL = 0;
constexpr size_t WS_KMEAN = 1 * MiB;
constexpr size_t WS_A32 = WS_KMEAN + 256 * 1024;
constexpr size_t WS_WRT = WS_A32 + 64 * 1024;
constexpr size_t WS_ROPE = 1 * MiB + 512 * 1024;
constexpr size_t WS_KC = 2 * MiB;
constexpr size_t WS_MIN = 3 * MiB;
constexpr size_t WS_WIN = 8 * MiB;
constexpr size_t WS_WGLU = 16 * MiB;
constexpr size_t WS_WPS = 17 * MiB;
constexpr size_t WS_WPA = 18 * MiB;
constexpr size_t WS_WOUT = 19 * MiB;
constexpr size_t WS_WGU = 21 * MiB;
constexpr size_t WS_WDN = 37 * MiB;
constexpr size_t WS_MOUT = 46 * MiB;
constexpr size_t WS_A = 50 * MiB;
constexpr size_t WS_XN = 210 * MiB;
constexpr size_t WS_LISTS = WS_A;
constexpr size_t WS_TG = WS_A + 16 * MiB;
constexpr size_t WS_ELOC = WS_A + 40 * MiB;
constexpr size_t WS_ATT = WS_A;
constexpr size_t WS_OS = WS_A + 32 * MiB;
constexpr size_t WS_B = 114 * MiB;
constexpr size_t WS_QH = WS_B, WS_KH = WS_B + 32 * MiB, WS_VT = WS_B + 64 * MiB;
constexpr size_t WS_MG = WS_B;
constexpr size_t WS_ACT = WS_B;
constexpr size_t WS_ELTOK = WS_B + 64 * MiB;
constexpr size_t WS_ELDST = WS_B + 68 * MiB;
constexpr size_t WS_ELW = WS_B + 72 * MiB;
constexpr size_t WS_ELR2 = WS_B + 76 * MiB;
constexpr size_t WS_PLTOK = WS_B + 80 * MiB;
constexpr size_t WS_C = 210 * MiB;
constexpr size_t WS_TMP = WS_C + 64 * MiB;
constexpr size_t WS_X1B = WS_C;
constexpr size_t WS_X1L = WS_C + 64 * MiB;
constexpr size_t WS_UGS = 338 * MiB;
constexpr size_t WS_Z = 380 * MiB;
constexpr size_t WS_PML = 412 * MiB;
constexpr size_t WS_KPART = 412 * MiB;
constexpr size_t WS_END = 420 * MiB;
constexpr int CW_LCNT = 1024;
constexpr int CW_ECNT = 4096;
constexpr int CW_PCNT = 4224;

constexpr int RING_BYTES = 131072;
constexpr int MISC_OFF = RING_BYTES;
constexpr int LDS_BYTES = 147456;

__device__ __forceinline__ unsigned pk2(float lo, float hi) { f32x2 v = {lo, hi}; bf16x2_t b = __builtin_convertvector(v, bf16x2_t); return __builtin_bit_cast(unsigned, b); }
__device__ __forceinline__ bf16_t f2bf(float f) { return (bf16_t)(pk2(f, 0.f) & 0xffffu); }
__device__ __forceinline__ float bflo(unsigned w) { return __uint_as_float(w << 16); }
__device__ __forceinline__ float bfhi(unsigned w) { return __uint_as_float(w & 0xffff0000u); }
__device__ __forceinline__ float bf2f(bf16_t b) { return __uint_as_float(((unsigned)b) << 16); }
__device__ __forceinline__ u32x4 pk8(f32x4 a, f32x4 b) { u32x4 w; w.x = pk2(a[0], a[1]); w.y = pk2(a[2], a[3]); w.z = pk2(b[0], b[1]); w.w = pk2(b[2], b[3]); return w; }
__device__ __forceinline__ void unpk8(u32x4 w, f32x4& a, f32x4& b) { a = (f32x4){bflo(w.x), bfhi(w.x), bflo(w.y), bfhi(w.y)}; b = (f32x4){bflo(w.z), bfhi(w.z), bflo(w.w), bfhi(w.w)}; }
__device__ __forceinline__ float sigmoidf_(float x) { return 1.0f / (1.0f + __expf(-x)); }
__device__ __forceinline__ float gelu_tanh(float x) { const float u = 0.7978845608028654f * (x + 0.044715f * x * x * x); const float e = __expf(-2.0f * u); return x / (1.0f + e); }
__device__ __forceinline__ int lane_id() { unsigned z = 0u; asm volatile("" : "+v"(z)); return __builtin_amdgcn_mbcnt_hi(~0u, __builtin_amdgcn_mbcnt_lo(~0u, z)); }
__device__ __forceinline__ float shx(float v, int mask, int lane) { return __uint_as_float(__builtin_amdgcn_ds_bpermute((lane ^ mask) << 2, __float_as_uint(v))); }
__device__ __forceinline__ int shup(int v, int o, int lane) { return __builtin_amdgcn_ds_bpermute((lane - o) << 2, v); }
__device__ __forceinline__ int fresh_tid(int wave) { int t = wave * 64 + lane_id(); asm volatile("" : "+v"(t)); return t; }
__device__ __forceinline__ float wave_sum(float v) {
    const int lane = lane_id();
#pragma unroll
    for (int o = 1; o < 64; o <<= 1) v += shx(v, o, lane);
    return v;
}

namespace gk {
constexpr int BM = 256, BK = 64, HALF = 128, HTB = HALF * BK * 2, STAGE_BYTES = 8 * HTB;
__device__ __forceinline__ int lds_byte(int r, int c) { const int st = (r >> 4) * 2 + (c >> 5), rr = r & 15, cc = c & 31, ob = rr * 64 + cc * 2; return st * 1024 + (ob ^ (((ob >> 9) & 1) << 5)); }
__device__ __forceinline__ void stage_rc(int b, int& R, int& C) { const int st = b / 1024, sb = b % 1024, swz = sb ^ (((sb >> 9) & 1) << 5); R = (st >> 1) * 16 + swz / 64; C = (st & 1) * 32 + (swz % 64) / 2; }
__device__ __forceinline__ int perm32(int rho) { const int n = rho >> 4, i = rho & 15; return 8 * (i >> 2) + 4 * n + (i & 3); }

struct Unit {
    int pm, pn;
    long aoff, boff;
    int nt;
    int nvalid;
    const int* rows;
    int bsplit; long bjump;
    int aux0, aux1;
    int lda, ldb;
};

template <class F> __device__ __forceinline__ void epi_rows(const f32x4 (&acc)[2][2][4][2], int wr, int wc, int fr, int fq, const F& f) {
#pragma unroll
    for (int ai = 0; ai < 2; ++ai)
#pragma unroll
        for (int m = 0; m < 4; ++m) {
            const int rl = ai * HALF + wr * 64 + m * 16 + fr;
#pragma unroll
            for (int bj = 0; bj < 2; ++bj) f(rl, bj * HALF + wc * 32 + 8 * fq, acc[ai][bj][m][0], acc[ai][bj][m][1]);
        }
}

template <class L, class FL, class FC> __device__ __forceinline__ void epi_rows2(const f32x4 (&acc)[2][2][4][2], int wr, int wc, int fr, int fq, const FL& fl, const FC& fc) {
#pragma unroll
    for (int ai = 0; ai < 2; ++ai) {
        L pre[4][2];
#pragma unroll
        for (int m = 0; m < 4; ++m)
#pragma unroll
            for (int bj = 0; bj < 2; ++bj) pre[m][bj] = fl(ai * HALF + wr * 64 + m * 16 + fr, bj * HALF + wc * 32 + 8 * fq);
#pragma unroll
        for (int m = 0; m < 4; ++m)
#pragma unroll
            for (int bj = 0; bj < 2; ++bj) fc(ai * HALF + wr * 64 + m * 16 + fr, bj * HALF + wc * 32 + 8 * fq, acc[ai][bj][m][0], acc[ai][bj][m][1], pre[m][bj]);
    }
}

#ifndef PROBE_PID
#define PROBE_PID -1
#endif
template <class Epi, class Sched, bool GATHER, bool BSPLIT, bool VARLD = false, int PID = 0>
__device__ __forceinline__ void gemm_phase(LAS unsigned char* lds, const int tid, const bf16_t* A, int lda, const bf16_t* Bt, int ldb, const Sched& S, const Epi& E) {
    const int wid = __builtin_amdgcn_readfirstlane(tid >> 6), lane = tid & 63, wr = wid >> 2, wc = wid & 3, fr = lane & 15, fq = lane >> 4;
    int Rr[2], Cc[2];
    unsigned voffA[2][2], voffB[2][2], voffN[2][2], voffBn[2][2];
#pragma unroll
    for (int i = 0; i < 2; ++i) {
        stage_rc(tid * 16 + i * 8192, Rr[i], Cc[i]);
        const int Rb = (Rr[i] & ~31) + perm32(Rr[i] & 31);
#pragma unroll
        for (int h = 0; h < 2; ++h) {
            voffA[h][i] = (unsigned)((h * HALF + Rr[i]) * lda + Cc[i]) * 2u;
            voffB[h][i] = (unsigned)((h * HALF + Rb) * ldb + Cc[i]) * 2u;
            voffN[h][i] = voffA[h][i]; voffBn[h][i] = voffB[h][i];
        }
    }
    constexpr size_t kstep = (size_t)(BK * 2);
    const unsigned ldsw = (unsigned)wid * 1024u;
    const int aoff = lds_byte(wr * 64 + fr, fq * 8), boff = lds_byte(wc * 32 + fr, fq * 8);
#define GK_SA(b, h) (((b) * 2 + (h)) * HTB)
#define GK_SB(b, h) ((4 + (b) * 2 + (h)) * HTB)
#define GK_STAGE(bufoff, gbase, voff) do { _Pragma("unroll") for (int _i = 0; _i < 2; ++_i) \
        __builtin_amdgcn_global_load_lds((const unsigned*)((const char*)(gbase) + (voff)[_i]), (LAS unsigned*)(lds + (bufoff) + ldsw + _i * 8192), 16, 0, 0); } while (0)
#define GK_LDA(dst, b, h) do { _Pragma("unroll") for (int m = 0; m < 4; ++m) _Pragma("unroll") for (int k = 0; k < 2; ++k) dst[m][k] = *(const LAS bf16x8*)(lds + GK_SA(b, h) + aoff + m * 2048 + k * 1024); } while (0)
#define GK_LDB(dst, b, h) do { _Pragma("unroll") for (int n = 0; n < 2; ++n) _Pragma("unroll") for (int k = 0; k < 2; ++k) dst[n][k] = *(const LAS bf16x8*)(lds + GK_SB(b, h) + boff + n * 2048 + k * 1024); } while (0)
#define GK_MMA(ai, bj, At, Bt_) do { __builtin_amdgcn_s_setprio(1); _Pragma("unroll") for (int m = 0; m < 4; ++m) _Pragma("unroll") for (int n = 0; n < 2; ++n) _Pragma("unroll") for (int k = 0; k < 2; ++k) \
        acc[ai][bj][m][n] = __builtin_amdgcn_mfma_f32_16x16x32_bf16(Bt_[n][k], At[m][k], acc[ai][bj][m][n], 0, 0, 0); __builtin_amdgcn_s_setprio(0); } while (0)
#define GK_WAIT_V(n) asm volatile("s_waitcnt vmcnt(" #n ")" ::: "memory")
#define GK_WAIT_L(n) asm volatile("s_waitcnt lgkmcnt(" #n ")" ::: "memory")
#define GK_BAR __builtin_amdgcn_s_barrier()
#define GK_SCHED __builtin_amdgcn_sched_barrier(0)
#define GK_GATHER(u, vo) do { if constexpr (GATHER) { _Pragma("unroll") for (int _h = 0; _h < 2; ++_h) _Pragma("unroll") for (int _i = 0; _i < 2; ++_i) { \
        const int _r = _h * HALF + Rr[_i]; const int _t = (_r < (u).nvalid) ? (u).rows[_r] : 0; vo[_h][_i] = (unsigned)(_t * lda + Cc[_i]) * 2u; } } } while (0)
#define GK_VARLD(u, vA, vB) do { if constexpr (VARLD) { _Pragma("unroll") for (int _h = 0; _h < 2; ++_h) _Pragma("unroll") for (int _i = 0; _i < 2; ++_i) { \
        const int _rb = (Rr[_i] & ~31) + perm32(Rr[_i] & 31); vA[_h][_i] = (unsigned)((_h * HALF + Rr[_i]) * (u).lda + Cc[_i]) * 2u; vB[_h][_i] = (unsigned)((_h * HALF + _rb) * (u).ldb + Cc[_i]) * 2u; } } } while (0)
#define GK_BP(u, base, t) ((base) + (size_t)(t) * kstep + ((BSPLIT && (t) >= (u).bsplit) ? (u).bjump : 0l))
    Unit cur, nxt; int ui = 0;
    if (!S.next(0, cur)) return;
    f32x4 acc[2][2][4][2];
#pragma unroll
    for (int a = 0; a < 2; ++a)
#pragma unroll
        for (int b = 0; b < 2; ++b)
#pragma unroll
            for (int m = 0; m < 4; ++m)
#pragma unroll
                for (int n = 0; n < 2; ++n) acc[a][b][m][n] = (f32x4){0.f, 0.f, 0.f, 0.f};
    bf16x8 At[4][2], B0[2][2], B1[2][2];
    const char* cA = (const char*)A + cur.aoff; const char* cB = (const char*)Bt + cur.boff;
    GK_GATHER(cur, voffA); GK_VARLD(cur, voffA, voffB);
    GK_STAGE(GK_SB(0, 0), GK_BP(cur, cB, 0), voffB[0]); GK_STAGE(GK_SB(0, 1), GK_BP(cur, cB, 0), voffB[1]); GK_STAGE(GK_SA(0, 0), cA, voffA[0]); GK_STAGE(GK_SA(0, 1), cA, voffA[1]);
    if (wr == 1) GK_BAR;
    GK_WAIT_V(2); GK_BAR;
    GK_STAGE(GK_SB(1, 0), GK_BP(cur, cB, 1), voffB[0]); GK_STAGE(GK_SA(1, 0), cA + kstep, voffA[0]); GK_STAGE(GK_SB(1, 1), GK_BP(cur, cB, 1), voffB[1]);
    GK_WAIT_V(6); GK_BAR;
    for (;;) {
        const bool has_next = S.next(ui + 1, nxt);
        if (!has_next) nxt = cur;
        const char* nA = has_next ? (const char*)A + nxt.aoff : cA; const char* nB = has_next ? (const char*)Bt + nxt.boff : cB;
        if constexpr (GATHER) { if (has_next) { GK_GATHER(nxt, voffN); } else {
#pragma unroll
            for (int h = 0; h < 2; ++h)
#pragma unroll
                for (int i = 0; i < 2; ++i) voffN[h][i] = voffA[h][i]; } }
        const int nt = cur.nt;
        const bool lo_rows = cur.nvalid > wr * 64, hi_rows = cur.nvalid > HALF + wr * 64;
        for (int t = 0; t < nt; t += 2) {
            const bool last = (t == nt - 2);
            const char* a1 = cA + (size_t)(t + 1) * kstep;
            const char* a2 = last ? nA : cA + (size_t)(t + 2) * kstep; const char* a3 = a2 + kstep;
            const char* b2 = last ? GK_BP(nxt, nB, 0) : GK_BP(cur, cB, t + 2);
            const char* b3 = last ? GK_BP(nxt, nB, 1) : GK_BP(cur, cB, t + 3);
            unsigned vA2[2][2], vB2[2][2];
#pragma unroll
            for (int h = 0; h < 2; ++h)
#pragma unroll
                for (int i = 0; i < 2; ++i) { vA2[h][i] = (GATHER && last) ? voffN[h][i] : voffA[h][i]; vB2[h][i] = voffB[h][i]; }
            if constexpr (VARLD) { if (last) { GK_VARLD(nxt, vA2, vB2); } }
            GK_LDB(B0, 0, 0); GK_LDB(B1, 0, 1); GK_SCHED; GK_LDA(At, 0, 0); GK_STAGE(GK_SA(1, 1), a1, voffA[1]);
            GK_WAIT_V(8); GK_WAIT_L(0); GK_BAR; if (lo_rows) { GK_MMA(0, 0, At, B0); GK_MMA(0, 1, At, B1); } GK_BAR; GK_SCHED;
            GK_LDA(At, 0, 1); GK_STAGE(GK_SB(0, 0), b2, vB2[0]); GK_STAGE(GK_SB(0, 1), b2, vB2[1]); GK_STAGE(GK_SA(0, 0), a2, vA2[0]);
            GK_WAIT_V(8); GK_WAIT_L(0); GK_BAR; if (hi_rows) { GK_MMA(1, 0, At, B0); GK_MMA(1, 1, At, B1); } GK_BAR; GK_SCHED;
            GK_LDB(B0, 1, 0); GK_LDB(B1, 1, 1); GK_SCHED; GK_LDA(At, 1, 0); GK_STAGE(GK_SA(0, 1), a2, vA2[1]);
            GK_WAIT_V(8); GK_WAIT_L(0); GK_BAR; if (lo_rows) { GK_MMA(0, 0, At, B0); GK_MMA(0, 1, At, B1); } GK_BAR; GK_SCHED;
            GK_LDA(At, 1, 1); GK_STAGE(GK_SB(1, 0), b3, vB2[0]); GK_STAGE(GK_SB(1, 1), b3, vB2[1]); GK_STAGE(GK_SA(1, 0), a3, vA2[0]);
            GK_WAIT_V(8); GK_WAIT_L(0); GK_BAR; if (hi_rows) { GK_MMA(1, 0, At, B0); GK_MMA(1, 1, At, B1); } GK_BAR; GK_SCHED;
        }
        if (wr == 0) GK_BAR;
#ifdef PROBE_A
        unsigned long long te0_ = 0; if (PID == PROBE_PID) te0_ = __builtin_amdgcn_s_memrealtime();
#endif
        E(acc, cur, wr, wc, fr, fq);
#ifdef PROBE_A
        if (PID == PROBE_PID) { const unsigned long long te1_ = __builtin_amdgcn_s_memrealtime(); asm volatile("s_waitcnt vmcnt(0)" ::: "memory"); if (blockIdx.x == PROBE_BLK && tid == PROBE_TID) { LAS unsigned long long* t_ = (LAS unsigned long long*)(lds + MISC_OFF + 12288); t_[37] += te1_ - te0_; t_[39] += __builtin_amdgcn_s_memrealtime() - te1_; t_[38] += 100; } }
#endif
        if (!has_next) break;
#pragma unroll
        for (int a = 0; a < 2; ++a)
#pragma unroll
            for (int b = 0; b < 2; ++b)
#pragma unroll
                for (int m = 0; m < 4; ++m)
#pragma unroll
                    for (int n = 0; n < 2; ++n) acc[a][b][m][n] = (f32x4){0.f, 0.f, 0.f, 0.f};
        cur = nxt; cA = nA; cB = nB; ++ui;
        if constexpr (GATHER || VARLD) {
#pragma unroll
            for (int h = 0; h < 2; ++h)
#pragma unroll
                for (int i = 0; i < 2; ++i) { if constexpr (GATHER) voffA[h][i] = voffN[h][i]; } }
        if constexpr (VARLD) { GK_VARLD(cur, voffA, voffB); }
        if (wr == 1) GK_BAR;
    }
    GK_WAIT_V(0);
    GK_BAR;
#undef GK_SA
#undef GK_SB
#undef GK_STAGE
#undef GK_LDA
#undef GK_LDB
#undef GK_MMA
#undef GK_WAIT_V
#undef GK_WAIT_L
#undef GK_BAR
#undef GK_SCHED
#undef GK_GATHER
#undef GK_VARLD
#undef GK_BP
}

struct GridOrder {
    int nM, nN, nwg, G, c, nt; long astep, bstep;
    __device__ void init(int nM_, int nN_, int K, int lda, int ldb, int G_, int c_) { nM = nM_; nN = nN_; nwg = nM * nN; G = G_; c = c_; nt = K / BK; astep = (long)BM * lda * 2; bstep = (long)BM * ldb * 2; }
    __device__ bool next(int i, Unit& u) const {
        const long L = (long)i * G + c; if (L >= nwg) return false;
        int wgid = (int)L; { const int q = nwg / 8, r = nwg % 8, xcd = wgid % 8, off = wgid / 8; wgid = (xcd < r ? xcd * (q + 1) : r * (q + 1) + (xcd - r) * q) + off; }
        const int WGM = 8, nig = WGM * nN, gid = wgid / nig, fm = gid * WGM, gsz = (nM - fm) < WGM ? (nM - fm) : WGM;
        u.pm = fm + ((wgid % nig) % gsz); u.pn = (wgid % nig) / gsz;
        u.aoff = u.pm * astep; u.boff = u.pn * bstep; u.nt = nt; u.nvalid = 256; u.rows = nullptr; u.bsplit = 1 << 30; u.bjump = 0; u.aux0 = 0; u.aux1 = 0; u.lda = 0; u.ldb = 0;
        return true;
    }
};
}

struct Params { const float* in[26]; float* out; unsigned char* ws; };
enum { I_X = 0, I_N1G, I_WIN, I_LAMRE, I_LAMIM, I_LOGDT, I_BRE, I_BIM, I_CRE, I_CIM, I_SSMD, I_WGLU, I_BGLU, I_QG, I_KG, I_WPS, I_WPA, I_WOUT, I_N2G, I_WRG, I_BRG, I_WRE, I_BREX, I_WGATE, I_WUP, I_WDOWN };

using gk::Unit; using gk::epi_rows; using gk::epi_rows2;
struct Pre1 { u32x4 a; }; struct Pre2 { u32x4 a, b; }; struct PreF2 { f32x4 a, b; };
typedef f32x4 Acc[2][2][4][2];

struct EpiProj {
    bf16_t *UGS, *QH, *KH, *VT; const float *QG, *KG, *ROPE; float* KMEAN; LAS float* misc;
    __device__ __forceinline__ void operator()(const Acc& acc, const Unit& u, int wr, int wc, int fr_, int fq_) const {
        int fr = fr_, fq = fq_; asm volatile("" : "+v"(fr), "+v"(fq));
        if (u.aux0) {
            const int tok0 = u.pn * 256, b = tok0 >> 13, blk = (tok0 & 8191) >> 8;
            epi_rows(acc, wr, wc, fr, fq, [&](int rl, int cl, f32x4 v0, f32x4 v1) {
                const int dim = u.pm * 256 + rl, h = dim >> 6, d = dim & 63;
                *(u32x4*)(VT + ((size_t)((b * NH + h) * NBLK + blk) * HD + d) * 256 + cl) = pk8(v0, v1);
            });
            return;
        }
        const int pn = u.pn, row0 = u.pm * 256;
        if (pn < 2) {
            epi_rows(acc, wr, wc, fr, fq, [&](int rl, int cl, f32x4 v0, f32x4 v1) {
                const int row = row0 + rl, col = pn * 256 + cl, b = row >> 13, s = row & 8191;
                const int g = col >> 4, ch0 = col & 15, chunk = s >> 5, t = s & 31;
                *(u32x4*)(UGS + ((size_t)(g * CROWS + b * NCH + chunk) * KU + 128 + t * 16 + ch0)) = pk8(v0, v1);
            });
            return;
        }
        const int which = (pn - 2) >> 1, hd0 = ((pn - 2) & 1) * 4, lane = fq * 16 + fr, bidx = row0 >> 13, blk = (row0 & 8191) >> 8;
        const int dbase = 32 * (wc & 1) + 8 * fq;
        const float* gain = which ? KG : QG;
        const f32x4 g0 = *(const f32x4*)(gain + dbase), g1 = *(const f32x4*)(gain + dbase + 4);
        LAS float* sq = misc;
        LAS float* kss = misc + 2048;
        float ps[2][4][2];
#pragma unroll
        for (int ai = 0; ai < 2; ++ai)
#pragma unroll
            for (int m = 0; m < 4; ++m)
#pragma unroll
                for (int bj = 0; bj < 2; ++bj) {
                    const f32x4 v0 = acc[ai][bj][m][0], v1 = acc[ai][bj][m][1];
                    float p = (v0.x * v0.x + v0.y * v0.y) + (v0.z * v0.z + v0.w * v0.w) + (v1.x * v1.x + v1.y * v1.y) + (v1.z * v1.z + v1.w * v1.w);
                    p += shx(p, 16, lane); p += shx(p, 32, lane);
                    ps[ai][m][bj] = p;
                    if (fq == 0) sq[(wc * 256 + ai * 128 + wr * 64 + m * 16 + fr) * 2 + bj] = p;
                }
        asm volatile("s_waitcnt lgkmcnt(0)" ::: "memory"); __builtin_amdgcn_s_barrier(); asm volatile("" ::: "memory");
#pragma unroll
        for (int ai = 0; ai < 2; ++ai)
#pragma unroll
            for (int m = 0; m < 4; ++m)
#pragma unroll
                for (int bj = 0; bj < 2; ++bj) { const float tot = ps[ai][m][bj] + sq[((wc ^ 1) * 256 + ai * 128 + wr * 64 + m * 16 + fr) * 2 + bj]; ps[ai][m][bj] = 1.0f / sqrtf(tot * (1.f / HD) + EPS); }
        f32x4 ks[2][2];
#pragma unroll
        for (int bj = 0; bj < 2; ++bj) { ks[bj][0] = (f32x4){0.f, 0.f, 0.f, 0.f}; ks[bj][1] = (f32x4){0.f, 0.f, 0.f, 0.f}; }
        const bool ropew = (wc & 1) == 0;
        bf16_t* outb = QH + (size_t)which * (16u << 20);
#pragma unroll
        for (int ai = 0; ai < 2; ++ai)
#pragma unroll
            for (int m = 0; m < 4; ++m) {
                const int rl = ai * 128 + wr * 64 + m * 16 + fr, s = blk * 256 + rl;
                f32x4 c0 = {1.f, 1.f, 1.f, 1.f}, c1 = c0, s0 = {0.f, 0.f, 0.f, 0.f}, s1 = s0;
                if (ropew && fq < 2) { const f32x4* rt = (const f32x4*)(ROPE + (size_t)s * 16); c0 = rt[0]; c1 = rt[1]; s0 = rt[2]; s1 = rt[3]; if (fq == 0) { s0 = -s0; s1 = -s1; } }
#pragma unroll
                for (int bj = 0; bj < 2; ++bj) {
                    const float rs = ps[ai][m][bj];
                    f32x4 a = acc[ai][bj][m][0] * rs * g0, b = acc[ai][bj][m][1] * rs * g1;
                    if (ropew) {
                        f32x4 pa, pb;
#pragma unroll
                        for (int j = 0; j < 4; ++j) { pa[j] = shx(a[j], 16, lane); pb[j] = shx(b[j], 16, lane); }
                        a = a * c0 + pa * s0; b = b * c1 + pb * s1;
                    }
                    bf16_t* dst = outb + ((size_t)((bidx * NH + hd0 + 2 * bj + (wc >> 1)) * SEQ + s) * HD + dbase);
                    if (which) { ks[bj][0] += a; ks[bj][1] += b; *(u32x4*)dst = pk8(a, b); }
                    else *(u32x4*)dst = pk8(a * QSCALE, b * QSCALE);
                }
            }
        if (which) {
#pragma unroll
            for (int bj = 0; bj < 2; ++bj)
#pragma unroll
                for (int n = 0; n < 2; ++n)
#pragma unroll
                    for (int j = 0; j < 4; ++j) { float v = ks[bj][n][j]; v += shx(v, 1, lane); v += shx(v, 2, lane); v += shx(v, 4, lane); v += shx(v, 8, lane);
                        if (fr == 0) kss[wr * 256 + bj * 128 + wc * 32 + 8 * fq + 4 * n + j] = v; }
            asm volatile("s_waitcnt lgkmcnt(0)" ::: "memory"); __builtin_amdgcn_s_barrier(); asm volatile("" ::: "memory");
            const int t = (wr * 4 + wc) * 64 + lane;
            if (t < 256) KMEAN[((size_t)((bidx * NH + hd0 + (t >> 6)) * NBLK + blk)) * HD + (t & 63)] = (kss[t] + kss[256 + t]) * (1.f / 256.f);
        }
    }
};
struct ProjOrder {
    gk::GridOrder g; int nmain;
    __device__ bool next(int i, Unit& u) const {
        const long L = (long)i * g.G + g.c;
        if (L < nmain) { if (!g.next(i, u)) return false; u.aoff += (long)WS_XN; u.boff += (long)WS_WIN; return true; }
        const int r = (int)(L - nmain); if (r >= 2 * (T / 256)) return false;
        const int vm = r & 1, vn = r >> 1;
        u.pm = vm; u.pn = vn; u.aoff = (long)WS_WIN + (long)(1536 + vm * 256) * DM * 2; u.boff = (long)WS_XN + (long)vn * 256 * DM * 2; u.nt = DM / 64;
        u.nvalid = 256; u.rows = nullptr; u.bsplit = 1 << 30; u.bjump = 0; u.aux0 = 1; u.aux1 = 0; u.lda = 0; u.ldb = 0; return true;
    }
};
struct EpiEloc {
    float* ELOC;
    __device__ __forceinline__ void operator()(const Acc& acc, const Unit& u, int wr, int wc, int fr, int fq) const {
        const int rowbase = u.aux0 * CROWS + u.pm * 256;
        epi_rows(acc, wr, wc, fr, fq, [&](int rl, int cl, f32x4 v0, f32x4 v1) {
            if (cl < 128) { float* d = ELOC + (size_t)(rowbase + rl) * 128 + cl; *(f32x4*)d = v0; *(f32x4*)(d + 4) = v1; }
        });
    }
};
struct EpiSsm {
    bf16_t* Z;
    __device__ __forceinline__ void operator()(const Acc& acc, const Unit& u, int wr, int wc, int fr, int fq) const {
        const int g = u.aux0, r0 = u.pm * 256, c0 = u.pn * 256;
        epi_rows(acc, wr, wc, fr, fq, [&](int rl, int cl, f32x4 v0, f32x4 v1) {
            const int col = c0 + cl, t = col >> 4, ch0 = col & 15; const size_t tok = (size_t)(r0 + rl) * CL + t;
            f32x4 a, bb;
#pragma unroll
            for (int j = 0; j < 4; ++j) { a[j] = gelu_tanh(v0[j]); bb[j] = gelu_tanh(v1[j]); }
            *(u32x4*)(Z + tok * SSMW + g * GC + ch0) = pk8(a, bb);
        });
    }
};
struct EpiGlu {
    const bf16_t* Z; const float* bias; bf16_t* OS;
    __device__ __forceinline__ void operator()(const Acc& acc, const Unit& u, int wr, int wc, int fr, int fq) const {
        const int r0 = u.pm * 256, c0 = u.pn * 256;
        f32x4 bs[2][2];
#pragma unroll
        for (int bj = 0; bj < 2; ++bj) { const float* bp = bias + c0 + bj * 128 + wc * 32 + 8 * fq; bs[bj][0] = *(const f32x4*)bp; bs[bj][1] = *(const f32x4*)(bp + 4); }
        epi_rows2<Pre1>(acc, wr, wc, fr, fq,
            [&](int rl, int cl) { Pre1 p; p.a = *(const u32x4*)(Z + (size_t)(r0 + rl) * SSMW + c0 + cl); return p; },
            [&](int rl, int cl, f32x4 v0, f32x4 v1, const Pre1& p) {
                f32x4 z0, z1; unpk8(p.a, z0, z1);
                const f32x4 b0 = bs[cl >> 7][0], b1 = bs[cl >> 7][1];
                f32x4 a, bb;
#pragma unroll
                for (int j = 0; j < 4; ++j) { a[j] = z0[j] * sigmoidf_(v0[j] + b0[j]); bb[j] = z1[j] * sigmoidf_(v1[j] + b1[j]); }
                *(u32x4*)(OS + (size_t)(r0 + rl) * SSMW + c0 + cl) = pk8(a, bb);
            });
    }
};
struct EpiMerge {
    bf16_t* MG; bf16_t* TMP;
    __device__ __forceinline__ void operator()(const Acc& acc, const Unit& u, int wr, int wc, int fr_, int fq_) const {
        int fr = fr_, fq = fq_; asm volatile("" : "+v"(fr), "+v"(fq));
        const int r0 = u.pm * 256, c0 = u.pn * 256, ps = u.aux0;
        const bool sg = ((ps & 1) == 0) == (u.aux1 == 0);
        if ((ps & 1) == 0) {
            bf16_t* D = ps ? TMP : MG;
            epi_rows(acc, wr, wc, fr, fq, [&](int rl, int cl, f32x4 v0, f32x4 v1) {
                f32x4 a = v0, bb = v1;
                if (sg) {
#pragma unroll
                    for (int j = 0; j < 4; ++j) { a[j] = sigmoidf_(v0[j]); bb[j] = sigmoidf_(v1[j]); } }
                *(u32x4*)(D + (size_t)(r0 + rl) * DM + c0 + cl) = pk8(a, bb);
            });
        } else if (ps == 1) {
            epi_rows2<Pre1>(acc, wr, wc, fr, fq,
                [&](int rl, int cl) { Pre1 p; p.a = *(const u32x4*)(MG + (size_t)(r0 + rl) * DM + c0 + cl); return p; },
                [&](int rl, int cl, f32x4 v0, f32x4 v1, const Pre1& p) { f32x4 m0, m1; unpk8(p.a, m0, m1); f32x4 a = v0, bb = v1;
                    if (sg) {
#pragma unroll
                        for (int j = 0; j < 4; ++j) { a[j] = sigmoidf_(v0[j]); bb[j] = sigmoidf_(v1[j]); } }
                    *(u32x4*)(MG + (size_t)(r0 + rl) * DM + c0 + cl) = pk8(m0 * a, m1 * bb); });
        } else {
            epi_rows2<Pre2>(acc, wr, wc, fr, fq,
                [&](int rl, int cl) { Pre2 p; const size_t off = (size_t)(r0 + rl) * DM + c0 + cl; p.a = *(const u32x4*)(MG + off); p.b = *(const u32x4*)(TMP + off); return p; },
                [&](int rl, int cl, f32x4 v0, f32x4 v1, const Pre2& p) { f32x4 m0, m1, t0, t1; unpk8(p.a, m0, m1); unpk8(p.b, t0, t1); f32x4 a = v0, bb = v1;
                    if (sg) {
#pragma unroll
                        for (int j = 0; j < 4; ++j) { a[j] = sigmoidf_(v0[j]); bb[j] = sigmoidf_(v1[j]); } }
                    *(u32x4*)(MG + (size_t)(r0 + rl) * DM + c0 + cl) = pk8(m0 + t0 * a, m1 + t1 * bb); });
        }
    }
};
struct MergeOrder {
    gk::GridOrder g; int order;
    __device__ bool next(int i, Unit& u) const {
        if (!g.next(i >> 2, u)) return false;
        const int ps = i & 3, br = ps >> 1; u.aux0 = ps; u.aux1 = order;
        const bool gate = ((ps & 1) == 0) == (order == 0);
        if (gate) { u.aoff = (long)WS_XN + (long)u.pm * 256 * DM * 2; u.boff = (long)WS_WIN + (long)(2048 + br * 1024 + u.pn * 256) * DM * 2; u.nt = DM / 64; u.lda = DM; u.ldb = DM; }
        else { u.aoff = (long)(br == 0 ? WS_OS : WS_ATT) + (long)u.pm * 256 * SSMW * 2; u.boff = (long)(br == 0 ? WS_WPS : WS_WPA) + (long)u.pn * 256 * SSMW * 2; u.nt = SSMW / 64; u.lda = SSMW; u.ldb = SSMW; }
        return true;
    }
};
struct EpiOut {
    const float* X; bf16_t* X1H; bf16_t* X1L;
    __device__ __forceinline__ void operator()(const Acc& acc, const Unit& u, int wr, int wc, int fr, int fq) const {
        const int r0 = u.pm * 256, c0 = u.pn * 256;
        epi_rows2<PreF2>(acc, wr, wc, fr, fq,
            [&](int rl, int cl) { PreF2 p; const float* xp = X + (size_t)(r0 + rl) * DM + c0 + cl; p.a = *(const f32x4*)xp; p.b = *(const f32x4*)(xp + 4); return p; },
            [&](int rl, int cl, f32x4 v0, f32x4 v1, const PreF2& p) {
                const size_t off = (size_t)(r0 + rl) * DM + c0 + cl;
                const f32x4 a = p.a + v0, bb = p.b + v1;
                const u32x4 hw = pk8(a, bb); f32x4 h0, h1; unpk8(hw, h0, h1);
                *(u32x4*)(X1H + off) = hw; if (X1L) *(u32x4*)(X1L + off) = pk8(a - h0, bb - h1);
            });
    }
};
struct EpiGU {
    const int* ELDST; const float* ELW; const float* ELR2; bf16_t* ACT; const LAS int* pairoff;
    __device__ __forceinline__ void operator()(const Acc& acc, const Unit& u, int wr, int wc, int fr, int fq) const {
        const int e = u.aux0, tile = u.pm;
#pragma unroll
        for (int ai = 0; ai < 2; ++ai) {
            int dst[4]; float w[4], r2[4];
#pragma unroll
            for (int m = 0; m < 4; ++m) {
                const int rl = ai * 128 + wr * 64 + m * 16 + fr; const size_t idx = (size_t)e * T + tile * 256 + (rl < u.nvalid ? rl : 0);
                dst[m] = ELDST[idx]; w[m] = ELW[idx]; r2[m] = ELR2[idx];
            }
#pragma unroll
            for (int m = 0; m < 4; ++m) {
                const int rl = ai * 128 + wr * 64 + m * 16 + fr;
                if (rl < u.nvalid) {
                    const int p = dst[m] >> 17, slot = (dst[m] >> 16) & 1, rank = dst[m] & 0xffff;
                    const size_t prow = (size_t)(pairoff[p] + rank);
                    f32x4 a[2];
#pragma unroll
                    for (int n = 0; n < 2; ++n)
#pragma unroll
                        for (int j = 0; j < 4; ++j) { const float gt = acc[ai][0][m][n][j] * r2[m], up = acc[ai][1][m][n][j] * r2[m]; a[n][j] = gt * sigmoidf_(gt) * up * w[m]; }
                    *(u32x4*)(ACT + prow * 256 + slot * 128 + wc * 32 + 8 * fq) = pk8(a[0], a[1]);
                }
            }
        }
    }
};
struct EpiDN {
    const int* PLTOK; const bf16_t* X1H; const bf16_t* X1L; float* OUT;
    __device__ __forceinline__ void operator()(const Acc& acc, const Unit& u, int wr, int wc, int fr, int fq) const {
        const int p = u.aux0, tile = u.aux1, c0 = u.pn * 256, nv = u.nvalid;
#pragma unroll
        for (int ai = 0; ai < 2; ++ai) {
            int tok[4];
#pragma unroll
            for (int m = 0; m < 4; ++m) { const int rl = ai * 128 + wr * 64 + m * 16 + fr; tok[m] = PLTOK[(size_t)p * T + tile * 256 + (rl < nv ? rl : 0)]; }
            u32x4 xh[4][2];
#pragma unroll
            for (int m = 0; m < 4; ++m)
#pragma unroll
                for (int bj = 0; bj < 2; ++bj) { const size_t off = (size_t)tok[m] * DM + c0 + bj * 128 + wc * 32 + 8 * fq; xh[m][bj] = *(const u32x4*)(X1H + off); }
#pragma unroll
            for (int m = 0; m < 4; ++m) {
                const int rl = ai * 128 + wr * 64 + m * 16 + fr;
                if (rl < nv) {
#pragma unroll
                    for (int bj = 0; bj < 2; ++bj) {
                        const size_t off = (size_t)tok[m] * DM + c0 + bj * 128 + wc * 32 + 8 * fq;
                        f32x4 h0, h1; unpk8(xh[m][bj], h0, h1);
                        *(f32x4*)(OUT + off) = h0 + acc[ai][bj][m][0]; *(f32x4*)(OUT + off + 4) = h1 + acc[ai][bj][m][1];
                    }
                }
            }
        }
    }
};

struct ElocOrder {
    int G, c;
    __device__ bool next(int i, Unit& u) const {
        const int L = i * G + c; if (L >= NG * 4) return false;
        const int g = L >> 2, pm = L & 3;
        u.pm = pm; u.pn = 0; u.aoff = ((long)(g * CROWS + pm * 256) * KU + 128) * 2; u.boff = (long)g * 128 * NTC * 2; u.nt = NTC / 64;
        u.nvalid = 256; u.rows = nullptr; u.bsplit = 1 << 30; u.bjump = 0; u.aux0 = g; u.aux1 = 0; return true;
    }
};
struct SsmOrder {
    int G, c;
    __device__ bool next(int i, Unit& u) const {
        const int L = i * G + c; if (L >= NG * 8) return false;
        const int g = L >> 3, pm = (L >> 1) & 3, pn = L & 1;
        u.pm = pm; u.pn = pn; u.aoff = (long)(g * CROWS + pm * 256) * KU * 2; u.boff = (long)(g * NTC + pn * 256) * KU * 2; u.nt = pn ? 10 : 6;
        u.nvalid = 256; u.rows = nullptr; u.bsplit = 1 << 30; u.bjump = 0; u.aux0 = g; u.aux1 = 0; return true;
    }
};
struct GUOrder {
    const LAS int* fpre; const LAS int* ecnt; const LAS int* plist; int nfull, npart; const int* ELTOK; int G, c;
    __device__ bool next(int i, Unit& u) const {
        const int L = i * G + c; if (L >= nfull + npart) return false;
        int e, tile;
        if (L < nfull) { e = 0; while (fpre[e + 1] <= L) ++e; e = __builtin_amdgcn_readfirstlane(e); tile = L - __builtin_amdgcn_readfirstlane(fpre[e]); }
        else { e = __builtin_amdgcn_readfirstlane(plist[L - nfull]); tile = __builtin_amdgcn_readfirstlane(ecnt[e]) >> 8; }
        const int cnt = __builtin_amdgcn_readfirstlane(ecnt[e]);
        u.pm = tile; u.pn = 0; u.aoff = 0; u.boff = (long)e * 256 * DM * 2; u.nt = DM / 64;
        u.nvalid = min(256, cnt - tile * 256); u.rows = ELTOK + (size_t)e * T + tile * 256; u.bsplit = 1 << 30; u.bjump = 0; u.aux0 = e; u.aux1 = 0; u.lda = 0; u.ldb = 0; return true;
    }
};
struct DNOrder {
    const LAS int* fpre; const LAS int* pcnt; const LAS int* pairoff; const LAS int* plist; int nfull, npart, G, c;
    __device__ bool next(int i, Unit& u) const {
        const int L = i * G + c; if (L >= (nfull + npart) * 4) return false;
        const int rt = L >> 2, pn = L & 3; int p, tile;
        if (rt < nfull) { p = 0; while (fpre[p + 1] <= rt) ++p; p = __builtin_amdgcn_readfirstlane(p); tile = rt - __builtin_amdgcn_readfirstlane(fpre[p]); }
        else { p = __builtin_amdgcn_readfirstlane(plist[rt - nfull]); tile = __builtin_amdgcn_readfirstlane(pcnt[p]) >> 8; }
        const int cnt = __builtin_amdgcn_readfirstlane(pcnt[p]), po = __builtin_amdgcn_readfirstlane(pairoff[p]);
        const int g = p / 28; int q = p % 28, lo = 0; while (q >= 7 - lo) { q -= 7 - lo; ++lo; } const int hi = lo + 1 + q;
        u.pm = 0; u.pn = pn; u.aoff = (long)(po + tile * 256) * 256 * 2; u.boff = ((long)pn * 256 * (NE * DE) + (g * 8 + lo) * DE) * 2; u.nt = 4;
        u.nvalid = min(256, cnt - tile * 256); u.rows = nullptr; u.bsplit = 2; u.bjump = (long)(hi - lo) * DE * 2 - 2 * 128; u.aux0 = p; u.aux1 = tile; u.lda = 0; u.ldb = 0; return true;
    }
};

__device__ __forceinline__ void p0_transpose_item(const float* W, int N, const float* kscale, bf16_t* WT, int ldt, LAS float* scr, int item, int lane) {
    const int nblk = N / 32, kb = item / nblk, nb = item % nblk, k0 = 64 * kb, n0 = 32 * nb;
    float v[32];
#pragma unroll
    for (int i = 0; i < 32; ++i) v[i] = W[(size_t)(k0 + 2 * i + (lane >> 5)) * N + n0 + (lane & 31)];
    if (kscale) {
#pragma unroll
        for (int i = 0; i < 32; ++i) v[i] *= kscale[k0 + 2 * i + (lane >> 5)];
    }
#pragma unroll
    for (int i = 0; i < 32; ++i) scr[(2 * i + (lane >> 5)) * 33 + (lane & 31)] = v[i];
    asm volatile("s_waitcnt lgkmcnt(0)" ::: "memory");
    const int c = lane & 7;
#pragma unroll
    for (int j = 0; j < 4; ++j) { const int n = (lane >> 3) + 8 * j; const LAS float* s = scr + (8 * c) * 33 + n;
        u32x4 o; o.x = pk2(s[0 * 33], s[1 * 33]); o.y = pk2(s[2 * 33], s[3 * 33]); o.z = pk2(s[4 * 33], s[5 * 33]); o.w = pk2(s[6 * 33], s[7 * 33]);
        *(u32x4*)(WT + (size_t)(n0 + n) * ldt + k0 + 8 * c) = o; }
    asm volatile("s_waitcnt lgkmcnt(0)" ::: "memory");
}

__device__ __forceinline__ void p0_ssm_tables(const Params& P, LAS unsigned char* lds, int g, int part, int tid) {
    unsigned char* ws = P.ws;
    LAS double* xs = (LAS double*)lds;
    LAS double* ys = xs + 64;
    LAS float* cfr = (LAS float*)(ys + 64);
    LAS float* cfi = cfr + 64;
    LAS f32x2* AP = (LAS f32x2*)(cfi + 64);
    LAS f32x2* BB = AP + 33 * 64;
    LAS f32x2* CC = BB + 64 * 16;
    if (tid < 64) {
        const int n = tid;
        const double dt = exp((double)P.in[I_LOGDT][g]);
        const float lrf = fminf(P.in[I_LAMRE][g * NS + n], -1e-4f);
        const double lr = lrf, li = P.in[I_LAMIM][g * NS + n];
        const double x = lr * dt, y = li * dt, mag = exp(x), ar = mag * cos(y), ai = mag * sin(y);
        const double den = lr * lr + li * li, nr = ar - 1.0, ni = ai;
        xs[n] = x; ys[n] = y; cfr[n] = (float)((nr * lr + ni * li) / den); cfi[n] = (float)((ni * lr - nr * li) / den);
        const double m32 = exp(32.0 * x);
        if (part == 0) ((f32x2*)(ws + WS_A32))[g * NS + n] = (f32x2){(float)(m32 * cos(32.0 * y)), (float)(m32 * sin(32.0 * y))};
    }
    __syncthreads();
#pragma unroll 1
    for (int idx = tid; idx < 33 * 64; idx += 512) { const int tau = idx >> 6, n = idx & 63; const float m = expf((float)xs[n] * (float)tau), a = (float)(ys[n] * tau); float sn, cs; sincosf(a, &sn, &cs); AP[idx] = (f32x2){m * cs, m * sn}; }
#pragma unroll 1
    for (int idx = tid; idx < 1024; idx += 512) {
        { const int n = idx >> 4; const float br = P.in[I_BRE][(size_t)g * 1024 + idx], bi = P.in[I_BIM][(size_t)g * 1024 + idx]; BB[idx] = (f32x2){cfr[n] * br - cfi[n] * bi, cfr[n] * bi + cfi[n] * br}; }
        CC[idx] = (f32x2){P.in[I_CRE][(size_t)g * 1024 + idx], P.in[I_CIM][(size_t)g * 1024 + idx]};
    }
    __syncthreads();
    float* KC = (float*)(ws + WS_KC) + (size_t)g * 32 * 256;
#pragma unroll 1
    for (int idx = part * 1024 + tid; idx < (part + 1) * 1024; idx += 512) {
        const int tau = idx >> 8, c = (idx >> 4) & 15, cp = idx & 15; float s = 0.f;
#pragma unroll 4
        for (int n = 0; n < 64; ++n) { const f32x2 cc = CC[c * 64 + n], ap = AP[tau * 64 + n], bb = BB[n * 16 + cp];
            const float xr = cc.x * ap.x - cc.y * ap.y, xi = cc.x * ap.y + cc.y * ap.x; s += xr * bb.x - xi * bb.y; }
        if (tau == 0 && c == cp) s += P.in[I_SSMD][g * GC + c];
        KC[idx] = s;
    }
    bf16_t* MO = (bf16_t*)(ws + WS_MOUT) + (size_t)g * NTC * 128;
#pragma unroll 1
    for (int idx = part * (NTC * 16) + tid; idx < (part + 1) * (NTC * 16); idx += 512) {
        const int row = idx >> 7, np = idx & 127, n = np & 63, t = row >> 4, c = row & 15;
        const f32x2 cc = CC[c * 64 + n], ap = AP[(t + 1) * 64 + n];
        const float zr = cc.x * ap.x - cc.y * ap.y, zi = cc.x * ap.y + cc.y * ap.x;
        MO[idx] = f2bf(np < 64 ? zr : -zi);
    }
    bf16_t* MIN = (bf16_t*)(ws + WS_MIN) + (size_t)g * 128 * NTC;
#pragma unroll 1
    for (int idx = part * (NTC * 16) + tid; idx < (part + 1) * (NTC * 16); idx += 512) {
        const int np = idx >> 9, k = idx & 511, n = np & 63, s = k >> 4, cp = k & 15;
        const f32x2 ap = AP[(31 - s) * 64 + n], bb = BB[n * 16 + cp];
        const float wr_ = ap.x * bb.x - ap.y * bb.y, wi_ = ap.x * bb.y + ap.y * bb.x;
        MIN[idx] = f2bf(np < 64 ? wr_ : wi_);
    }
    __syncthreads();
}

__device__ __forceinline__ void phase0(const Params& P, LAS unsigned char* lds, int G, const int tid) {
    unsigned char* ws = P.ws;
    const int lane = tid & 63, wid = __builtin_amdgcn_readfirstlane(tid >> 6), bid = blockIdx.x;
    for (int u = bid; u < NG * 8; u += G) p0_ssm_tables(P, lds, u >> 3, u & 7, tid);
#ifdef PROBE_A
#define P0STAMP(i) do { if (blockIdx.x == PROBE_BLK && tid == 0) ((LAS unsigned long long*)(lds + MISC_OFF + 12288))[i] = __builtin_amdgcn_s_memrealtime(); } while (0)
#else
#define P0STAMP(i) do { } while (0)
#endif
    P0STAMP(26);
    {
        LAS float* scr = (LAS float*)(lds + wid * 16384);
        const int gw = bid * 8 + wid, NGW = G * 8;
        for (int it = gw; it < 16 * 128; it += NGW) p0_transpose_item(P.in[I_WIN], NIN, nullptr, (bf16_t*)(ws + WS_WIN), DM, scr, it, lane);
    }
    P0STAMP(27);
    {
        bf16_t* HI = (bf16_t*)(ws + WS_WRT); bf16_t* LO = HI + 48 * DM;
        for (int idx = bid * 512 + tid; idx < 48 * DM; idx += G * 512) {
            const int col = idx >> 10, k = idx & 1023;
            float v = 0.f;
            if (col < 4) v = P.in[I_WRG][k * 4 + col]; else if (col < 36) v = P.in[I_WRE][k * 32 + col - 4];
            v *= P.in[I_N2G][k];
            const bf16_t h = f2bf(v); HI[idx] = h; LO[idx] = f2bf(v - bf2f(h));
        }
    }
    {
        const float invf[8] = {1.0f, 0.1939227432012558f, 0.03760603070259094f, 0.007292664609849453f, 0.0014142135623842478f, 0.00027424818836152554f, 5.318296098266728e-05f, 1.0313386155758053e-05f};
        float* RT = (float*)(ws + WS_ROPE);
        for (int idx = bid * 512 + tid; idx < SEQ * 8; idx += G * 512) {
            const int pos = idx >> 3, i = idx & 7; float fr = 1.0f;
#pragma unroll
            for (int k = 0; k < 8; ++k) if (i == k) fr = invf[k];
            const float ang = (float)pos * fr;
            RT[pos * 16 + i] = cosf(ang); RT[pos * 16 + 8 + i] = sinf(ang);
        }
    }
    P0STAMP(28);
    {
        const int gw = bid * 8 + wid, NGW = G * 8;
        const f32x4* gp = (const f32x4*)P.in[I_N1G] + lane;
        f32x4 gv[4];
#pragma unroll
        for (int j = 0; j < 4; ++j) gv[j] = gp[64 * j];
        f32x4 v[4], vn[4];
        if (gw < T) { const f32x4* xr = (const f32x4*)(P.in[I_X] + (size_t)gw * DM) + lane;
#pragma unroll
            for (int j = 0; j < 4; ++j) v[j] = xr[64 * j]; }
        for (int m = gw; m < T; m += NGW) {
            const int mn = (m + NGW < T) ? m + NGW : m;
            { const f32x4* xr = (const f32x4*)(P.in[I_X] + (size_t)mn * DM) + lane;
#pragma unroll
              for (int j = 0; j < 4; ++j) vn[j] = xr[64 * j]; }
            float ssum = 0.f;
#pragma unroll
            for (int j = 0; j < 4; ++j) ssum += (v[j].x * v[j].x + v[j].y * v[j].y) + (v[j].z * v[j].z + v[j].w * v[j].w);
            const float rs = 1.0f / sqrtf(wave_sum(ssum) * (1.f / DM) + EPS);
            u32x2* o8 = (u32x2*)((bf16_t*)(ws + WS_XN) + (size_t)m * DM) + lane;
#pragma unroll
            for (int j = 0; j < 4; ++j) { const f32x4 y = v[j] * rs * gv[j]; u32x2 w; w.x = pk2(y.x, y.y); w.y = pk2(y.z, y.w); o8[64 * j] = w; }
#pragma unroll
            for (int j = 0; j < 4; ++j) v[j] = vn[j];
        }
    }
}


__device__ __forceinline__ void late_transposes(const Params& P, LAS unsigned char* lds, int G, const int tid, int half, int slot, int nslots) {
    unsigned char* ws = P.ws;
    const int lane = tid & 63, wid = __builtin_amdgcn_readfirstlane(tid >> 6), bid = blockIdx.x;
    LAS float* scr = (LAS float*)(lds + wid * 16384);
    const int gw = slot * 8 + wid, NGW = nslots * 8;
    constexpr int I_GLU = 8 * 16, I_P = 8 * 32, I_O = 16 * 32, I_E = 64 * NE;
    constexpr int NIT = I_GLU + 2 * I_P + I_O + 3 * I_E;
    bf16_t* WGU = (bf16_t*)(ws + WS_WGU); bf16_t* WDN = (bf16_t*)(ws + WS_WDN);
    const int lo = half ? NIT / 2 : 0, hi = half ? NIT : NIT / 2;
    for (int it = lo + gw; it < hi; it += NGW) {
        int r = it;
        if (r < I_GLU) { p0_transpose_item(P.in[I_WGLU], SSMW, nullptr, (bf16_t*)(ws + WS_WGLU), SSMW, scr, r, lane); continue; } r -= I_GLU;
        if (r < I_P) { p0_transpose_item(P.in[I_WPS], DM, nullptr, (bf16_t*)(ws + WS_WPS), SSMW, scr, r, lane); continue; } r -= I_P;
        if (r < I_P) { p0_transpose_item(P.in[I_WPA], DM, nullptr, (bf16_t*)(ws + WS_WPA), SSMW, scr, r, lane); continue; } r -= I_P;
        if (r < I_O) { p0_transpose_item(P.in[I_WOUT], DM, nullptr, (bf16_t*)(ws + WS_WOUT), DM, scr, r, lane); continue; } r -= I_O;
        if (r < I_E) { const int e = r >> 6; p0_transpose_item(P.in[I_WGATE] + (size_t)e * DM * DE, DE, P.in[I_N2G], WGU + (size_t)e * 256 * DM, DM, scr, r & 63, lane); continue; } r -= I_E;
        if (r < I_E) { const int e = r >> 6; p0_transpose_item(P.in[I_WUP] + (size_t)e * DM * DE, DE, P.in[I_N2G], WGU + (size_t)(e * 256 + 128) * DM, DM, scr, r & 63, lane); continue; } r -= I_E;
        { const int e = r >> 6; p0_transpose_item(P.in[I_WDOWN] + (size_t)e * DE * DM, DM, nullptr, WDN + e * DE, NE * DE, scr, r & 63, lane); }
    }
    __syncthreads();
}

struct QkvRegs { u32x4 q[4], k[4]; };
__device__ __forceinline__ void qkv_load(const Params& P, int wu, int lane, QkvRegs& R) {
    const int bh = wu >> 8, blk = (wu >> 3) & 31, sub = wu & 7;
    const size_t off = ((size_t)bh * SEQ + blk * 256 + sub * 32 + (lane >> 3)) * HD + (lane & 7) * 8;
    const bf16_t* qp = (const bf16_t*)(P.ws + WS_QH) + off; const bf16_t* kp = (const bf16_t*)(P.ws + WS_KH) + off;
#pragma unroll
    for (int it = 0; it < 4; ++it) { R.q[it] = *(const u32x4*)(qp + it * 8 * HD); R.k[it] = *(const u32x4*)(kp + it * 8 * HD); }
}
__device__ __forceinline__ void qkv_wave_unit(const Params& P, LAS bf16_t* vt, int wu, int lane, const QkvRegs& R, const f32x4 (&gq)[2], const f32x4 (&gk)[2]) {
    unsigned char* ws = P.ws;
    const int bh = wu >> 8, blk = (wu >> 3) & 31, sub = wu & 7, r8 = lane >> 3, c8 = lane & 7;
    const size_t blkoff = ((size_t)bh * SEQ + blk * 256) * HD;
    const size_t off = blkoff + (size_t)(sub * 32 + r8) * HD + c8 * 8;
    bf16_t* qp = (bf16_t*)(ws + WS_QH) + off; bf16_t* kp = (bf16_t*)(ws + WS_KH) + off;
    f32x4 ks0 = {0.f, 0.f, 0.f, 0.f}, ks1 = {0.f, 0.f, 0.f, 0.f};
#pragma unroll
    for (int it = 0; it < 4; ++it) {
        const int pos = blk * 256 + sub * 32 + it * 8 + r8;
        f32x4 c0 = {1.f, 1.f, 1.f, 1.f}, c1 = c0, s0 = {0.f, 0.f, 0.f, 0.f}, s1 = s0;
        if (c8 < 2) { const f32x4* rt = (const f32x4*)((const float*)(ws + WS_ROPE) + (size_t)pos * 16); c0 = rt[0]; c1 = rt[1]; s0 = rt[2]; s1 = rt[3]; if (c8 == 0) { s0 = -s0; s1 = -s1; } }
#pragma unroll
        for (int w = 0; w < 2; ++w) {
            f32x4 a, b; unpk8(w ? R.k[it] : R.q[it], a, b);
            float ss = (a.x * a.x + a.y * a.y) + (a.z * a.z + a.w * a.w) + (b.x * b.x + b.y * b.y) + (b.z * b.z + b.w * b.w);
            ss += shx(ss, 1, lane); ss += shx(ss, 2, lane); ss += shx(ss, 4, lane);
            const float rs = 1.0f / sqrtf(ss * (1.f / HD) + EPS);
            a = a * rs * (w ? gk[0] : gq[0]); b = b * rs * (w ? gk[1] : gq[1]);
            f32x4 pa, pb;
#pragma unroll
            for (int j = 0; j < 4; ++j) { pa[j] = shx(a[j], 1, lane); pb[j] = shx(b[j], 1, lane); }
            a = a * c0 + pa * s0; b = b * c1 + pb * s1;
            if (w) { ks0 += a; ks1 += b; *(u32x4*)(kp + it * 8 * HD) = pk8(a, b); }
            else *(u32x4*)(qp + it * 8 * HD) = pk8(a * QSCALE, b * QSCALE);
        }
    }
#pragma unroll
    for (int j = 0; j < 4; ++j) { ks0[j] += shx(ks0[j], 8, lane); ks0[j] += shx(ks0[j], 16, lane); ks0[j] += shx(ks0[j], 32, lane); ks1[j] += shx(ks1[j], 8, lane); ks1[j] += shx(ks1[j], 16, lane); ks1[j] += shx(ks1[j], 32, lane); }
    if (lane < 8) { float* kpart = (float*)(ws + WS_KPART) + ((size_t)(bh * NBLK + blk) * 8 + sub) * HD + c8 * 8; *(f32x4*)kpart = ks0; *(f32x4*)(kpart + 4) = ks1; }
}
__device__ __forceinline__ void qkv_phase(const Params& P, LAS unsigned char* lds, int G, const int tid) {
    const int lane = tid & 63, wid = __builtin_amdgcn_readfirstlane(tid >> 6), c8 = lane & 7;
    LAS bf16_t* vt = (LAS bf16_t*)(lds + wid * 8192);
    f32x4 gq[2], gk[2];
    gq[0] = *(const f32x4*)(P.in[I_QG] + c8 * 8); gq[1] = *(const f32x4*)(P.in[I_QG] + c8 * 8 + 4); gk[0] = *(const f32x4*)(P.in[I_KG] + c8 * 8); gk[1] = *(const f32x4*)(P.in[I_KG] + c8 * 8 + 4);
    const int NWU = NBH * NBLK * 8, step = G * 8;
    int wu = blockIdx.x * 8 + wid;
    QkvRegs Ra, Rb;
    if (wu < NWU) qkv_load(P, wu, lane, Ra);
    for (; wu < NWU; wu += 2 * step) {
        if (wu + step < NWU) qkv_load(P, wu + step, lane, Rb);
        qkv_wave_unit(P, vt, wu, lane, Ra, gq, gk);
        if (wu + step < NWU) { if (wu + 2 * step < NWU) qkv_load(P, wu + 2 * step, lane, Ra); qkv_wave_unit(P, vt, wu + step, lane, Rb, gq, gk); }
    }
    __syncthreads();
}

__device__ __forceinline__ void select_phase(const Params& P, LAS unsigned char* lds, int G, const int tid) {
    unsigned char* ws = P.ws;
    LAS int* lc = (LAS int*)lds;
    LAS int* lb = lc + 128;
    const int lane = tid & 63, wid = __builtin_amdgcn_readfirstlane(tid >> 6), q32 = lane & 31, hi = lane >> 5, r = wid * 32 + q32;
    const int NU = NBH * NBLK;
    for (int u0 = blockIdx.x; u0 < NU; u0 += 4 * G) {
        if (tid < 128) lc[tid] = 0;
        bf16x8 qf[4][4];
#pragma unroll
        for (int k = 0; k < 4; ++k) { const int u = u0 + k * G; const int uu = u < NU ? u : u0;
            const bf16_t* qp = (const bf16_t*)(ws + WS_QH) + ((size_t)(uu >> 5) * SEQ + (uu & 31) * 256 + r) * HD + hi * 8;
#pragma unroll
            for (int d0 = 0; d0 < 4; ++d0) qf[k][d0] = *(const bf16x8*)(qp + d0 * 16); }
        __syncthreads();
        int sj[4][3], srank[4][3];
#pragma unroll
        for (int k = 0; k < 4; ++k) {
            const int u = u0 + k * G; const bool act = u < NU; const int uu = act ? u : u0, bh = uu >> 5, qb = uu & 31;
            f32x16 sc;
#pragma unroll
            for (int i = 0; i < 16; ++i) sc[i] = 0.f;
            const float* kmp = (const float*)(ws + WS_KMEAN) + ((size_t)bh * NBLK + q32) * HD + hi * 8;
            f32x4 km[4][2];
#pragma unroll
            for (int d0 = 0; d0 < 4; ++d0) { km[d0][0] = *(const f32x4*)(kmp + d0 * 16); km[d0][1] = *(const f32x4*)(kmp + d0 * 16 + 4); }
#pragma unroll
            for (int d0 = 0; d0 < 4; ++d0) {
                const u32x4 hw = pk8(km[d0][0], km[d0][1]); f32x4 h0, h1; unpk8(hw, h0, h1); const u32x4 lw = pk8(km[d0][0] - h0, km[d0][1] - h1);
                sc = __builtin_amdgcn_mfma_f32_32x32x16_bf16(__builtin_bit_cast(bf16x8, hw), qf[k][d0], sc, 0, 0, 0);
                sc = __builtin_amdgcn_mfma_f32_32x32x16_bf16(__builtin_bit_cast(bf16x8, lw), qf[k][d0], sc, 0, 0, 0);
            }
            float b0 = -INFINITY, b1 = -INFINITY, b2 = -INFINITY; int i0 = 1 << 20, i1 = 1 << 20, i2 = 1 << 20;
#pragma unroll
            for (int rr = 0; rr < 16; ++rr) {
                const int j = (rr & 3) + 8 * (rr >> 2) + 4 * hi; const float sv = j < qb ? sc[rr] : -INFINITY;
                if (sv > b0) { b2 = b1; i2 = i1; b1 = b0; i1 = i0; b0 = sv; i0 = j; }
                else if (sv > b1) { b2 = b1; i2 = i1; b1 = sv; i1 = j; }
                else if (sv > b2) { b2 = sv; i2 = j; }
            }
            const float pb[3] = {shx(b0, 32, lane), shx(b1, 32, lane), shx(b2, 32, lane)};
            const int pi[3] = {__builtin_amdgcn_ds_bpermute((lane ^ 32) << 2, i0), __builtin_amdgcn_ds_bpermute((lane ^ 32) << 2, i1), __builtin_amdgcn_ds_bpermute((lane ^ 32) << 2, i2)};
#pragma unroll
            for (int c = 0; c < 3; ++c) {
                const float sv = pb[c]; const int j = pi[c];
                if (sv > b0 || (sv == b0 && j < i0)) { b2 = b1; i2 = i1; b1 = b0; i1 = i0; b0 = sv; i0 = j; }
                else if (sv > b1 || (sv == b1 && j < i1)) { b2 = b1; i2 = i1; b1 = sv; i1 = j; }
                else if (sv > b2 || (sv == b2 && j < i2)) { b2 = sv; i2 = j; }
            }
            sj[k][0] = i0; sj[k][1] = i1; sj[k][2] = i2;
            const int nsel = act ? (qb < 3 ? qb : 3) : 0;
#pragma unroll
            for (int c = 0; c < 3; ++c) { srank[k][c] = 0; if (hi == 0 && c < nsel) srank[k][c] = atomicAdd((int*)&lc[k * 32 + sj[k][c]], 1); }
        }
        __syncthreads();
        if (tid < 128) { const int k = tid >> 5, j = tid & 31, u = u0 + k * G; const int n = lc[tid];
            lb[tid] = (u < NU && n > 0) ? atomicAdd((int*)(ws + WS_CTL) + CW_LCNT + (u >> 5) * NBLK + j, n) : 0; }
        __syncthreads();
        if (hi == 0) {
            unsigned short* lists = (unsigned short*)(ws + WS_LISTS);
#pragma unroll
            for (int k = 0; k < 4; ++k) { const int u = u0 + k * G; if (u < NU) { const int bh = u >> 5, qb = u & 31, nsel = qb < 3 ? qb : 3;
#pragma unroll
                for (int c = 0; c < 3; ++c) if (c < nsel) lists[(size_t)(bh * NBLK + sj[k][c]) * SEQ + lb[k * 32 + sj[k][c]] + srank[k][c]] = (unsigned short)((qb * 256 + r) | (c << 13)); } }
        }
        __syncthreads();
    }
}

__device__ __forceinline__ void tg_expand(const Params& P, int G, const int tid, int slot, int nslots) {
    unsigned char* ws = P.ws;
    const float* KC = (const float*)(ws + WS_KC); bf16_t* TG = (bf16_t*)(ws + WS_TG);
    for (int idx = slot * 512 + tid; idx < NG * NTC * CL; idx += nslots * 512) {
        const int s = idx & 31, row = (idx >> 5) & 511, g = idx >> 14, t = row >> 4, c = row & 15;
        u32x4 w0 = {0u, 0u, 0u, 0u}, w1 = {0u, 0u, 0u, 0u};
        if (s <= t) { const f32x4* kp = (const f32x4*)(KC + ((size_t)(g * 32 + (t - s)) * 16 + c) * 16); w0 = pk8(kp[0], kp[1]); w1 = pk8(kp[2], kp[3]); }
        bf16_t* d = TG + ((size_t)(g * NTC + row)) * KU + 128 + s * 16;
        *(u32x4*)d = w0; *(u32x4*)(d + 8) = w1;
        if (s < 16) *(u32x4*)(TG + ((size_t)(g * NTC + row)) * KU + s * 8) = *(const u32x4*)((const bf16_t*)(ws + WS_MOUT) + ((size_t)(g * NTC + row)) * 128 + s * 8);
    }
}

__device__ __forceinline__ void carry_scan(const Params& P, LAS unsigned char* lds, int vb, int tid) {
    unsigned char* ws = P.ws;
    LAS f32x2* tot = (LAS f32x2*)lds;
    const int pair = vb >> 1, g = pair >> 2, b = pair & 3, nl = tid & 31, n = (vb & 1) * 32 + nl, seg = tid >> 5;
    const f32x2 a = ((const f32x2*)(ws + WS_A32))[g * NS + n];
    const float* EL = (const float*)(ws + WS_ELOC) + ((size_t)(g * CROWS + b * NCH + seg * 16)) * 128;
    float er[16], ei[16];
#pragma unroll
    for (int i = 0; i < 16; ++i) { er[i] = EL[(size_t)i * 128 + n]; ei[i] = EL[(size_t)i * 128 + 64 + n]; }
    float pr[16], pi[16]; float sr = 0.f, si = 0.f;
#pragma unroll
    for (int i = 0; i < 16; ++i) { pr[i] = sr; pi[i] = si; const float tr = a.x * sr - a.y * si + er[i], ti = a.x * si + a.y * sr + ei[i]; sr = tr; si = ti; }
    tot[seg * 32 + nl] = (f32x2){sr, si};
    __syncthreads();
    f32x2 a16 = a;
#pragma unroll
    for (int k = 0; k < 4; ++k) a16 = (f32x2){a16.x * a16.x - a16.y * a16.y, 2.f * a16.x * a16.y};
    float cr = 0.f, ci = 0.f;
    for (int j = 0; j < seg; ++j) { const f32x2 tj = tot[j * 32 + nl]; const float tr = a16.x * cr - a16.y * ci + tj.x, ti = a16.x * ci + a16.y * cr + tj.y; cr = tr; ci = ti; }
    bf16_t* U = (bf16_t*)(ws + WS_UGS) + ((size_t)(g * CROWS + b * NCH + seg * 16)) * KU;
#pragma unroll
    for (int i = 0; i < 16; ++i) {
        U[(size_t)i * KU + n] = f2bf(cr + pr[i]); U[(size_t)i * KU + 64 + n] = f2bf(ci + pi[i]);
        const float tr = a.x * cr - a.y * ci, ti = a.x * ci + a.y * cr; cr = tr; ci = ti;
    }
    __syncthreads();
}

struct AttnDesc { int bh, j, row0, nrows, diag; };
__device__ __forceinline__ void attn_dma(const Params& P, LAS unsigned char* buf, const AttnDesc& u, int wid, int lane) {
    const size_t blkoff = ((size_t)u.bh * SEQ + u.j * 256) * HD;
    const bf16_t* kg = (const bf16_t*)(P.ws + WS_KH) + blkoff; const bf16_t* vg = (const bf16_t*)(P.ws + WS_VT) + blkoff;
#pragma unroll
    for (int i = 0; i < 4; ++i) {
        const int c = wid * 4 + i;
        { const int rho = c * 8 + (lane >> 3), cc = (lane & 7) ^ ((rho >> 1) & 7), kv = (rho & ~12) | ((rho & 4) << 1) | ((rho & 8) >> 1);
          __builtin_amdgcn_global_load_lds((const unsigned*)(kg + kv * 64 + cc * 8), (LAS unsigned*)(buf + c * 1024), 16, 0, 0); }
        { const int dd = c * 2 + (lane >> 5), c16 = (lane & 31) ^ (dd & 15);
          __builtin_amdgcn_global_load_lds((const unsigned*)(vg + dd * 256 + c16 * 8), (LAS unsigned*)(buf + 32768 + c * 1024), 16, 0, 0); }
    }
}
__device__ __forceinline__ unsigned attn_entry(const Params& P, const AttnDesc& u, int rq) {
    if (u.diag) return (unsigned)(u.j * 256 + rq) | (3u << 13);
    return (rq < u.nrows) ? (unsigned)((const unsigned short*)(P.ws + WS_LISTS))[(size_t)(u.bh * NBLK + u.j) * SEQ + u.row0 + rq] : 0u;
}
__device__ __forceinline__ void attn_qload(const Params& P, bf16x8 (&qf)[4], int bh, unsigned e, int hi) {
    const bf16_t* qp = (const bf16_t*)(P.ws + WS_QH) + ((size_t)bh * SEQ + (e & 0x1fff)) * HD + hi * 8;
#pragma unroll
    for (int d0 = 0; d0 < 4; ++d0) qf[d0] = *(const bf16x8*)(qp + d0 * 16);
}

template <class F> __device__ __forceinline__ void block_prefix_1024(LAS int* pre, LAS int* wt, int tid, const F& val) {
    const int lane = tid & 63, wid = tid >> 6;
    const int a = val(2 * tid), b = val(2 * tid + 1), s = a + b;
    int inc = s;
#pragma unroll
    for (int o = 1; o < 64; o <<= 1) { const int v = shup(inc, o, lane); if (lane >= o) inc += v; }
    if (lane == 63) wt[wid] = inc;
    __syncthreads();
    int woff = 0;
    for (int w = 0; w < wid; ++w) woff += wt[w];
    const int ex = inc - s + woff;
    pre[2 * tid] = ex; pre[2 * tid + 1] = ex + a;
    if (tid == 511) pre[1024] = ex + s;
    __syncthreads();
}

__device__ __forceinline__ bool attn_unit_desc(const Params& P, const LAS int* pre, int total, int nunits, int u, AttnDesc& D) {
    if (u >= nunits) return false;
    if (u < total) {
        int lo = 0, hi = 1023;
        while (lo < hi) { const int mid = (lo + hi + 1) >> 1; if (pre[mid] <= u) lo = mid; else hi = mid - 1; }
        const int L = __builtin_amdgcn_readfirstlane(lo), tile = u - __builtin_amdgcn_readfirstlane(pre[L]);
        const int cnt = __builtin_amdgcn_readfirstlane(pre[1040 + L]);
        D.bh = L >> 5; D.j = L & 31; D.row0 = tile * 256; D.nrows = min(256, cnt - tile * 256); D.diag = 0;
    } else { const int d = u - total; D.bh = d >> 5; D.j = d & 31; D.row0 = 0; D.nrows = 256; D.diag = 1; }
    return true;
}
#define ATT_QK(sacc, kt) do { const int rho_ = (kt) * 32 + r32; const LAS unsigned char* kb_ = buf + rho_ * 128; const int sw_ = (rho_ >> 1) & 7; \
        { const bf16x8 kf_ = *(const LAS bf16x8*)(kb_ + ((hi ^ sw_) << 4)); sacc = __builtin_amdgcn_mfma_f32_32x32x16_bf16(kf_, qf[0], cinit, 0, 0, 0); } \
        _Pragma("unroll") for (int d0 = 1; d0 < 4; ++d0) { const bf16x8 kf_ = *(const LAS bf16x8*)(kb_ + (((d0 * 2 + hi) ^ sw_) << 4)); sacc = __builtin_amdgcn_mfma_f32_32x32x16_bf16(kf_, qf[d0], sacc, 0, 0, 0); } } while (0)
#define ATT_PV(sacc, kt) do { _Pragma("unroll") for (int r = 0; r < 16; ++r) { const float p_ = __builtin_amdgcn_exp2f(sacc[r]); sacc[r] = p_; l += p_; } \
        _Pragma("unroll") for (int s2 = 0; s2 < 2; ++s2) { u32x4 pw_; pw_.x = pk2(sacc[8 * s2 + 0], sacc[8 * s2 + 1]); pw_.y = pk2(sacc[8 * s2 + 2], sacc[8 * s2 + 3]); pw_.z = pk2(sacc[8 * s2 + 4], sacc[8 * s2 + 5]); pw_.w = pk2(sacc[8 * s2 + 6], sacc[8 * s2 + 7]); \
            const bf16x8 pf_ = __builtin_bit_cast(bf16x8, pw_); \
            _Pragma("unroll") for (int dt = 0; dt < 2; ++dt) { const int dd_ = dt * 32 + r32; \
                const bf16x8 vf_ = *(const LAS bf16x8*)(buf + 32768 + dd_ * 512 + ((((kt) * 4 + 2 * s2 + hi) ^ (dd_ & 15)) << 4)); \
                ot[dt] = __builtin_amdgcn_mfma_f32_32x32x16_bf16(vf_, pf_, ot[dt], 0, 0, 0); } } } while (0)
__device__ __forceinline__ void attn_phase(const Params& P, LAS unsigned char* lds, int G, const int tid) {
    unsigned char* ws = P.ws;
    LAS int* pre = (LAS int*)(lds + MISC_OFF);
    LAS int* wt = pre + 1032;
    const int* lcnt = (const int*)(ws + WS_CTL) + CW_LCNT;
    { const int c0 = lcnt[2 * tid], c1 = lcnt[2 * tid + 1]; pre[1040 + 2 * tid] = c0; pre[1040 + 2 * tid + 1] = c1; }
    block_prefix_1024(pre, wt, tid, [&](int i) { return (pre[1040 + i] + 255) >> 8; });
    const int total = __builtin_amdgcn_readfirstlane(pre[1024]), nunits = total + NBH * NBLK;
    const int lane = tid & 63, wid = __builtin_amdgcn_readfirstlane(tid >> 6), r32 = lane & 31, hi = lane >> 5, rq = wid * 32 + r32;
    float gq = 0.f, gk = 0.f;
    for (int d = 0; d < HD; ++d) { gq = fmaxf(gq, fabsf(P.in[I_QG][d])); gk = fmaxf(gk, fabsf(P.in[I_KG][d])); }
    const float negB = -(64.0f * QSCALE * 1.02f) * gq * gk;
    f32x16 cinit;
#pragma unroll
    for (int r = 0; r < 16; ++r) cinit[r] = negB;
    LAS int* dtab = pre + 2080;
    if (tid < 64) {
        const int uu = (int)blockIdx.x + tid * G;
        if (uu < nunits) {
            LAS int* e = dtab + tid * 8;
            if (uu < total) {
                int lo = 0, hi2 = 1023;
                while (lo < hi2) { const int mid = (lo + hi2 + 1) >> 1; if (pre[mid] <= uu) lo = mid; else hi2 = mid - 1; }
                const int tile = uu - pre[lo], cnt = pre[1040 + lo];
                e[0] = lo >> 5; e[1] = lo & 31; e[2] = tile * 256; e[3] = min(256, cnt - tile * 256); e[4] = 0;
            } else { const int d = uu - total; e[0] = d >> 5; e[1] = d & 31; e[2] = 0; e[3] = 256; e[4] = 1; }
        }
    }
    __syncthreads();
    const int nmine = ((int)blockIdx.x < nunits) ? (nunits - 1 - (int)blockIdx.x) / G + 1 : 0;
#define ATT_DESC(i, D) ((i) < nmine ? ((D).bh = __builtin_amdgcn_readfirstlane(dtab[(i) * 8]), (D).j = __builtin_amdgcn_readfirstlane(dtab[(i) * 8 + 1]), (D).row0 = __builtin_amdgcn_readfirstlane(dtab[(i) * 8 + 2]), \
        (D).nrows = __builtin_amdgcn_readfirstlane(dtab[(i) * 8 + 3]), (D).diag = __builtin_amdgcn_readfirstlane(dtab[(i) * 8 + 4]), true) : false)
    AttnDesc cur, nxt, nn;
    int ui = 0;
    if (!ATT_DESC(0, cur)) return;
    bool has_next = ATT_DESC(1, nxt);
    unsigned ecur = attn_entry(P, cur, rq), enext = has_next ? attn_entry(P, nxt, rq) : 0u;
    attn_dma(P, lds, cur, wid, lane);
    bf16x8 qf[4], qn[4];
    attn_qload(P, qf, cur.bh, ecur, hi);
    asm volatile("s_waitcnt vmcnt(0) lgkmcnt(0)" ::: "memory"); __builtin_amdgcn_s_barrier();
    int b = 0;
    for (;;) {
        LAS unsigned char* buf = lds + b * 65536;
#ifdef PROBE_A
        const unsigned long long tu0_ = __builtin_amdgcn_s_memrealtime();
#endif
        const bool has_nn = has_next && ATT_DESC(ui + 2, nn);
        unsigned enn = 0u;
        if (has_nn) enn = attn_entry(P, nn, rq);
        if (has_next) { attn_dma(P, lds + (b ^ 1) * 65536, nxt, wid, lane); attn_qload(P, qn, nxt.bh, enext, hi); }
        else {
#pragma unroll
            for (int d0 = 0; d0 < 4; ++d0) qn[d0] = qf[d0]; }
        f32x16 ot[2];
#pragma unroll
        for (int r = 0; r < 16; ++r) { ot[0][r] = 0.f; ot[1][r] = 0.f; }
        float l = 0.f;
        if (!cur.diag) {
            f32x16 sA, sB;
            ATT_QK(sA, 0);
            ATT_QK(sB, 1); ATT_PV(sA, 0);
            ATT_QK(sA, 2); ATT_PV(sB, 1);
            ATT_QK(sB, 3); ATT_PV(sA, 2);
            ATT_QK(sA, 4); ATT_PV(sB, 3);
            ATT_QK(sB, 5); ATT_PV(sA, 4);
            ATT_QK(sA, 6); ATT_PV(sB, 5);
            ATT_QK(sB, 7); ATT_PV(sA, 6);
            ATT_PV(sB, 7);
        } else {
            int qrel = r32 - 8 * hi; asm volatile("" : "+v"(qrel));
#pragma unroll
            for (int kt = 0; kt < 8; ++kt) {
                if (kt <= wid) {
                    f32x16 sA; ATT_QK(sA, kt);
                    if (kt == wid) {
#pragma unroll
                        for (int r = 0; r < 16; ++r) if ((r & 3) + 4 * ((r >> 2) & 1) + 16 * (r >> 3) > qrel) sA[r] = -INFINITY;
                    }
                    ATT_PV(sA, kt);
                }
            }
        }
        l += shx(l, 32, lane);
#ifdef PROBE_A
        const unsigned long long tw0_ = __builtin_amdgcn_s_memrealtime();
        if (blockIdx.x == PROBE_BLK && tid == PROBE_TID) { LAS unsigned long long* t_ = (LAS unsigned long long*)(lds + MISC_OFF + 12288); if (cur.diag) { t_[35] += tw0_ - tu0_; t_[36] += 100; } else { t_[33] += tw0_ - tu0_; t_[34] += 100; } }
        asm volatile("s_waitcnt vmcnt(0) lgkmcnt(0)" ::: "memory");
        const unsigned long long tw1_ = __builtin_amdgcn_s_memrealtime();
        __builtin_amdgcn_s_barrier(); asm volatile("" ::: "memory");
        if (blockIdx.x == PROBE_BLK && tid == 0) { LAS unsigned long long* t_ = (LAS unsigned long long*)(lds + MISC_OFF + 12288); t_[30] += tw1_ - tw0_; t_[32] += __builtin_amdgcn_s_memrealtime() - tw1_; }
#else
        asm volatile("s_waitcnt vmcnt(0) lgkmcnt(0)" ::: "memory"); __builtin_amdgcn_s_barrier(); asm volatile("" ::: "memory");
#endif
        if (rq < cur.nrows) {
            const int spos = ecur & 0x1fff, slot = ecur >> 13;
            const size_t prow = ((size_t)((cur.bh >> 3) * SEQ + spos) * NH + (cur.bh & 7)) * 4 + slot;
            if (hi == 0) ((f32x2*)(ws + WS_PML))[prow] = (f32x2){0.f, l};
        }
        {
            const int spos = ecur & 0x1fff, slot = ecur >> 13;
            const size_t prow = ((size_t)((cur.bh >> 3) * SEQ + spos) * NH + (cur.bh & 7)) * 4 + slot;
            const float inv = 1.0f / l;
            bf16_t* po = (bf16_t*)P.out + prow * HD;
#pragma unroll
            for (int dt = 0; dt < 2; ++dt)
#pragma unroll
                for (int gp = 0; gp < 2; ++gp) {
                    const int gA = 2 * gp, gB = 2 * gp + 1;
                    const unsigned ax = pk2(ot[dt][4 * gA] * inv, ot[dt][4 * gA + 1] * inv), ay = pk2(ot[dt][4 * gA + 2] * inv, ot[dt][4 * gA + 3] * inv);
                    const unsigned bx = pk2(ot[dt][4 * gB] * inv, ot[dt][4 * gB + 1] * inv), by = pk2(ot[dt][4 * gB + 2] * inv, ot[dt][4 * gB + 3] * inv);
                    const auto rx = __builtin_amdgcn_permlane32_swap(ax, bx, false, false), ry = __builtin_amdgcn_permlane32_swap(ay, by, false, false);
                    const u32x4 w = {rx[0], ry[0], rx[1], ry[1]};
                    if (rq < cur.nrows) *(u32x4*)(po + dt * 32 + (hi ? gB : gA) * 8) = w;
                }
        }
        if (!has_next) break;
        cur = nxt; nxt = nn; has_next = has_nn; ++ui; b ^= 1; ecur = enext; enext = enn;
#pragma unroll
        for (int d0 = 0; d0 < 4; ++d0) qf[d0] = qn[d0];
    }
    asm volatile("s_waitcnt vmcnt(0)" ::: "memory");
    __syncthreads();
}
#undef ATT_QK
#undef ATT_PV
#undef ATT_DESC

__device__ __forceinline__ void combine_phase(const Params& P, int G, const int tid) {
    unsigned char* ws = P.ws;
    const f32x2* PML = (const f32x2*)(ws + WS_PML); const bf16_t* PO = (const bf16_t*)P.out; bf16_t* ATT = (bf16_t*)(ws + WS_ATT);
    constexpr int NIT = T * NH * 4;
    for (int idx0 = blockIdx.x * 512 + tid; idx0 < NIT; idx0 += 2 * G * 512) {
        float ll[2][4]; u32x4 pw[2][4][2];
#pragma unroll
        for (int t = 0; t < 2; ++t) {
            const int idx = idx0 + t * G * 512; const bool in = idx < NIT; const int ii = in ? idx : idx0;
            const int qd = ii & 3, th = ii >> 2, token = th >> 3, qblk = (token & (SEQ - 1)) >> 8, nv = qblk < 3 ? qblk : 3;
#pragma unroll
            for (int sl = 0; sl < 4; ++sl) {
                const bool v = (sl < nv) || (sl == 3);
                ll[t][sl] = v ? PML[(size_t)th * 4 + sl].y : 0.f;
                const u32x4* pp = (const u32x4*)(PO + ((size_t)th * 4 + (v ? sl : 3)) * HD + qd * 16);
                pw[t][sl][0] = pp[0]; pw[t][sl][1] = pp[1];
            }
        }
#pragma unroll
        for (int t = 0; t < 2; ++t) {
            const int idx = idx0 + t * G * 512; if (idx >= NIT) break;
            const int qd = idx & 3, th = idx >> 2, token = th >> 3, head = th & 7;
            float o[16];
#pragma unroll
            for (int i = 0; i < 16; ++i) o[i] = 0.f;
            float W = 0.f;
#pragma unroll
            for (int sl = 0; sl < 4; ++sl) {
                const float w = ll[t][sl]; W += w;
                f32x4 a, b, c, d; unpk8(pw[t][sl][0], a, b); unpk8(pw[t][sl][1], c, d);
#pragma unroll
                for (int i = 0; i < 4; ++i) { o[i] += w * a[i]; o[4 + i] += w * b[i]; o[8 + i] += w * c[i]; o[12 + i] += w * d[i]; }
            }
            const float inv = 1.0f / W;
            u32x4 w0, w1;
            w0.x = pk2(o[0] * inv, o[1] * inv); w0.y = pk2(o[2] * inv, o[3] * inv); w0.z = pk2(o[4] * inv, o[5] * inv); w0.w = pk2(o[6] * inv, o[7] * inv);
            w1.x = pk2(o[8] * inv, o[9] * inv); w1.y = pk2(o[10] * inv, o[11] * inv); w1.z = pk2(o[12] * inv, o[13] * inv); w1.w = pk2(o[14] * inv, o[15] * inv);
            u32x4* dp = (u32x4*)(ATT + (size_t)token * SSMW + head * HD + qd * 16);
            dp[0] = w0; dp[1] = w1;
        }
    }
}

__device__ __forceinline__ void route_phase(const Params& P, LAS unsigned char* lds, int G, const int tid) {
    unsigned char* ws = P.ws;
    const int lane = tid & 63, wid = __builtin_amdgcn_readfirstlane(tid >> 6), rr = lane & 15, kq = lane >> 4;
    LAS float* lg = (LAS float*)(lds + 65536 + wid * 3200);
    LAS int* he = (LAS int*)(lds + MISC_OFF);
    LAS int* hp = he + 32;
    LAS int* be = hp + 112;
    LAS int* bp = be + 32;
    int* gcnt = (int*)(ws + WS_CTL);
    const bf16_t* WHL = (const bf16_t*)(ws + WS_WRT);
    const bf16_t* X1H = (const bf16_t*)(ws + WS_X1B); const bf16_t* X1L = (const bf16_t*)(ws + WS_X1L);
    constexpr int WROW = 136;
    constexpr int NSTG = 8, STG_BYTES = 96 * WROW * 2;
    for (int base = 0; base < T / 16; base += G * 8) {
        const int tile = base + blockIdx.x * 8 + wid; const bool active = tile < T / 16;
        if (tid < 144) he[tid] = 0;
        u32x4 wq[3];
#pragma unroll
        for (int i = 0; i < 3; ++i) { const int pc = tid + 512 * i, row = pc >> 4, ch = pc & 15; wq[i] = *(const u32x4*)(WHL + (size_t)row * DM + ch * 8); }
#pragma unroll
        for (int i = 0; i < 3; ++i) { const int pc = tid + 512 * i, row = pc >> 4, ch = pc & 15; *(LAS u32x4*)(lds + (row * WROW + ch * 8) * 2) = wq[i]; }
        const size_t arow = (size_t)((active ? tile : 0) * 16 + rr) * DM + kq * 8;
        bf16x8 ah[4], al[4];
#pragma unroll
        for (int k = 0; k < 4; ++k) { ah[k] = *(const bf16x8*)(X1H + arow + k * 32); al[k] = (bf16x8){0, 0, 0, 0, 0, 0, 0, 0}; }
        f32x4 acc[3]; float ssq = 0.f;
#pragma unroll
        for (int ct = 0; ct < 3; ++ct) acc[ct] = (f32x4){0.f, 0.f, 0.f, 0.f};
        __syncthreads();
#pragma unroll 1
        for (int q = 0; q < NSTG; ++q) {
            LAS unsigned char* wb = lds + (q & 1) * STG_BYTES;
            const int qn = (q + 1 < NSTG) ? q + 1 : q;
#pragma unroll
            for (int i = 0; i < 3; ++i) { const int pc = tid + 512 * i, row = pc >> 4, ch = pc & 15; wq[i] = *(const u32x4*)(WHL + (size_t)row * DM + qn * 128 + ch * 8); }
            bf16x8 nh[4], nl[4];
#pragma unroll
            for (int k = 0; k < 4; ++k) { nh[k] = *(const bf16x8*)(X1H + arow + qn * 128 + k * 32); nl[k] = (bf16x8){0, 0, 0, 0, 0, 0, 0, 0}; }
#pragma unroll
            for (int k = 0; k < 4; ++k) {
                { const u32x4 hw = __builtin_bit_cast(u32x4, ah[k]), lw = __builtin_bit_cast(u32x4, al[k]); f32x4 h0, h1, l0, l1; unpk8(hw, h0, h1); unpk8(lw, l0, l1);
                  const f32x4 x0 = h0 + l0, x1 = h1 + l1; ssq += (x0.x * x0.x + x0.y * x0.y) + (x0.z * x0.z + x0.w * x0.w) + (x1.x * x1.x + x1.y * x1.y) + (x1.z * x1.z + x1.w * x1.w); }
#pragma unroll
                for (int ct = 0; ct < 3; ++ct) {
                    const LAS unsigned char* bpw = wb + ((ct * 16 + rr) * WROW + k * 32 + kq * 8) * 2;
                    const bf16x8 bh = *(const LAS bf16x8*)bpw, bl = *(const LAS bf16x8*)(bpw + 48 * WROW * 2);
                    acc[ct] = __builtin_amdgcn_mfma_f32_16x16x32_bf16(ah[k], bh, acc[ct], 0, 0, 0);
                    acc[ct] = __builtin_amdgcn_mfma_f32_16x16x32_bf16(ah[k], bl, acc[ct], 0, 0, 0);
                }
            }
            {
                LAS unsigned char* wn = lds + ((q + 1) & 1) * STG_BYTES;
#pragma unroll
                for (int i = 0; i < 3; ++i) { const int pc = tid + 512 * i, row = pc >> 4, ch = pc & 15; *(LAS u32x4*)(wn + (row * WROW + ch * 8) * 2) = wq[i]; }
#pragma unroll
                for (int k = 0; k < 4; ++k) { ah[k] = nh[k]; al[k] = nl[k]; }
            }
            __syncthreads();
        }
        int E0 = 0, E1 = 0, pp = 0, sl0 = 0, re0 = 0, re1 = 0, rp = 0; float w0 = 0.f, w1 = 0.f, r2 = 0.f;
        if (active) {
            ssq += shx(ssq, 16, lane); ssq += shx(ssq, 32, lane);
#pragma unroll
            for (int ct = 0; ct < 3; ++ct)
#pragma unroll
                for (int rg = 0; rg < 4; ++rg) lg[(kq * 4 + rg) * 49 + ct * 16 + rr] = acc[ct][rg];
            asm volatile("s_waitcnt lgkmcnt(0)" ::: "memory"); __builtin_amdgcn_wave_barrier();
            if (lane < 16) {
                r2 = 1.0f / sqrtf(ssq * (1.f / DM) + EPS);
                const LAS float* row = lg + lane * 49;
                float gl[4]; int gi = 0; float gmax = -INFINITY;
#pragma unroll
                for (int c = 0; c < 4; ++c) { gl[c] = row[c] * r2 + P.in[I_BRG][c]; if (gl[c] > gmax) { gmax = gl[c]; gi = c; } }
                float den = 0.f;
#pragma unroll
                for (int c = 0; c < 4; ++c) den += __expf(gl[c] - gmax);
                const float gp = 1.0f / den;
                float ev[8];
#pragma unroll
                for (int e = 0; e < 8; ++e) ev[e] = row[4 + gi * 8 + e] * r2 + P.in[I_BREX][gi * 8 + e];
                int i0 = 0; float v0 = -INFINITY;
#pragma unroll
                for (int e = 0; e < 8; ++e) if (ev[e] > v0) { v0 = ev[e]; i0 = e; }
                int i1 = 0; float v1 = -INFINITY;
#pragma unroll
                for (int e = 0; e < 8; ++e) if (e != i0 && ev[e] > v1) { v1 = ev[e]; i1 = e; }
                const float tt = __expf(v1 - v0);
                w0 = gp / (1.0f + tt); w1 = gp * tt / (1.0f + tt);
                const int lo = i0 < i1 ? i0 : i1, hh = i0 < i1 ? i1 : i0;
                pp = gi * 28 + (lo * (15 - lo)) / 2 + (hh - lo - 1);
                sl0 = (i0 == lo) ? 0 : 1;
                E0 = gi * 8 + i0; E1 = gi * 8 + i1;
                re0 = atomicAdd((int*)&he[E0], 1); re1 = atomicAdd((int*)&he[E1], 1); rp = atomicAdd((int*)&hp[pp], 1);
            }
        }
        __syncthreads();
        if (tid < 144) { const int h = he[tid]; be[tid] = h ? atomicAdd(gcnt + (tid < 32 ? CW_ECNT + tid : CW_PCNT + tid - 32), h) : 0; }
        __syncthreads();
        if (active && lane < 16) {
            const int token = tile * 16 + lane;
            const int rankp = bp[pp] + rp;
            const size_t i0x = (size_t)E0 * T + be[E0] + re0, i1x = (size_t)E1 * T + be[E1] + re1;
            ((int*)(ws + WS_ELTOK))[i0x] = token; ((int*)(ws + WS_ELDST))[i0x] = (pp << 17) | (sl0 << 16) | rankp; ((float*)(ws + WS_ELW))[i0x] = w0; ((float*)(ws + WS_ELR2))[i0x] = r2;
            ((int*)(ws + WS_ELTOK))[i1x] = token; ((int*)(ws + WS_ELDST))[i1x] = (pp << 17) | ((1 - sl0) << 16) | rankp; ((float*)(ws + WS_ELW))[i1x] = w1; ((float*)(ws + WS_ELR2))[i1x] = r2;
            ((int*)(ws + WS_PLTOK))[(size_t)pp * T + rankp] = token;
        }
        __syncthreads();
    }
}

struct MoeTables { LAS int *ecnt, *efpre, *eplist, *pcnt, *pfpre, *pplist, *pairoff; int enfull, enpart, pnfull, pnpart; };
__device__ __forceinline__ MoeTables moe_tables(const Params& P, LAS unsigned char* lds, int tid) {
    MoeTables M;
    M.ecnt = (LAS int*)(lds + MISC_OFF); M.efpre = M.ecnt + 32; M.eplist = M.efpre + 40; M.pcnt = M.eplist + 32; M.pfpre = M.pcnt + 112; M.pplist = M.pfpre + 120; M.pairoff = M.pplist + 112;
    LAS int* hdr = M.pairoff + 120;
    const int* gcnt = (const int*)(P.ws + WS_CTL);
    if (tid < 32) M.ecnt[tid] = gcnt[CW_ECNT + tid];
    if (tid >= 64 && tid < 64 + NPAIR) M.pcnt[tid - 64] = gcnt[CW_PCNT + tid - 64];
    __syncthreads();
    if (tid == 0) { int s = 0, np = 0; for (int e = 0; e < NE; ++e) { M.efpre[e] = s; s += M.ecnt[e] >> 8; if (M.ecnt[e] & 255) M.eplist[np++] = e; } M.efpre[NE] = s; hdr[0] = s; hdr[1] = np; }
    if (tid == 64) { int s = 0, r = 0, np = 0; for (int p = 0; p < NPAIR; ++p) { M.pfpre[p] = s; M.pairoff[p] = r; s += M.pcnt[p] >> 8; r += ((M.pcnt[p] + 255) >> 8) * 256; if (M.pcnt[p] & 255) M.pplist[np++] = p; } M.pfpre[NPAIR] = s; M.pairoff[NPAIR] = r; hdr[2] = s; hdr[3] = np; }
    __syncthreads();
    M.enfull = __builtin_amdgcn_readfirstlane(hdr[0]); M.enpart = __builtin_amdgcn_readfirstlane(hdr[1]); M.pnfull = __builtin_amdgcn_readfirstlane(hdr[2]); M.pnpart = __builtin_amdgcn_readfirstlane(hdr[3]);
    return M;
}

constexpr int CW_BAR = 8192;
#define XB_TMO      128
#define XB_XCNT(j)  (256  + 64 * (j))
#define XB_XSUB(j)  (1280 + 64 * (j))
#define XB_XGEN(j)  (2304 + 64 * (j))
#define XB_TOP      3328
#define XB_TOPGEN   3392
#define XCD_BAR_WORDS 3456
#define XB_SPIN_CAP (1u << 18)
__device__ __forceinline__ unsigned xb_ld(unsigned* p)              { return __hip_atomic_load(p, __ATOMIC_RELAXED, __HIP_MEMORY_SCOPE_AGENT); }
__device__ __forceinline__ unsigned xb_add(unsigned* p, unsigned v) { return __hip_atomic_fetch_add(p, v, __ATOMIC_RELAXED, __HIP_MEMORY_SCOPE_AGENT); }
__device__ __forceinline__ unsigned xb_xcc_id() { return (unsigned)__builtin_amdgcn_s_getreg((3 << 11) | 20) & 0xFu; }
#define XB_SPIN(cond, bar) do { unsigned _sp = 0; while (cond) { __builtin_amdgcn_s_sleep(1); \
    if ((++_sp & 255u) == 0u) { if (xb_ld(&(bar)[XB_TMO])) break; if (_sp > XB_SPIN_CAP) { atomicAdd(&(bar)[XB_TMO], 1u); break; } } } } while (0)
struct XcdBarrier { unsigned* bar; unsigned x; volatile LAS unsigned* st; };
__device__ __forceinline__ XcdBarrier xcd_barrier_post(unsigned* bar, volatile LAS unsigned* st) {
    XcdBarrier b; b.bar = bar; b.x = xb_xcc_id(); b.st = st;
    if (threadIdx.x == 0) (void)xb_add(&bar[XB_XCNT(b.x)], 1u);
    return b;
}
__device__ __forceinline__ void xcd_barrier_complete(unsigned* bar, unsigned x, unsigned& nloc, unsigned& nx) {
    const unsigned G = gridDim.x * gridDim.y * gridDim.z;
    unsigned sum, cnt, mine, sp = 0u;
    for (;;) {
        sum = 0u; cnt = 0u; mine = 0u;
#pragma unroll
        for (unsigned j = 0; j < 16; ++j) { const unsigned c = xb_ld(&bar[XB_XCNT(j)]); sum += c; cnt += (c > 0u) ? 1u : 0u; mine = (j == x) ? c : mine; }
        if (sum == G) break;
        __builtin_amdgcn_s_sleep(1);
        if ((++sp & 255u) == 0u) { if (xb_ld(&bar[XB_TMO])) break; if (sp > XB_SPIN_CAP) { atomicAdd(&bar[XB_TMO], 1u); break; } }
    }
    nloc = mine > 0u ? mine : 1u; nx = cnt > 0u ? cnt : 1u;
}
__device__ __forceinline__ void xcd_barrier(const XcdBarrier& b, const int tid) {
    asm volatile("s_waitcnt vmcnt(0)" ::: "memory");
    __syncthreads();
    if (tid == 0) {
        unsigned* bar = b.bar;
        __builtin_amdgcn_s_waitcnt(0);
        unsigned nloc = b.st[0], nx = b.st[1];
        if (nloc == 0u) { xcd_barrier_complete(bar, b.x, nloc, nx); b.st[0] = nloc; b.st[1] = nx; }
        const unsigned old = xb_add(&bar[XB_XSUB(b.x)], 1u);
        const unsigned gen = old / nloc;
        if (old + 1u == (gen + 1u) * nloc) {
            __builtin_amdgcn_fence(__ATOMIC_RELEASE, "agent");
            asm volatile("s_waitcnt vmcnt(0)" ::: "memory");
            const unsigned og = xb_add(&bar[XB_TOP], 1u);
            const unsigned tg = og / nx;
            if (og + 1u == (tg + 1u) * nx) xb_add(&bar[XB_TOPGEN], 1u);
            else XB_SPIN(xb_ld(&bar[XB_TOPGEN]) == tg, bar);
            __builtin_amdgcn_fence(__ATOMIC_ACQUIRE, "agent");
            xb_add(&bar[XB_XGEN(b.x)], 1u);
            asm volatile("s_waitcnt vmcnt(0)" ::: "memory");
        } else {
            XB_SPIN(xb_ld(&bar[XB_XGEN(b.x)]) == gen, bar);
            __builtin_amdgcn_fence(__ATOMIC_ACQUIRE, "agent");
            asm volatile("s_waitcnt vmcnt(0)" ::: "memory");
        }
    }
    __syncthreads();
}

#ifndef N_PHASES
#define N_PHASES 11
#endif
__global__ void __launch_bounds__(512, 2) hybrid_fwd(Params P) {
    extern __shared__ __attribute__((aligned(16))) unsigned char lds_raw[];
    LAS unsigned char* lds = (LAS unsigned char*)lds_raw;
    const int G = gridDim.x, c = blockIdx.x, wave = __builtin_amdgcn_readfirstlane(threadIdx.x >> 6);
#define FT fresh_tid(wave)
    volatile LAS unsigned* bst = (volatile LAS unsigned*)(lds + LDS_BYTES - 16);
    if (threadIdx.x == 0) { bst[0] = 0u; bst[1] = 0u; }
    __syncthreads();
    const XcdBarrier bar = xcd_barrier_post((unsigned*)(P.ws + WS_CTL) + CW_BAR, bst);
#define GRID_SYNC() xcd_barrier(bar, FT)
#ifndef PROBE_TID
#define PROBE_TID 0
#endif
#ifdef PROBE_A
    LAS unsigned long long* tsl = (LAS unsigned long long*)(lds + MISC_OFF + 12288);
#define STAMP(i) do { if (blockIdx.x == PROBE_BLK && threadIdx.x == 0) tsl[i] = __builtin_amdgcn_s_memrealtime(); } while (0)
#else
#define STAMP(i) do { } while (0)
#endif
    STAMP(0);
#ifdef PROBE_A
    if (blockIdx.x == PROBE_BLK && threadIdx.x == 0) { for (int i_ = 30; i_ < 40; ++i_) tsl[i_] = 0; }
#endif
    unsigned char* ws = P.ws;
#define BF(off) ((bf16_t*)(ws + (off)))
    phase0(P, lds, G, FT);
    GRID_SYNC();
    STAMP(1);
    { ProjOrder S; S.g.init(T / 256, 1536 / 256, DM, DM, DM, G, c); S.nmain = (T / 256) * 6;
      EpiProj E{BF(WS_UGS), BF(WS_QH), BF(WS_KH), BF(WS_VT), P.in[I_QG], P.in[I_KG], (const float*)(ws + WS_ROPE), (float*)(ws + WS_KMEAN), (LAS float*)(lds + MISC_OFF)};
      gk::gemm_phase<EpiProj, ProjOrder, false, false>(lds, FT, (const bf16_t*)ws, DM, (const bf16_t*)ws, DM, S, E); }
    GRID_SYNC();
    STAMP(2);
    select_phase(P, lds, G, FT);
    STAMP(22);
    STAMP(23);
    {
        const int nel = NG * 4, nslots = (G > nel) ? nel + 2 * (G - nel) : G;
        const int s0 = (G > nel && c >= nel) ? nel + 2 * (c - nel) : c, ns = (G > nel && c >= nel) ? 2 : 1;
        for (int k = 0; k < ns; ++k) tg_expand(P, G, FT, s0 + k, nslots);
        STAMP(24);
        for (int k = 0; k < ns; ++k) { late_transposes(P, lds, G, FT, 0, s0 + k, nslots); late_transposes(P, lds, G, FT, 1, s0 + k, nslots); }
    }
    { ElocOrder S{G, c}; EpiEloc E{(float*)(ws + WS_ELOC)};
      gk::gemm_phase<EpiEloc, ElocOrder, false, false>(lds, FT, BF(WS_UGS), KU, BF(WS_MIN), NTC, S, E); }
    GRID_SYNC();
    STAMP(3);
    STAMP(4);
    for (int L = c; L < NG * 8; L += G) { const int g = L >> 3, bb = (L >> 1) & 3; carry_scan(P, lds, (g * 4 + bb) * 2, FT); carry_scan(P, lds, (g * 4 + bb) * 2 + 1, FT); }
    asm volatile("s_waitcnt vmcnt(0)" ::: "memory"); __syncthreads();
    { SsmOrder S{G, c}; EpiSsm E{BF(WS_Z)};
      gk::gemm_phase<EpiSsm, SsmOrder, false, false>(lds, FT, BF(WS_UGS), KU, BF(WS_TG), KU, S, E); }
    STAMP(20);
    attn_phase(P, lds, G, FT);
    STAMP(21);
    GRID_SYNC();
    STAMP(5);
    combine_phase(P, G, FT);
    STAMP(25);
    { gk::GridOrder S; S.init(T / 256, SSMW / 256, SSMW, SSMW, SSMW, G, c);
      EpiGlu E{BF(WS_Z), P.in[I_BGLU], BF(WS_OS)};
      gk::gemm_phase<EpiGlu, gk::GridOrder, false, false>(lds, FT, BF(WS_Z), SSMW, BF(WS_WGLU), SSMW, S, E); }
    GRID_SYNC();
    STAMP(6);
    { MergeOrder S; S.g.init(T / 256, DM / 256, DM, DM, DM, G, c); S.order = (c >> 3) & 1;
      EpiMerge E{BF(WS_MG), BF(WS_TMP)};
      gk::gemm_phase<EpiMerge, MergeOrder, false, false, true, 6>(lds, FT, (const bf16_t*)ws, DM, (const bf16_t*)ws, DM, S, E); }
    GRID_SYNC();
    STAMP(7);
    { gk::GridOrder S; S.init(T / 256, DM / 256, DM, DM, DM, G, c);
      EpiOut E{P.in[I_X], BF(WS_X1B), nullptr};
      gk::gemm_phase<EpiOut, gk::GridOrder, false, false, false, 7>(lds, FT, BF(WS_MG), DM, BF(WS_WOUT), DM, S, E); }
    GRID_SYNC();
    STAMP(8);
    route_phase(P, lds, G, FT);
    GRID_SYNC();
    STAMP(9);
    MoeTables M = moe_tables(P, lds, FT);
    { GUOrder S{M.efpre, M.ecnt, M.eplist, M.enfull, M.enpart, (const int*)(ws + WS_ELTOK), G, c};
      EpiGU E{(const int*)(ws + WS_ELDST), (const float*)(ws + WS_ELW), (const float*)(ws + WS_ELR2), BF(WS_ACT), M.pairoff};
      gk::gemm_phase<EpiGU, GUOrder, true, false>(lds, FT, BF(WS_X1B), DM, BF(WS_WGU), DM, S, E); }
    GRID_SYNC();
    STAMP(10);
    { DNOrder S{M.pfpre, M.pcnt, M.pairoff, M.pplist, M.pnfull, M.pnpart, G, c};
      EpiDN E{(const int*)(ws + WS_PLTOK), BF(WS_X1B), BF(WS_X1L), P.out};
      gk::gemm_phase<EpiDN, DNOrder, false, true>(lds, FT, BF(WS_ACT), 256, BF(WS_WDN), NE * DE, S, E); }
    STAMP(11);
#ifdef PROBE_A
    GRID_SYNC();
    if (blockIdx.x == PROBE_BLK && threadIdx.x == 0) { const float us = (float)(tsl[PROBE_B] - tsl[PROBE_A]) * 0.01f; P.out[0] += us * PROBE_SCALE; }
#endif
#undef BF
#undef FT
#undef GRID_SYNC
}

extern "C" void kernel_launch(void* const* d_in, const int* in_sizes, int n_in, void* d_out, int out_size, void* d_ws, size_t ws_size, hipStream_t stream) {
    static int grid = 0;
    if (grid == 0) {
        if (n_in != 26 || in_sizes[0] != T * DM || out_size != T * DM || ws_size < WS_END) {
            fprintf(stderr, "kernel_launch: unexpected shapes (n_in %d, in0 %d, out %d, ws %zu)\n", n_in, n_in > 0 ? in_sizes[0] : -1, out_size, ws_size); grid = -1; return; }
        int dev = 0, cus = 0, per_cu = 0;
        (void)hipGetDevice(&dev);
        (void)hipDeviceGetAttribute(&cus, hipDeviceAttributeMultiprocessorCount, dev);
        (void)hipFuncSetAttribute((const void*)hybrid_fwd, hipFuncAttributeMaxDynamicSharedMemorySize, LDS_BYTES);
        (void)hipOccupancyMaxActiveBlocksPerMultiprocessor(&per_cu, (const void*)hybrid_fwd, 512, LDS_BYTES);
        if (per_cu < 1) { fprintf(stderr, "kernel_launch: occupancy query says %d blocks/CU\n", per_cu); grid = -1; return; }
        grid = cus * (per_cu > 1 ? 1 : per_cu);
        (void)hipGetLastError();
    }
    if (grid < 0) return;
    (void)hipMemsetAsync((char*)d_ws + WS_CTL, 0, 64 * 1024, stream);
    Params p{};
    for (int i = 0; i < 26; ++i) p.in[i] = (const float*)d_in[i];
    p.out = (float*)d_out; p.ws = (unsigned char*)d_ws;
    void* args[] = {&p};
    hipError_t e = hipLaunchCooperativeKernel((const void*)hybrid_fwd, dim3(grid), dim3(512), args, LDS_BYTES, stream);
    if (e != hipSuccess) fprintf(stderr, "cooperative launch failed: %s (grid %d)\n", hipGetErrorString(e), grid);
}
```

```cpp
#include <hip/hip_runtime.h>
#include <hip/hip_cooperative_groups.h>
#include <cstdio>
#include <cstdint>
namespace cg = cooperative_groups;

#define LAS __attribute__((address_space(3)))
typedef unsigned short bf16_t;
typedef short bf16x8 __attribute__((ext_vector_type(8)));
typedef float f32x2 __attribute__((ext_vector_type(2)));
typedef float f32x4 __attribute__((ext_vector_type(4)));
typedef float f32x16 __attribute__((ext_vector_type(16)));
typedef unsigned u32x2 __attribute__((ext_vector_type(2)));
typedef unsigned u32x4 __attribute__((ext_vector_type(4)));
typedef __bf16 bf16x2_t __attribute__((ext_vector_type(2)));

constexpr int NB = 4, SEQ = 8192, T = NB * SEQ, DM = 1024, NIN = 4096;
constexpr int NH = 8, HD = 64, NBH = NB * NH, NBLK = 32, BLK = 256;
constexpr int SSMW = 512, NG = 32, GC = 16, NS = 64;
constexpr int CL = 32, NCH = SEQ / CL, CROWS = NB * NCH  , KU = 128 + CL * GC  , NTC = CL * GC  ;
constexpr int NE = 32, DE = 128, NPAIR = 112;
constexpr float EPS = 1e-6f;
constexpr float QSCALE = 0.125f * 1.4426950408889634f;

constexpr size_t MiB = 1u << 20;
constexpr size_t WS_CTL = 0;
constexpr size_t WS_KMEAN = 1 * MiB;
constexpr size_t WS_A32 = WS_KMEAN + 256 * 1024;
constexpr size_t WS_WRT = WS_A32 + 64 * 1024;
constexpr size_t WS_ROPE = 1 * MiB + 512 * 1024;
constexpr size_t WS_KC = 2 * MiB;
constexpr size_t WS_MIN = 3 * MiB;
constexpr size_t WS_WIN = 8 * MiB;
constexpr size_t WS_WGLU = 16 * MiB;
constexpr size_t WS_WPS = 17 * MiB;
constexpr size_t WS_WPA = 18 * MiB;
constexpr size_t WS_WOUT = 19 * MiB;
constexpr size_t WS_WGU = 21 * MiB;
constexpr size_t WS_WDN = 37 * MiB;
constexpr size_t WS_MOUT = 46 * MiB;
constexpr size_t WS_A = 50 * MiB;
constexpr size_t WS_XN = 210 * MiB;
constexpr size_t WS_LISTS = WS_A;
constexpr size_t WS_TG = WS_A + 16 * MiB;
constexpr size_t WS_ELOC = WS_A + 40 * MiB;
constexpr size_t WS_ATT = WS_A;
constexpr size_t WS_OS = WS_A + 32 * MiB;
constexpr size_t WS_B = 114 * MiB;
constexpr size_t WS_QH = WS_B, WS_KH = WS_B + 32 * MiB, WS_VT = WS_B + 64 * MiB;
constexpr size_t WS_MG = WS_B;
constexpr size_t WS_ACT = WS_B;
constexpr size_t WS_ELTOK = WS_B + 64 * MiB;
constexpr size_t WS_ELDST = WS_B + 68 * MiB;
constexpr size_t WS_ELW = WS_B + 72 * MiB;
constexpr size_t WS_ELR2 = WS_B + 76 * MiB;
constexpr size_t WS_PLTOK = WS_B + 80 * MiB;
constexpr size_t WS_C = 210 * MiB;
constexpr size_t WS_TMP = WS_C + 64 * MiB;
constexpr size_t WS_X1B = WS_C;
constexpr size_t WS_X1L = WS_C + 64 * MiB;
constexpr size_t WS_UGS = 338 * MiB;
constexpr size_t WS_Z = 380 * MiB;
constexpr size_t WS_PML = 412 * MiB;
constexpr size_t WS_KPART = 412 * MiB;
constexpr size_t WS_END = 420 * MiB;
constexpr int CW_LCNT = 1024;
constexpr int CW_ECNT = 4096;
constexpr int CW_PCNT = 4224;

constexpr int RING_BYTES = 131072;
constexpr int MISC_OFF = RING_BYTES;
constexpr int LDS_BYTES = 147456;

__device__ __forceinline__ unsigned pk2(float lo, float hi) { f32x2 v = {lo, hi}; bf16x2_t b = __builtin_convertvector(v, bf16x2_t); return __builtin_bit_cast(unsigned, b); }
__device__ __forceinline__ bf16_t f2bf(float f) { return (bf16_t)(pk2(f, 0.f) & 0xffffu); }
__device__ __forceinline__ float bflo(unsigned w) { return __uint_as_float(w << 16); }
__device__ __forceinline__ float bfhi(unsigned w) { return __uint_as_float(w & 0xffff0000u); }
__device__ __forceinline__ float bf2f(bf16_t b) { return __uint_as_float(((unsigned)b) << 16); }
__device__ __forceinline__ u32x4 pk8(f32x4 a, f32x4 b) { u32x4 w; w.x = pk2(a[0], a[1]); w.y = pk2(a[2], a[3]); w.z = pk2(b[0], b[1]); w.w = pk2(b[2], b[3]); return w; }
__device__ __forceinline__ void unpk8(u32x4 w, f32x4& a, f32x4& b) { a = (f32x4){bflo(w.x), bfhi(w.x), bflo(w.y), bfhi(w.y)}; b = (f32x4){bflo(w.z), bfhi(w.z), bflo(w.w), bfhi(w.w)}; }
__device__ __forceinline__ float sigmoidf_(float x) { return 1.0f / (1.0f + __expf(-x)); }
__device__ __forceinline__ float gelu_tanh(float x) { const float u = 0.7978845608028654f * (x + 0.044715f * x * x * x); const float e = __expf(-2.0f * u); return x / (1.0f + e); }
__device__ __forceinline__ int lane_id() { unsigned z = 0u; asm volatile("" : "+v"(z)); return __builtin_amdgcn_mbcnt_hi(~0u, __builtin_amdgcn_mbcnt_lo(~0u, z)); }
__device__ __forceinline__ float shx(float v, int mask, int lane) { return __uint_as_float(__builtin_amdgcn_ds_bpermute((lane ^ mask) << 2, __float_as_uint(v))); }
__device__ __forceinline__ int shup(int v, int o, int lane) { return __builtin_amdgcn_ds_bpermute((lane - o) << 2, v); }
__device__ __forceinline__ int fresh_tid(int wave) { int t = wave * 64 + lane_id(); asm volatile("" : "+v"(t)); return t; }
__device__ __forceinline__ float wave_sum(float v) {
    const int lane = lane_id();
#pragma unroll
    for (int o = 1; o < 64; o <<= 1) v += shx(v, o, lane);
    return v;
}

namespace gk {
constexpr int BM = 256, BK = 64, HALF = 128, HTB = HALF * BK * 2, STAGE_BYTES = 8 * HTB;
__device__ __forceinline__ int lds_byte(int r, int c) { const int st = (r >> 4) * 2 + (c >> 5), rr = r & 15, cc = c & 31, ob = rr * 64 + cc * 2; return st * 1024 + (ob ^ (((ob >> 9) & 1) << 5)); }
__device__ __forceinline__ void stage_rc(int b, int& R, int& C) { const int st = b / 1024, sb = b % 1024, swz = sb ^ (((sb >> 9) & 1) << 5); R = (st >> 1) * 16 + swz / 64; C = (st & 1) * 32 + (swz % 64) / 2; }
__device__ __forceinline__ int perm32(int rho) { const int n = rho >> 4, i = rho & 15; return 8 * (i >> 2) + 4 * n + (i & 3); }

struct Unit {
    int pm, pn;
    long aoff, boff;
    int nt;
    int nvalid;
    const int* rows;
    int bsplit; long bjump;
    int aux0, aux1;
    int lda, ldb;
};

template <class F> __device__ __forceinline__ void epi_rows(const f32x4 (&acc)[2][2][4][2], int wr, int wc, int fr, int fq, const F& f) {
#pragma unroll
    for (int ai = 0; ai < 2; ++ai)
#pragma unroll
        for (int m = 0; m < 4; ++m) {
            const int rl = ai * HALF + wr * 64 + m * 16 + fr;
#pragma unroll
            for (int bj = 0; bj < 2; ++bj) f(rl, bj * HALF + wc * 32 + 8 * fq, acc[ai][bj][m][0], acc[ai][bj][m][1]);
        }
}

template <class L, class FL, class FC> __device__ __forceinline__ void epi_rows2(const f32x4 (&acc)[2][2][4][2], int wr, int wc, int fr, int fq, const FL& fl, const FC& fc) {
#pragma unroll
    for (int ai = 0; ai < 2; ++ai) {
        L pre[4][2];
#pragma unroll
        for (int m = 0; m < 4; ++m)
#pragma unroll
            for (int bj = 0; bj < 2; ++bj) pre[m][bj] = fl(ai * HALF + wr * 64 + m * 16 + fr, bj * HALF + wc * 32 + 8 * fq);
#pragma unroll
        for (int m = 0; m < 4; ++m)
#pragma unroll
            for (int bj = 0; bj < 2; ++bj) fc(ai * HALF + wr * 64 + m * 16 + fr, bj * HALF + wc * 32 + 8 * fq, acc[ai][bj][m][0], acc[ai][bj][m][1], pre[m][bj]);
    }
}

#ifndef PROBE_PID
#define PROBE_PID -1
#endif
template <class Epi, class Sched, bool GATHER, bool BSPLIT, bool VARLD = false, int PID = 0>
__device__ __forceinline__ void gemm_phase(LAS unsigned char* lds, const int tid, const bf16_t* A, int lda, const bf16_t* Bt, int ldb, const Sched& S, const Epi& E) {
    const int wid = __builtin_amdgcn_readfirstlane(tid >> 6), lane = tid & 63, wr = wid >> 2, wc = wid & 3, fr = lane & 15, fq = lane >> 4;
    int Rr[2], Cc[2];
    unsigned voffA[2][2], voffB[2][2], voffN[2][2], voffBn[2][2];
#pragma unroll
    for (int i = 0; i < 2; ++i) {
        stage_rc(tid * 16 + i * 8192, Rr[i], Cc[i]);
        const int Rb = (Rr[i] & ~31) + perm32(Rr[i] & 31);
#pragma unroll
        for (int h = 0; h < 2; ++h) {
            voffA[h][i] = (unsigned)((h * HALF + Rr[i]) * lda + Cc[i]) * 2u;
            voffB[h][i] = (unsigned)((h * HALF + Rb) * ldb + Cc[i]) * 2u;
            voffN[h][i] = voffA[h][i]; voffBn[h][i] = voffB[h][i];
        }
    }
    constexpr size_t kstep = (size_t)(BK * 2);
    const unsigned ldsw = (unsigned)wid * 1024u;
    const int aoff = lds_byte(wr * 64 + fr, fq * 8), boff = lds_byte(wc * 32 + fr, fq * 8);
#define GK_SA(b, h) (((b) * 2 + (h)) * HTB)
#define GK_SB(b, h) ((4 + (b) * 2 + (h)) * HTB)
#define GK_STAGE(bufoff, gbase, voff) do { _Pragma("unroll") for (int _i = 0; _i < 2; ++_i) \
        __builtin_amdgcn_global_load_lds((const unsigned*)((const char*)(gbase) + (voff)[_i]), (LAS unsigned*)(lds + (bufoff) + ldsw + _i * 8192), 16, 0, 0); } while (0)
#define GK_LDA(dst, b, h) do { _Pragma("unroll") for (int m = 0; m < 4; ++m) _Pragma("unroll") for (int k = 0; k < 2; ++k) dst[m][k] = *(const LAS bf16x8*)(lds + GK_SA(b, h) + aoff + m * 2048 + k * 1024); } while (0)
#define GK_LDB(dst, b, h) do { _Pragma("unroll") for (int n = 0; n < 2; ++n) _Pragma("unroll") for (int k = 0; k < 2; ++k) dst[n][k] = *(const LAS bf16x8*)(lds + GK_SB(b, h) + boff + n * 2048 + k * 1024); } while (0)
#define GK_MMA(ai, bj, At, Bt_) do { __builtin_amdgcn_s_setprio(1); _Pragma("unroll") for (int m = 0; m < 4; ++m) _Pragma("unroll") for (int n = 0; n < 2; ++n) _Pragma("unroll") for (int k = 0; k < 2; ++k) \
        acc[ai][bj][m][n] = __builtin_amdgcn_mfma_f32_16x16x32_bf16(Bt_[n][k], At[m][k], acc[ai][bj][m][n], 0, 0, 0); __builtin_amdgcn_s_setprio(0); } while (0)
#define GK_WAIT_V(n) asm volatile("s_waitcnt vmcnt(" #n ")" ::: "memory")
#define GK_WAIT_L(n) asm volatile("s_waitcnt lgkmcnt(" #n ")" ::: "memory")
#define GK_BAR __builtin_amdgcn_s_barrier()
#define GK_SCHED __builtin_amdgcn_sched_barrier(0)
#define GK_GATHER(u, vo) do { if constexpr (GATHER) { _Pragma("unroll") for (int _h = 0; _h < 2; ++_h) _Pragma("unroll") for (int _i = 0; _i < 2; ++_i) { \
        const int _r = _h * HALF + Rr[_i]; const int _t = (_r < (u).nvalid) ? (u).rows[_r] : 0; vo[_h][_i] = (unsigned)(_t * lda + Cc[_i]) * 2u; } } } while (0)
#define GK_VARLD(u, vA, vB) do { if constexpr (VARLD) { _Pragma("unroll") for (int _h = 0; _h < 2; ++_h) _Pragma("unroll") for (int _i = 0; _i < 2; ++_i) { \
        const int _rb = (Rr[_i] & ~31) + perm32(Rr[_i] & 31); vA[_h][_i] = (unsigned)((_h * HALF + Rr[_i]) * (u).lda + Cc[_i]) * 2u; vB[_h][_i] = (unsigned)((_h * HALF + _rb) * (u).ldb + Cc[_i]) * 2u; } } } while (0)
#define GK_BP(u, base, t) ((base) + (size_t)(t) * kstep + ((BSPLIT && (t) >= (u).bsplit) ? (u).bjump : 0l))
    Unit cur, nxt; int ui = 0;
    if (!S.next(0, cur)) return;
    f32x4 acc[2][2][4][2];
#pragma unroll
    for (int a = 0; a < 2; ++a)
#pragma unroll
        for (int b = 0; b < 2; ++b)
#pragma unroll
            for (int m = 0; m < 4; ++m)
#pragma unroll
                for (int n = 0; n < 2; ++n) acc[a][b][m][n] = (f32x4){0.f, 0.f, 0.f, 0.f};
    bf16x8 At[4][2], B0[2][2], B1[2][2];
    const char* cA = (const char*)A + cur.aoff; const char* cB = (const char*)Bt + cur.boff;
    GK_GATHER(cur, voffA); GK_VARLD(cur, voffA, voffB);
    GK_STAGE(GK_SB(0, 0), GK_BP(cur, cB, 0), voffB[0]); GK_STAGE(GK_SB(0, 1), GK_BP(cur, cB, 0), voffB[1]); GK_STAGE(GK_SA(0, 0), cA, voffA[0]); GK_STAGE(GK_SA(0, 1), cA, voffA[1]);
    if (wr == 1) GK_BAR;
    GK_WAIT_V(2); GK_BAR;
    GK_STAGE(GK_SB(1, 0), GK_BP(cur, cB, 1), voffB[0]); GK_STAGE(GK_SA(1, 0), cA + kstep, voffA[0]); GK_STAGE(GK_SB(1, 1), GK_BP(cur, cB, 1), voffB[1]);
    GK_WAIT_V(6); GK_BAR;
    for (;;) {
        const bool has_next = S.next(ui + 1, nxt);
        if (!has_next) nxt = cur;
        const char* nA = has_next ? (const char*)A + nxt.aoff : cA; const char* nB = has_next ? (const char*)Bt + nxt.boff : cB;
        if constexpr (GATHER) { if (has_next) { GK_GATHER(nxt, voffN); } else {
#pragma unroll
            for (int h = 0; h < 2; ++h)
#pragma unroll
                for (int i = 0; i < 2; ++i) voffN[h][i] = voffA[h][i]; } }
        const int nt = cur.nt;
        const bool lo_rows = cur.nvalid > wr * 64, hi_rows = cur.nvalid > HALF + wr * 64;
        for (int t = 0; t < nt; t += 2) {
            const bool last = (t == nt - 2);
            const char* a1 = cA + (size_t)(t + 1) * kstep;
            const char* a2 = last ? nA : cA + (size_t)(t + 2) * kstep; const char* a3 = a2 + kstep;
            const char* b2 = last ? GK_BP(nxt, nB, 0) : GK_BP(cur, cB, t + 2);
            const char* b3 = last ? GK_BP(nxt, nB, 1) : GK_BP(cur, cB, t + 3);
            unsigned vA2[2][2], vB2[2][2];
#pragma unroll
            for (int h = 0; h < 2; ++h)
#pragma unroll
                for (int i = 0; i < 2; ++i) { vA2[h][i] = (GATHER && last) ? voffN[h][i] : voffA[h][i]; vB2[h][i] = voffB[h][i]; }
            if constexpr (VARLD) { if (last) { GK_VARLD(nxt, vA2, vB2); } }
            GK_LDB(B0, 0, 0); GK_LDB(B1, 0, 1); GK_SCHED; GK_LDA(At, 0, 0); GK_STAGE(GK_SA(1, 1), a1, voffA[1]);
            GK_WAIT_V(8); GK_WAIT_L(0); GK_BAR; if (lo_rows) { GK_MMA(0, 0, At, B0); GK_MMA(0, 1, At, B1); } GK_BAR; GK_SCHED;
            GK_LDA(At, 0, 1); GK_STAGE(GK_SB(0, 0), b2, vB2[0]); GK_STAGE(GK_SB(0, 1), b2, vB2[1]); GK_STAGE(GK_SA(0, 0), a2, vA2[0]);
            GK_WAIT_V(8); GK_WAIT_L(0); GK_BAR; if (hi_rows) { GK_MMA(1, 0, At, B0); GK_MMA(1, 1, At, B1); } GK_BAR; GK_SCHED;
            GK_LDB(B0, 1, 0); GK_LDB(B1, 1, 1); GK_SCHED; GK_LDA(At, 1, 0); GK_STAGE(GK_SA(0, 1), a2, vA2[1]);
            GK_WAIT_V(8); GK_WAIT_L(0); GK_BAR; if (lo_rows) { GK_MMA(0, 0, At, B0); GK_MMA(0, 1, At, B1); } GK_BAR; GK_SCHED;
            GK_LDA(At, 1, 1); GK_STAGE(GK_SB(1, 0), b3, vB2[0]); GK_STAGE(GK_SB(1, 1), b3, vB2[1]); GK_STAGE(GK_SA(1, 0), a3, vA2[0]);
            GK_WAIT_V(8); GK_WAIT_L(0); GK_BAR; if (hi_rows) { GK_MMA(1, 0, At, B0); GK_MMA(1, 1, At, B1); } GK_BAR; GK_SCHED;
        }
        if (wr == 0) GK_BAR;
#ifdef PROBE_A
        unsigned long long te0_ = 0; if (PID == PROBE_PID) te0_ = __builtin_amdgcn_s_memrealtime();
#endif
        E(acc, cur, wr, wc, fr, fq);
#ifdef PROBE_A
        if (PID == PROBE_PID) { const unsigned long long te1_ = __builtin_amdgcn_s_memrealtime(); asm volatile("s_waitcnt vmcnt(0)" ::: "memory"); if (blockIdx.x == PROBE_BLK && tid == PROBE_TID) { LAS unsigned long long* t_ = (LAS unsigned long long*)(lds + MISC_OFF + 12288); t_[37] += te1_ - te0_; t_[39] += __builtin_amdgcn_s_memrealtime() - te1_; t_[38] += 100; } }
#endif
        if (!has_next) break;
#pragma unroll
        for (int a = 0; a < 2; ++a)
#pragma unroll
            for (int b = 0; b < 2; ++b)
#pragma unroll
                for (int m = 0; m < 4; ++m)
#pragma unroll
                    for (int n = 0; n < 2; ++n) acc[a][b][m][n] = (f32x4){0.f, 0.f, 0.f, 0.f};
        cur = nxt; cA = nA; cB = nB; ++ui;
        if constexpr (GATHER || VARLD) {
#pragma unroll
            for (int h = 0; h < 2; ++h)
#pragma unroll
                for (int i = 0; i < 2; ++i) { if constexpr (GATHER) voffA[h][i] = voffN[h][i]; } }
        if constexpr (VARLD) { GK_VARLD(cur, voffA, voffB); }
        if (wr == 1) GK_BAR;
    }
    GK_WAIT_V(0);
    GK_BAR;
#undef GK_SA
#undef GK_SB
#undef GK_STAGE
#undef GK_LDA
#undef GK_LDB
#undef GK_MMA
#undef GK_WAIT_V
#undef GK_WAIT_L
#undef GK_BAR
#undef GK_SCHED
#undef GK_GATHER
#undef GK_VARLD
#undef GK_BP
}

struct GridOrder {
    int nM, nN, nwg, G, c, nt; long astep, bstep;
    __device__ void init(int nM_, int nN_, int K, int lda, int ldb, int G_, int c_) { nM = nM_; nN = nN_; nwg = nM * nN; G = G_; c = c_; nt = K / BK; astep = (long)BM * lda * 2; bstep = (long)BM * ldb * 2; }
    __device__ bool next(int i, Unit& u) const {
        const long L = (long)i * G + c; if (L >= nwg) return false;
        int wgid = (int)L; { const int q = nwg / 8, r = nwg % 8, xcd = wgid % 8, off = wgid / 8; wgid = (xcd < r ? xcd * (q + 1) : r * (q + 1) + (xcd - r) * q) + off; }
        const int WGM = 8, nig = WGM * nN, gid = wgid / nig, fm = gid * WGM, gsz = (nM - fm) < WGM ? (nM - fm) : WGM;
        u.pm = fm + ((wgid % nig) % gsz); u.pn = (wgid % nig) / gsz;
        u.aoff = u.pm * astep; u.boff = u.pn * bstep; u.nt = nt; u.nvalid = 256; u.rows = nullptr; u.bsplit = 1 << 30; u.bjump = 0; u.aux0 = 0; u.aux1 = 0; u.lda = 0; u.ldb = 0;
        return true;
    }
};
}

struct Params { const float* in[26]; float* out; unsigned char* ws; };
enum { I_X = 0, I_N1G, I_WIN, I_LAMRE, I_LAMIM, I_LOGDT, I_BRE, I_BIM, I_CRE, I_CIM, I_SSMD, I_WGLU, I_BGLU, I_QG, I_KG, I_WPS, I_WPA, I_WOUT, I_N2G, I_WRG, I_BRG, I_WRE, I_BREX, I_WGATE, I_WUP, I_WDOWN };

using gk::Unit; using gk::epi_rows; using gk::epi_rows2;
struct Pre1 { u32x4 a; }; struct Pre2 { u32x4 a, b; }; struct PreF2 { f32x4 a, b; };
typedef f32x4 Acc[2][2][4][2];

struct EpiProj {
    bf16_t *UGS, *QH, *KH, *VT; const float *QG, *KG, *ROPE; float* KMEAN; LAS float* misc;
    __device__ __forceinline__ void operator()(const Acc& acc, const Unit& u, int wr, int wc, int fr_, int fq_) const {
        int fr = fr_, fq = fq_; asm volatile("" : "+v"(fr), "+v"(fq));
        if (u.aux0) {
            const int tok0 = u.pn * 256, b = tok0 >> 13, blk = (tok0 & 8191) >> 8;
            epi_rows(acc, wr, wc, fr, fq, [&](int rl, int cl, f32x4 v0, f32x4 v1) {
                const int dim = u.pm * 256 + rl, h = dim >> 6, d = dim & 63;
                *(u32x4*)(VT + ((size_t)((b * NH + h) * NBLK + blk) * HD + d) * 256 + cl) = pk8(v0, v1);
            });
            return;
        }
        const int pn = u.pn, row0 = u.pm * 256;
        if (pn < 2) {
            epi_rows(acc, wr, wc, fr, fq, [&](int rl, int cl, f32x4 v0, f32x4 v1) {
                const int row = row0 + rl, col = pn * 256 + cl, b = row >> 13, s = row & 8191;
                const int g = col >> 4, ch0 = col & 15, chunk = s >> 5, t = s & 31;
                *(u32x4*)(UGS + ((size_t)(g * CROWS + b * NCH + chunk) * KU + 128 + t * 16 + ch0)) = pk8(v0, v1);
            });
            return;
        }
        const int which = (pn - 2) >> 1, hd0 = ((pn - 2) & 1) * 4, lane = fq * 16 + fr, bidx = row0 >> 13, blk = (row0 & 8191) >> 8;
        const int dbase = 32 * (wc & 1) + 8 * fq;
        const float* gain = which ? KG : QG;
        const f32x4 g0 = *(const f32x4*)(gain + dbase), g1 = *(const f32x4*)(gain + dbase + 4);
        LAS float* sq = misc;
        LAS float* kss = misc + 2048;
        float ps[2][4][2];
#pragma unroll
        for (int ai = 0; ai < 2; ++ai)
#pragma unroll
            for (int m = 0; m < 4; ++m)
#pragma unroll
                for (int bj = 0; bj < 2; ++bj) {
                    const f32x4 v0 = acc[ai][bj][m][0], v1 = acc[ai][bj][m][1];
                    float p = (v0.x * v0.x + v0.y * v0.y) + (v0.z * v0.z + v0.w * v0.w) + (v1.x * v1.x + v1.y * v1.y) + (v1.z * v1.z + v1.w * v1.w);
                    p += shx(p, 16, lane); p += shx(p, 32, lane);
                    ps[ai][m][bj] = p;
                    if (fq == 0) sq[(wc * 256 + ai * 128 + wr * 64 + m * 16 + fr) * 2 + bj] = p;
                }
        asm volatile("s_waitcnt lgkmcnt(0)" ::: "memory"); __builtin_amdgcn_s_barrier(); asm volatile("" ::: "memory");
#pragma unroll
        for (int ai = 0; ai < 2; ++ai)
#pragma unroll
            for (int m = 0; m < 4; ++m)
#pragma unroll
                for (int bj = 0; bj < 2; ++bj) { const float tot = ps[ai][m][bj] + sq[((wc ^ 1) * 256 + ai * 128 + wr * 64 + m * 16 + fr) * 2 + bj]; ps[ai][m][bj] = 1.0f / sqrtf(tot * (1.f / HD) + EPS); }
        f32x4 ks[2][2];
#pragma unroll
        for (int bj = 0; bj < 2; ++bj) { ks[bj][0] = (f32x4){0.f, 0.f, 0.f, 0.f}; ks[bj][1] = (f32x4){0.f, 0.f, 0.f, 0.f}; }
        const bool ropew = (wc & 1) == 0;
        bf16_t* outb = QH + (size_t)which * (16u << 20);
#pragma unroll
        for (int ai = 0; ai < 2; ++ai)
#pragma unroll
            for (int m = 0; m < 4; ++m) {
                const int rl = ai * 128 + wr * 64 + m * 16 + fr, s = blk * 256 + rl;
                f32x4 c0 = {1.f, 1.f, 1.f, 1.f}, c1 = c0, s0 = {0.f, 0.f, 0.f, 0.f}, s1 = s0;
                if (ropew && fq < 2) { const f32x4* rt = (const f32x4*)(ROPE + (size_t)s * 16); c0 = rt[0]; c1 = rt[1]; s0 = rt[2]; s1 = rt[3]; if (fq == 0) { s0 = -s0; s1 = -s1; } }
#pragma unroll
                for (int bj = 0; bj < 2; ++bj) {
                    const float rs = ps[ai][m][bj];
                    f32x4 a = acc[ai][bj][m][0] * rs * g0, b = acc[ai][bj][m][1] * rs * g1;
                    if (ropew) {
                        f32x4 pa, pb;
#pragma unroll
                        for (int j = 0; j < 4; ++j) { pa[j] = shx(a[j], 16, lane); pb[j] = shx(b[j], 16, lane); }
                        a = a * c0 + pa * s0; b = b * c1 + pb * s1;
                    }
                    bf16_t* dst = outb + ((size_t)((bidx * NH + hd0 + 2 * bj + (wc >> 1)) * SEQ + s) * HD + dbase);
                    if (which) { ks[bj][0] += a; ks[bj][1] += b; *(u32x4*)dst = pk8(a, b); }
                    else *(u32x4*)dst = pk8(a * QSCALE, b * QSCALE);
                }
            }
        if (which) {
#pragma unroll
            for (int bj = 0; bj < 2; ++bj)
#pragma unroll
                for (int n = 0; n < 2; ++n)
#pragma unroll
                    for (int j = 0; j < 4; ++j) { float v = ks[bj][n][j]; v += shx(v, 1, lane); v += shx(v, 2, lane); v += shx(v, 4, lane); v += shx(v, 8, lane);
                        if (fr == 0) kss[wr * 256 + bj * 128 + wc * 32 + 8 * fq + 4 * n + j] = v; }
            asm volatile("s_waitcnt lgkmcnt(0)" ::: "memory"); __builtin_amdgcn_s_barrier(); asm volatile("" ::: "memory");
            const int t = (wr * 4 + wc) * 64 + lane;
            if (t < 256) KMEAN[((size_t)((bidx * NH + hd0 + (t >> 6)) * NBLK + blk)) * HD + (t & 63)] = (kss[t] + kss[256 + t]) * (1.f / 256.f);
        }
    }
};
struct ProjOrder {
    gk::GridOrder g; int nmain;
    __device__ bool next(int i, Unit& u) const {
        const long L = (long)i * g.G + g.c;
        if (L < nmain) { if (!g.next(i, u)) return false; u.aoff += (long)WS_XN; u.boff += (long)WS_WIN; return true; }
        const int r = (int)(L - nmain); if (r >= 2 * (T / 256)) return false;
        const int vm = r & 1, vn = r >> 1;
        u.pm = vm; u.pn = vn; u.aoff = (long)WS_WIN + (long)(1536 + vm * 256) * DM * 2; u.boff = (long)WS_XN + (long)vn * 256 * DM * 2; u.nt = DM / 64;
        u.nvalid = 256; u.rows = nullptr; u.bsplit = 1 << 30; u.bjump = 0; u.aux0 = 1; u.aux1 = 0; u.lda = 0; u.ldb = 0; return true;
    }
};
struct EpiEloc {
    float* ELOC;
    __device__ __forceinline__ void operator()(const Acc& acc, const Unit& u, int wr, int wc, int fr, int fq) const {
        const int rowbase = u.aux0 * CROWS + u.pm * 256;
        epi_rows(acc, wr, wc, fr, fq, [&](int rl, int cl, f32x4 v0, f32x4 v1) {
            if (cl < 128) { float* d = ELOC + (size_t)(rowbase + rl) * 128 + cl; *(f32x4*)d = v0; *(f32x4*)(d + 4) = v1; }
        });
    }
};
struct EpiSsm {
    bf16_t* Z;
    __device__ __forceinline__ void operator()(const Acc& acc, const Unit& u, int wr, int wc, int fr, int fq) const {
        const int g = u.aux0, r0 = u.pm * 256, c0 = u.pn * 256;
        epi_rows(acc, wr, wc, fr, fq, [&](int rl, int cl, f32x4 v0, f32x4 v1) {
            const int col = c0 + cl, t = col >> 4, ch0 = col & 15; const size_t tok = (size_t)(r0 + rl) * CL + t;
            f32x4 a, bb;
#pragma unroll
            for (int j = 0; j < 4; ++j) { a[j] = gelu_tanh(v0[j]); bb[j] = gelu_tanh(v1[j]); }
            *(u32x4*)(Z + tok * SSMW + g * GC + ch0) = pk8(a, bb);
        });
    }
};
struct EpiGlu {
    const bf16_t* Z; const float* bias; bf16_t* OS;
    __device__ __forceinline__ void operator()(const Acc& acc, const Unit& u, int wr, int wc, int fr, int fq) const {
        const int r0 = u.pm * 256, c0 = u.pn * 256;
        f32x4 bs[2][2];
#pragma unroll
        for (int bj = 0; bj < 2; ++bj) { const float* bp = bias + c0 + bj * 128 + wc * 32 + 8 * fq; bs[bj][0] = *(const f32x4*)bp; bs[bj][1] = *(const f32x4*)(bp + 4); }
        epi_rows2<Pre1>(acc, wr, wc, fr, fq,
            [&](int rl, int cl) { Pre1 p; p.a = *(const u32x4*)(Z + (size_t)(r0 + rl) * SSMW + c0 + cl); return p; },
            [&](int rl, int cl, f32x4 v0, f32x4 v1, const Pre1& p) {
                f32x4 z0, z1; unpk8(p.a, z0, z1);
                const f32x4 b0 = bs[cl >> 7][0], b1 = bs[cl >> 7][1];
                f32x4 a, bb;
#pragma unroll
                for (int j = 0; j < 4; ++j) { a[j] = z0[j] * sigmoidf_(v0[j] + b0[j]); bb[j] = z1[j] * sigmoidf_(v1[j] + b1[j]); }
                *(u32x4*)(OS + (size_t)(r0 + rl) * SSMW + c0 + cl) = pk8(a, bb);
            });
    }
};
struct EpiMerge {
    bf16_t* MG; bf16_t* TMP;
    __device__ __forceinline__ void operator()(const Acc& acc, const Unit& u, int wr, int wc, int fr_, int fq_) const {
        int fr = fr_, fq = fq_; asm volatile("" : "+v"(fr), "+v"(fq));
        const int r0 = u.pm * 256, c0 = u.pn * 256, ps = u.aux0;
        const bool sg = ((ps & 1) == 0) == (u.aux1 == 0);
        if ((ps & 1) == 0) {
            bf16_t* D = ps ? TMP : MG;
            epi_rows(acc, wr, wc, fr, fq, [&](int rl, int cl, f32x4 v0, f32x4 v1) {
                f32x4 a = v0, bb = v1;
                if (sg) {
#pragma unroll
                    for (int j = 0; j < 4; ++j) { a[j] = sigmoidf_(v0[j]); bb[j] = sigmoidf_(v1[j]); } }
                *(u32x4*)(D + (size_t)(r0 + rl) * DM + c0 + cl) = pk8(a, bb);
            });
        } else if (ps == 1) {
            epi_rows2<Pre1>(acc, wr, wc, fr, fq,
                [&](int rl, int cl) { Pre1 p; p.a = *(const u32x4*)(MG + (size_t)(r0 + rl) * DM + c0 + cl); return p; },
                [&](int rl, int cl, f32x4 v0, f32x4 v1, const Pre1& p) { f32x4 m0, m1; unpk8(p.a, m0, m1); f32x4 a = v0, bb = v1;
                    if (sg) {
#pragma unroll
                        for (int j = 0; j < 4; ++j) { a[j] = sigmoidf_(v0[j]); bb[j] = sigmoidf_(v1[j]); } }
                    *(u32x4*)(MG + (size_t)(r0 + rl) * DM + c0 + cl) = pk8(m0 * a, m1 * bb); });
        } else {
            epi_rows2<Pre2>(acc, wr, wc, fr, fq,
                [&](int rl, int cl) { Pre2 p; const size_t off = (size_t)(r0 + rl) * DM + c0 + cl; p.a = *(const u32x4*)(MG + off); p.b = *(const u32x4*)(TMP + off); return p; },
                [&](int rl, int cl, f32x4 v0, f32x4 v1, const Pre2& p) { f32x4 m0, m1, t0, t1; unpk8(p.a, m0, m1); unpk8(p.b, t0, t1); f32x4 a = v0, bb = v1;
                    if (sg) {
#pragma unroll
                        for (int j = 0; j < 4; ++j) { a[j] = sigmoidf_(v0[j]); bb[j] = sigmoidf_(v1[j]); } }
                    *(u32x4*)(MG + (size_t)(r0 + rl) * DM + c0 + cl) = pk8(m0 + t0 * a, m1 + t1 * bb); });
        }
    }
};
struct MergeOrder {
    gk::GridOrder g; int order;
    __device__ bool next(int i, Unit& u) const {
        if (!g.next(i >> 2, u)) return false;
        const int ps = i & 3, br = ps >> 1; u.aux0 = ps; u.aux1 = order;
        const bool gate = ((ps & 1) == 0) == (order == 0);
        if (gate) { u.aoff = (long)WS_XN + (long)u.pm * 256 * DM * 2; u.boff = (long)WS_WIN + (long)(2048 + br * 1024 + u.pn * 256) * DM * 2; u.nt = DM / 64; u.lda = DM; u.ldb = DM; }
        else { u.aoff = (long)(br == 0 ? WS_OS : WS_ATT) + (long)u.pm * 256 * SSMW * 2; u.boff = (long)(br == 0 ? WS_WPS : WS_WPA) + (long)u.pn * 256 * SSMW * 2; u.nt = SSMW / 64; u.lda = SSMW; u.ldb = SSMW; }
        return true;
    }
};
struct EpiOut {
    const float* X; bf16_t* X1H; bf16_t* X1L;
    __device__ __forceinline__ void operator()(const Acc& acc, const Unit& u, int wr, int wc, int fr, int fq) const {
        const int r0 = u.pm * 256, c0 = u.pn * 256;
        epi_rows2<PreF2>(acc, wr, wc, fr, fq,
            [&](int rl, int cl) { PreF2 p; const float* xp = X + (size_t)(r0 + rl) * DM + c0 + cl; p.a = *(const f32x4*)xp; p.b = *(const f32x4*)(xp + 4); return p; },
            [&](int rl, int cl, f32x4 v0, f32x4 v1, const PreF2& p) {
                const size_t off = (size_t)(r0 + rl) * DM + c0 + cl;
                const f32x4 a = p.a + v0, bb = p.b + v1;
                const u32x4 hw = pk8(a, bb); f32x4 h0, h1; unpk8(hw, h0, h1);
                *(u32x4*)(X1H + off) = hw; if (X1L) *(u32x4*)(X1L + off) = pk8(a - h0, bb - h1);
            });
    }
};
struct EpiGU {
    const int* ELDST; const float* ELW; const float* ELR2; bf16_t* ACT; const LAS int* pairoff;
    __device__ __forceinline__ void operator()(const Acc& acc, const Unit& u, int wr, int wc, int fr, int fq) const {
        const int e = u.aux0, tile = u.pm;
#pragma unroll
        for (int ai = 0; ai < 2; ++ai) {
            int dst[4]; float w[4], r2[4];
#pragma unroll
            for (int m = 0; m < 4; ++m) {
                const int rl = ai * 128 + wr * 64 + m * 16 + fr; const size_t idx = (size_t)e * T + tile * 256 + (rl < u.nvalid ? rl : 0);
                dst[m] = ELDST[idx]; w[m] = ELW[idx]; r2[m] = ELR2[idx];
            }
#pragma unroll
            for (int m = 0; m < 4; ++m) {
                const int rl = ai * 128 + wr * 64 + m * 16 + fr;
                if (rl < u.nvalid) {
                    const int p = dst[m] >> 17, slot = (dst[m] >> 16) & 1, rank = dst[m] & 0xffff;
                    const size_t prow = (size_t)(pairoff[p] + rank);
                    f32x4 a[2];
#pragma unroll
                    for (int n = 0; n < 2; ++n)
#pragma unroll
                        for (int j = 0; j < 4; ++j) { const float gt = acc[ai][0][m][n][j] * r2[m], up = acc[ai][1][m][n][j] * r2[m]; a[n][j] = gt * sigmoidf_(gt) * up * w[m]; }
                    *(u32x4*)(ACT + prow * 256 + slot * 128 + wc * 32 + 8 * fq) = pk8(a[0], a[1]);
                }
            }
        }
    }
};
struct EpiDN {
    const int* PLTOK; const bf16_t* X1H; const bf16_t* X1L; float* OUT;
    __device__ __forceinline__ void operator()(const Acc& acc, const Unit& u, int wr, int wc, int fr, int fq) const {
        const int p = u.aux0, tile = u.aux1, c0 = u.pn * 256, nv = u.nvalid;
#pragma unroll
        for (int ai = 0; ai < 2; ++ai) {
            int tok[4];
#pragma unroll
            for (int m = 0; m < 4; ++m) { const int rl = ai * 128 + wr * 64 + m * 16 + fr; tok[m] = PLTOK[(size_t)p * T + tile * 256 + (rl < nv ? rl : 0)]; }
            u32x4 xh[4][2];
#pragma unroll
            for (int m = 0; m < 4; ++m)
#pragma unroll
                for (int bj = 0; bj < 2; ++bj) { const size_t off = (size_t)tok[m] * DM + c0 + bj * 128 + wc * 32 + 8 * fq; xh[m][bj] = *(const u32x4*)(X1H + off); }
#pragma unroll
            for (int m = 0; m < 4; ++m) {
                const int rl = ai * 128 + wr * 64 + m * 16 + fr;
                if (rl < nv) {
#pragma unroll
                    for (int bj = 0; bj < 2; ++bj) {
                        const size_t off = (size_t)tok[m] * DM + c0 + bj * 128 + wc * 32 + 8 * fq;
                        f32x4 h0, h1; unpk8(xh[m][bj], h0, h1);
                        *(f32x4*)(OUT + off) = h0 + acc[ai][bj][m][0]; *(f32x4*)(OUT + off + 4) = h1 + acc[ai][bj][m][1];
                    }
                }
            }
        }
    }
};

struct ElocOrder {
    int G, c;
    __device__ bool next(int i, Unit& u) const {
        const int L = i * G + c; if (L >= NG * 4) return false;
        const int g = L >> 2, pm = L & 3;
        u.pm = pm; u.pn = 0; u.aoff = ((long)(g * CROWS + pm * 256) * KU + 128) * 2; u.boff = (long)g * 128 * NTC * 2; u.nt = NTC / 64;
        u.nvalid = 256; u.rows = nullptr; u.bsplit = 1 << 30; u.bjump = 0; u.aux0 = g; u.aux1 = 0; return true;
    }
};
struct SsmOrder {
    int G, c;
    __device__ bool next(int i, Unit& u) const {
        const int L = i * G + c; if (L >= NG * 8) return false;
        const int g = L >> 3, pm = (L >> 1) & 3, pn = L & 1;
        u.pm = pm; u.pn = pn; u.aoff = (long)(g * CROWS + pm * 256) * KU * 2; u.boff = (long)(g * NTC + pn * 256) * KU * 2; u.nt = pn ? 10 : 6;
        u.nvalid = 256; u.rows = nullptr; u.bsplit = 1 << 30; u.bjump = 0; u.aux0 = g; u.aux1 = 0; return true;
    }
};
struct GUOrder {
    const LAS int* fpre; const LAS int* ecnt; const LAS int* plist; int nfull, npart; const int* ELTOK; int G, c;
    __device__ bool next(int i, Unit& u) const {
        const int L = i * G + c; if (L >= nfull + npart) return false;
        int e, tile;
        if (L < nfull) { e = 0; while (fpre[e + 1] <= L) ++e; e = __builtin_amdgcn_readfirstlane(e); tile = L - __builtin_amdgcn_readfirstlane(fpre[e]); }
        else { e = __builtin_amdgcn_readfirstlane(plist[L - nfull]); tile = __builtin_amdgcn_readfirstlane(ecnt[e]) >> 8; }
        const int cnt = __builtin_amdgcn_readfirstlane(ecnt[e]);
        u.pm = tile; u.pn = 0; u.aoff = 0; u.boff = (long)e * 256 * DM * 2; u.nt = DM / 64;
        u.nvalid = min(256, cnt - tile * 256); u.rows = ELTOK + (size_t)e * T + tile * 256; u.bsplit = 1 << 30; u.bjump = 0; u.aux0 = e; u.aux1 = 0; u.lda = 0; u.ldb = 0; return true;
    }
};
struct DNOrder {
    const LAS int* fpre; const LAS int* pcnt; const LAS int* pairoff; const LAS int* plist; int nfull, npart, G, c;
    __device__ bool next(int i, Unit& u) const {
        const int L = i * G + c; if (L >= (nfull + npart) * 4) return false;
        const int rt = L >> 2, pn = L & 3; int p, tile;
        if (rt < nfull) { p = 0; while (fpre[p + 1] <= rt) ++p; p = __builtin_amdgcn_readfirstlane(p); tile = rt - __builtin_amdgcn_readfirstlane(fpre[p]); }
        else { p = __builtin_amdgcn_readfirstlane(plist[rt - nfull]); tile = __builtin_amdgcn_readfirstlane(pcnt[p]) >> 8; }
        const int cnt = __builtin_amdgcn_readfirstlane(pcnt[p]), po = __builtin_amdgcn_readfirstlane(pairoff[p]);
        const int g = p / 28; int q = p % 28, lo = 0; while (q >= 7 - lo) { q -= 7 - lo; ++lo; } const int hi = lo + 1 + q;
        u.pm = 0; u.pn = pn; u.aoff = (long)(po + tile * 256) * 256 * 2; u.boff = ((long)pn * 256 * (NE * DE) + (g * 8 + lo) * DE) * 2; u.nt = 4;
        u.nvalid = min(256, cnt - tile * 256); u.rows = nullptr; u.bsplit = 2; u.bjump = (long)(hi - lo) * DE * 2 - 2 * 128; u.aux0 = p; u.aux1 = tile; u.lda = 0; u.ldb = 0; return true;
    }
};

__device__ __forceinline__ void p0_transpose_item(const float* W, int N, const float* kscale, bf16_t* WT, int ldt, LAS float* scr, int item, int lane) {
    const int nblk = N / 32, kb = item / nblk, nb = item % nblk, k0 = 64 * kb, n0 = 32 * nb;
    float v[32];
#pragma unroll
    for (int i = 0; i < 32; ++i) v[i] = W[(size_t)(k0 + 2 * i + (lane >> 5)) * N + n0 + (lane & 31)];
    if (kscale) {
#pragma unroll
        for (int i = 0; i < 32; ++i) v[i] *= kscale[k0 + 2 * i + (lane >> 5)];
    }
#pragma unroll
    for (int i = 0; i < 32; ++i) scr[(2 * i + (lane >> 5)) * 33 + (lane & 31)] = v[i];
    asm volatile("s_waitcnt lgkmcnt(0)" ::: "memory");
    const int c = lane & 7;
#pragma unroll
    for (int j = 0; j < 4; ++j) { const int n = (lane >> 3) + 8 * j; const LAS float* s = scr + (8 * c) * 33 + n;
        u32x4 o; o.x = pk2(s[0 * 33], s[1 * 33]); o.y = pk2(s[2 * 33], s[3 * 33]); o.z = pk2(s[4 * 33], s[5 * 33]); o.w = pk2(s[6 * 33], s[7 * 33]);
        *(u32x4*)(WT + (size_t)(n0 + n) * ldt + k0 + 8 * c) = o; }
    asm volatile("s_waitcnt lgkmcnt(0)" ::: "memory");
}

__device__ __forceinline__ void p0_ssm_tables(const Params& P, LAS unsigned char* lds, int g, int part, int tid) {
    unsigned char* ws = P.ws;
    LAS double* xs = (LAS double*)lds;
    LAS double* ys = xs + 64;
    LAS float* cfr = (LAS float*)(ys + 64);
    LAS float* cfi = cfr + 64;
    LAS f32x2* AP = (LAS f32x2*)(cfi + 64);
    LAS f32x2* BB = AP + 33 * 64;
    LAS f32x2* CC = BB + 64 * 16;
    if (tid < 64) {
        const int n = tid;
        const double dt = exp((double)P.in[I_LOGDT][g]);
        const float lrf = fminf(P.in[I_LAMRE][g * NS + n], -1e-4f);
        const double lr = lrf, li = P.in[I_LAMIM][g * NS + n];
        const double x = lr * dt, y = li * dt, mag = exp(x), ar = mag * cos(y), ai = mag * sin(y);
        const double den = lr * lr + li * li, nr = ar - 1.0, ni = ai;
        xs[n] = x; ys[n] = y; cfr[n] = (float)((nr * lr + ni * li) / den); cfi[n] = (float)((ni * lr - nr * li) / den);
        const double m32 = exp(32.0 * x);
        if (part == 0) ((f32x2*)(ws + WS_A32))[g * NS + n] = (f32x2){(float)(m32 * cos(32.0 * y)), (float)(m32 * sin(32.0 * y))};
    }
    __syncthreads();
#pragma unroll 1
    for (int idx = tid; idx < 33 * 64; idx += 512) { const int tau = idx >> 6, n = idx & 63; const float m = expf((float)xs[n] * (float)tau), a = (float)(ys[n] * tau); float sn, cs; sincosf(a, &sn, &cs); AP[idx] = (f32x2){m * cs, m * sn}; }
#pragma unroll 1
    for (int idx = tid; idx < 1024; idx += 512) {
        { const int n = idx >> 4; const float br = P.in[I_BRE][(size_t)g * 1024 + idx], bi = P.in[I_BIM][(size_t)g * 1024 + idx]; BB[idx] = (f32x2){cfr[n] * br - cfi[n] * bi, cfr[n] * bi + cfi[n] * br}; }
        CC[idx] = (f32x2){P.in[I_CRE][(size_t)g * 1024 + idx], P.in[I_CIM][(size_t)g * 1024 + idx]};
    }
    __syncthreads();
    float* KC = (float*)(ws + WS_KC) + (size_t)g * 32 * 256;
#pragma unroll 1
    for (int idx = part * 1024 + tid; idx < (part + 1) * 1024; idx += 512) {
        const int tau = idx >> 8, c = (idx >> 4) & 15, cp = idx & 15; float s = 0.f;
#pragma unroll 4
        for (int n = 0; n < 64; ++n) { const f32x2 cc = CC[c * 64 + n], ap = AP[tau * 64 + n], bb = BB[n * 16 + cp];
            const float xr = cc.x * ap.x - cc.y * ap.y, xi = cc.x * ap.y + cc.y * ap.x; s += xr * bb.x - xi * bb.y; }
        if (tau == 0 && c == cp) s += P.in[I_SSMD][g * GC + c];
        KC[idx] = s;
    }
    bf16_t* MO = (bf16_t*)(ws + WS_MOUT) + (size_t)g * NTC * 128;
#pragma unroll 1
    for (int idx = part * (NTC * 16) + tid; idx < (part + 1) * (NTC * 16); idx += 512) {
        const int row = idx >> 7, np = idx & 127, n = np & 63, t = row >> 4, c = row & 15;
        const f32x2 cc = CC[c * 64 + n], ap = AP[(t + 1) * 64 + n];
        const float zr = cc.x * ap.x - cc.y * ap.y, zi = cc.x * ap.y + cc.y * ap.x;
        MO[idx] = f2bf(np < 64 ? zr : -zi);
    }
    bf16_t* MIN = (bf16_t*)(ws + WS_MIN) + (size_t)g * 128 * NTC;
#pragma unroll 1
    for (int idx = part * (NTC * 16) + tid; idx < (part + 1) * (NTC * 16); idx += 512) {
        const int np = idx >> 9, k = idx & 511, n = np & 63, s = k >> 4, cp = k & 15;
        const f32x2 ap = AP[(31 - s) * 64 + n], bb = BB[n * 16 + cp];
        const float wr_ = ap.x * bb.x - ap.y * bb.y, wi_ = ap.x * bb.y + ap.y * bb.x;
        MIN[idx] = f2bf(np < 64 ? wr_ : wi_);
    }
    __syncthreads();
}

__device__ __forceinline__ void phase0(const Params& P, LAS unsigned char* lds, int G, const int tid) {
    unsigned char* ws = P.ws;
    const int lane = tid & 63, wid = __builtin_amdgcn_readfirstlane(tid >> 6), bid = blockIdx.x;
    for (int u = bid; u < NG * 8; u += G) p0_ssm_tables(P, lds, u >> 3, u & 7, tid);
#ifdef PROBE_A
#define P0STAMP(i) do { if (blockIdx.x == PROBE_BLK && tid == 0) ((LAS unsigned long long*)(lds + MISC_OFF + 12288))[i] = __builtin_amdgcn_s_memrealtime(); } while (0)
#else
#define P0STAMP(i) do { } while (0)
#endif
    P0STAMP(26);
    {
        LAS float* scr = (LAS float*)(lds + wid * 16384);
        const int gw = bid * 8 + wid, NGW = G * 8;
        for (int it = gw; it < 16 * 128; it += NGW) p0_transpose_item(P.in[I_WIN], NIN, nullptr, (bf16_t*)(ws + WS_WIN), DM, scr, it, lane);
    }
    P0STAMP(27);
    {
        bf16_t* HI = (bf16_t*)(ws + WS_WRT); bf16_t* LO = HI + 48 * DM;
        for (int idx = bid * 512 + tid; idx < 48 * DM; idx += G * 512) {
            const int col = idx >> 10, k = idx & 1023;
            float v = 0.f;
            if (col < 4) v = P.in[I_WRG][k * 4 + col]; else if (col < 36) v = P.in[I_WRE][k * 32 + col - 4];
            v *= P.in[I_N2G][k];
            const bf16_t h = f2bf(v); HI[idx] = h; LO[idx] = f2bf(v - bf2f(h));
        }
    }
    {
        const float invf[8] = {1.0f, 0.1939227432012558f, 0.03760603070259094f, 0.007292664609849453f, 0.0014142135623842478f, 0.00027424818836152554f, 5.318296098266728e-05f, 1.0313386155758053e-05f};
        float* RT = (float*)(ws + WS_ROPE);
        for (int idx = bid * 512 + tid; idx < SEQ * 8; idx += G * 512) {
            const int pos = idx >> 3, i = idx & 7; float fr = 1.0f;
#pragma unroll
            for (int k = 0; k < 8; ++k) if (i == k) fr = invf[k];
            const float ang = (float)pos * fr;
            RT[pos * 16 + i] = cosf(ang); RT[pos * 16 + 8 + i] = sinf(ang);
        }
    }
    P0STAMP(28);
    {
        const int gw = bid * 8 + wid, NGW = G * 8;
        const f32x4* gp = (const f32x4*)P.in[I_N1G] + lane;
        f32x4 gv[4];
#pragma unroll
        for (int j = 0; j < 4; ++j) gv[j] = gp[64 * j];
        f32x4 v[4], vn[4];
        if (gw < T) { const f32x4* xr = (const f32x4*)(P.in[I_X] + (size_t)gw * DM) + lane;
#pragma unroll
            for (int j = 0; j < 4; ++j) v[j] = xr[64 * j]; }
        for (int m = gw; m < T; m += NGW) {
            const int mn = (m + NGW < T) ? m + NGW : m;
            { const f32x4* xr = (const f32x4*)(P.in[I_X] + (size_t)mn * DM) + lane;
#pragma unroll
              for (int j = 0; j < 4; ++j) vn[j] = xr[64 * j]; }
            float ssum = 0.f;
#pragma unroll
            for (int j = 0; j < 4; ++j) ssum += (v[j].x * v[j].x + v[j].y * v[j].y) + (v[j].z * v[j].z + v[j].w * v[j].w);
            const float rs = 1.0f / sqrtf(wave_sum(ssum) * (1.f / DM) + EPS);
            u32x2* o8 = (u32x2*)((bf16_t*)(ws + WS_XN) + (size_t)m * DM) + lane;
#pragma unroll
            for (int j = 0; j < 4; ++j) { const f32x4 y = v[j] * rs * gv[j]; u32x2 w; w.x = pk2(y.x, y.y); w.y = pk2(y.z, y.w); o8[64 * j] = w; }
#pragma unroll
            for (int j = 0; j < 4; ++j) v[j] = vn[j];
        }
    }
}


__device__ __forceinline__ void late_transposes(const Params& P, LAS unsigned char* lds, int G, const int tid, int half, int slot, int nslots) {
    unsigned char* ws = P.ws;
    const int lane = tid & 63, wid = __builtin_amdgcn_readfirstlane(tid >> 6), bid = blockIdx.x;
    LAS float* scr = (LAS float*)(lds + wid * 16384);
    const int gw = slot * 8 + wid, NGW = nslots * 8;
    constexpr int I_GLU = 8 * 16, I_P = 8 * 32, I_O = 16 * 32, I_E = 64 * NE;
    constexpr int NIT = I_GLU + 2 * I_P + I_O + 3 * I_E;
    bf16_t* WGU = (bf16_t*)(ws + WS_WGU); bf16_t* WDN = (bf16_t*)(ws + WS_WDN);
    const int lo = half ? NIT / 2 : 0, hi = half ? NIT : NIT / 2;
    for (int it = lo + gw; it < hi; it += NGW) {
        int r = it;
        if (r < I_GLU) { p0_transpose_item(P.in[I_WGLU], SSMW, nullptr, (bf16_t*)(ws + WS_WGLU), SSMW, scr, r, lane); continue; } r -= I_GLU;
        if (r < I_P) { p0_transpose_item(P.in[I_WPS], DM, nullptr, (bf16_t*)(ws + WS_WPS), SSMW, scr, r, lane); continue; } r -= I_P;
        if (r < I_P) { p0_transpose_item(P.in[I_WPA], DM, nullptr, (bf16_t*)(ws + WS_WPA), SSMW, scr, r, lane); continue; } r -= I_P;
        if (r < I_O) { p0_transpose_item(P.in[I_WOUT], DM, nullptr, (bf16_t*)(ws + WS_WOUT), DM, scr, r, lane); continue; } r -= I_O;
        if (r < I_E) { const int e = r >> 6; p0_transpose_item(P.in[I_WGATE] + (size_t)e * DM * DE, DE, P.in[I_N2G], WGU + (size_t)e * 256 * DM, DM, scr, r & 63, lane); continue; } r -= I_E;
        if (r < I_E) { const int e = r >> 6; p0_transpose_item(P.in[I_WUP] + (size_t)e * DM * DE, DE, P.in[I_N2G], WGU + (size_t)(e * 256 + 128) * DM, DM, scr, r & 63, lane); continue; } r -= I_E;
        { const int e = r >> 6; p0_transpose_item(P.in[I_WDOWN] + (size_t)e * DE * DM, DM, nullptr, WDN + e * DE, NE * DE, scr, r & 63, lane); }
    }
    __syncthreads();
}

struct QkvRegs { u32x4 q[4], k[4]; };
__device__ __forceinline__ void qkv_load(const Params& P, int wu, int lane, QkvRegs& R) {
    const int bh = wu >> 8, blk = (wu >> 3) & 31, sub = wu & 7;
    const size_t off = ((size_t)bh * SEQ + blk * 256 + sub * 32 + (lane >> 3)) * HD + (lane & 7) * 8;
    const bf16_t* qp = (const bf16_t*)(P.ws + WS_QH) + off; const bf16_t* kp = (const bf16_t*)(P.ws + WS_KH) + off;
#pragma unroll
    for (int it = 0; it < 4; ++it) { R.q[it] = *(const u32x4*)(qp + it * 8 * HD); R.k[it] = *(const u32x4*)(kp + it * 8 * HD); }
}
__device__ __forceinline__ void qkv_wave_unit(const Params& P, LAS bf16_t* vt, int wu, int lane, const QkvRegs& R, const f32x4 (&gq)[2], const f32x4 (&gk)[2]) {
    unsigned char* ws = P.ws;
    const int bh = wu >> 8, blk = (wu >> 3) & 31, sub = wu & 7, r8 = lane >> 3, c8 = lane & 7;
    const size_t blkoff = ((size_t)bh * SEQ + blk * 256) * HD;
    const size_t off = blkoff + (size_t)(sub * 32 + r8) * HD + c8 * 8;
    bf16_t* qp = (bf16_t*)(ws + WS_QH) + off; bf16_t* kp = (bf16_t*)(ws + WS_KH) + off;
    f32x4 ks0 = {0.f, 0.f, 0.f, 0.f}, ks1 = {0.f, 0.f, 0.f, 0.f};
#pragma unroll
    for (int it = 0; it < 4; ++it) {
        const int pos = blk * 256 + sub * 32 + it * 8 + r8;
        f32x4 c0 = {1.f, 1.f, 1.f, 1.f}, c1 = c0, s0 = {0.f, 0.f, 0.f, 0.f}, s1 = s0;
        if (c8 < 2) { const f32x4* rt = (const f32x4*)((const float*)(ws + WS_ROPE) + (size_t)pos * 16); c0 = rt[0]; c1 = rt[1]; s0 = rt[2]; s1 = rt[3]; if (c8 == 0) { s0 = -s0; s1 = -s1; } }
#pragma unroll
        for (int w = 0; w < 2; ++w) {
            f32x4 a, b; unpk8(w ? R.k[it] : R.q[it], a, b);
            float ss = (a.x * a.x + a.y * a.y) + (a.z * a.z + a.w * a.w) + (b.x * b.x + b.y * b.y) + (b.z * b.z + b.w * b.w);
            ss += shx(ss, 1, lane); ss += shx(ss, 2, lane); ss += shx(ss, 4, lane);
            const float rs = 1.0f / sqrtf(ss * (1.f / HD) + EPS);
            a = a * rs * (w ? gk[0] : gq[0]); b = b * rs * (w ? gk[1] : gq[1]);
            f32x4 pa, pb;
#pragma unroll
            for (int j = 0; j < 4; ++j) { pa[j] = shx(a[j], 1, lane); pb[j] = shx(b[j], 1, lane); }
            a = a * c0 + pa * s0; b = b * c1 + pb * s1;
            if (w) { ks0 += a; ks1 += b; *(u32x4*)(kp + it * 8 * HD) = pk8(a, b); }
            else *(u32x4*)(qp + it * 8 * HD) = pk8(a * QSCALE, b * QSCALE);
        }
    }
#pragma unroll
    for (int j = 0; j < 4; ++j) { ks0[j] += shx(ks0[j], 8, lane); ks0[j] += shx(ks0[j], 16, lane); ks0[j] += shx(ks0[j], 32, lane); ks1[j] += shx(ks1[j], 8, lane); ks1[j] += shx(ks1[j], 16, lane); ks1[j] += shx(ks1[j], 32, lane); }
    if (lane < 8) { float* kpart = (float*)(ws + WS_KPART) + ((size_t)(bh * NBLK + blk) * 8 + sub) * HD + c8 * 8; *(f32x4*)kpart = ks0; *(f32x4*)(kpart + 4) = ks1; }
}
__device__ __forceinline__ void qkv_phase(const Params& P, LAS unsigned char* lds, int G, const int tid) {
    const int lane = tid & 63, wid = __builtin_amdgcn_readfirstlane(tid >> 6), c8 = lane & 7;
    LAS bf16_t* vt = (LAS bf16_t*)(lds + wid * 8192);
    f32x4 gq[2], gk[2];
    gq[0] = *(const f32x4*)(P.in[I_QG] + c8 * 8); gq[1] = *(const f32x4*)(P.in[I_QG] + c8 * 8 + 4); gk[0] = *(const f32x4*)(P.in[I_KG] + c8 * 8); gk[1] = *(const f32x4*)(P.in[I_KG] + c8 * 8 + 4);
    const int NWU = NBH * NBLK * 8, step = G * 8;
    int wu = blockIdx.x * 8 + wid;
    QkvRegs Ra, Rb;
    if (wu < NWU) qkv_load(P, wu, lane, Ra);
    for (; wu < NWU; wu += 2 * step) {
        if (wu + step < NWU) qkv_load(P, wu + step, lane, Rb);
        qkv_wave_unit(P, vt, wu, lane, Ra, gq, gk);
        if (wu + step < NWU) { if (wu + 2 * step < NWU) qkv_load(P, wu + 2 * step, lane, Ra); qkv_wave_unit(P, vt, wu + step, lane, Rb, gq, gk); }
    }
    __syncthreads();
}

__device__ __forceinline__ void select_phase(const Params& P, LAS unsigned char* lds, int G, const int tid) {
    unsigned char* ws = P.ws;
    LAS int* lc = (LAS int*)lds;
    LAS int* lb = lc + 128;
    const int lane = tid & 63, wid = __builtin_amdgcn_readfirstlane(tid >> 6), q32 = lane & 31, hi = lane >> 5, r = wid * 32 + q32;
    const int NU = NBH * NBLK;
    for (int u0 = blockIdx.x; u0 < NU; u0 += 4 * G) {
        if (tid < 128) lc[tid] = 0;
        bf16x8 qf[4][4];
#pragma unroll
        for (int k = 0; k < 4; ++k) { const int u = u0 + k * G; const int uu = u < NU ? u : u0;
            const bf16_t* qp = (const bf16_t*)(ws + WS_QH) + ((size_t)(uu >> 5) * SEQ + (uu & 31) * 256 + r) * HD + hi * 8;
#pragma unroll
            for (int d0 = 0; d0 < 4; ++d0) qf[k][d0] = *(const bf16x8*)(qp + d0 * 16); }
        __syncthreads();
        int sj[4][3], srank[4][3];
#pragma unroll
        for (int k = 0; k < 4; ++k) {
            const int u = u0 + k * G; const bool act = u < NU; const int uu = act ? u : u0, bh = uu >> 5, qb = uu & 31;
            f32x16 sc;
#pragma unroll
            for (int i = 0; i < 16; ++i) sc[i] = 0.f;
            const float* kmp = (const float*)(ws + WS_KMEAN) + ((size_t)bh * NBLK + q32) * HD + hi * 8;
            f32x4 km[4][2];
#pragma unroll
            for (int d0 = 0; d0 < 4; ++d0) { km[d0][0] = *(const f32x4*)(kmp + d0 * 16); km[d0][1] = *(const f32x4*)(kmp + d0 * 16 + 4); }
#pragma unroll
            for (int d0 = 0; d0 < 4; ++d0) {
                const u32x4 hw = pk8(km[d0][0], km[d0][1]); f32x4 h0, h1; unpk8(hw, h0, h1); const u32x4 lw = pk8(km[d0][0] - h0, km[d0][1] - h1);
                sc = __builtin_amdgcn_mfma_f32_32x32x16_bf16(__builtin_bit_cast(bf16x8, hw), qf[k][d0], sc, 0, 0, 0);
                sc = __builtin_amdgcn_mfma_f32_32x32x16_bf16(__builtin_bit_cast(bf16x8, lw), qf[k][d0], sc, 0, 0, 0);
            }
            float b0 = -INFINITY, b1 = -INFINITY, b2 = -INFINITY; int i0 = 1 << 20, i1 = 1 << 20, i2 = 1 << 20;
#pragma unroll
            for (int rr = 0; rr < 16; ++rr) {
                const int j = (rr & 3) + 8 * (rr >> 2) + 4 * hi; const float sv = j < qb ? sc[rr] : -INFINITY;
                if (sv > b0) { b2 = b1; i2 = i1; b1 = b0; i1 = i0; b0 = sv; i0 = j; }
                else if (sv > b1) { b2 = b1; i2 = i1; b1 = sv; i1 = j; }
                else if (sv > b2) { b2 = sv; i2 = j; }
            }
            const float pb[3] = {shx(b0, 32, lane), shx(b1, 32, lane), shx(b2, 32, lane)};
            const int pi[3] = {__builtin_amdgcn_ds_bpermute((lane ^ 32) << 2, i0), __builtin_amdgcn_ds_bpermute((lane ^ 32) << 2, i1), __builtin_amdgcn_ds_bpermute((lane ^ 32) << 2, i2)};
#pragma unroll
            for (int c = 0; c < 3; ++c) {
                const float sv = pb[c]; const int j = pi[c];
                if (sv > b0 || (sv == b0 && j < i0)) { b2 = b1; i2 = i1; b1 = b0; i1 = i0; b0 = sv; i0 = j; }
                else if (sv > b1 || (sv == b1 && j < i1)) { b2 = b1; i2 = i1; b1 = sv; i1 = j; }
                else if (sv > b2 || (sv == b2 && j < i2)) { b2 = sv; i2 = j; }
            }
            sj[k][0] = i0; sj[k][1] = i1; sj[k][2] = i2;
            const int nsel = act ? (qb < 3 ? qb : 3) : 0;
#pragma unroll
            for (int c = 0; c < 3; ++c) { srank[k][c] = 0; if (hi == 0 && c < nsel) srank[k][c] = atomicAdd((int*)&lc[k * 32 + sj[k][c]], 1); }
        }
        __syncthreads();
        if (tid < 128) { const int k = tid >> 5, j = tid & 31, u = u0 + k * G; const int n = lc[tid];
            lb[tid] = (u < NU && n > 0) ? atomicAdd((int*)(ws + WS_CTL) + CW_LCNT + (u >> 5) * NBLK + j, n) : 0; }
        __syncthreads();
        if (hi == 0) {
            unsigned short* lists = (unsigned short*)(ws + WS_LISTS);
#pragma unroll
            for (int k = 0; k < 4; ++k) { const int u = u0 + k * G; if (u < NU) { const int bh = u >> 5, qb = u & 31, nsel = qb < 3 ? qb : 3;
#pragma unroll
                for (int c = 0; c < 3; ++c) if (c < nsel) lists[(size_t)(bh * NBLK + sj[k][c]) * SEQ + lb[k * 32 + sj[k][c]] + srank[k][c]] = (unsigned short)((qb * 256 + r) | (c << 13)); } }
        }
        __syncthreads();
    }
}

__device__ __forceinline__ void tg_expand(const Params& P, int G, const int tid, int slot, int nslots) {
    unsigned char* ws = P.ws;
    const float* KC = (const float*)(ws + WS_KC); bf16_t* TG = (bf16_t*)(ws + WS_TG);
    for (int idx = slot * 512 + tid; idx < NG * NTC * CL; idx += nslots * 512) {
        const int s = idx & 31, row = (idx >> 5) & 511, g = idx >> 14, t = row >> 4, c = row & 15;
        u32x4 w0 = {0u, 0u, 0u, 0u}, w1 = {0u, 0u, 0u, 0u};
        if (s <= t) { const f32x4* kp = (const f32x4*)(KC + ((size_t)(g * 32 + (t - s)) * 16 + c) * 16); w0 = pk8(kp[0], kp[1]); w1 = pk8(kp[2], kp[3]); }
        bf16_t* d = TG + ((size_t)(g * NTC + row)) * KU + 128 + s * 16;
        *(u32x4*)d = w0; *(u32x4*)(d + 8) = w1;
        if (s < 16) *(u32x4*)(TG + ((size_t)(g * NTC + row)) * KU + s * 8) = *(const u32x4*)((const bf16_t*)(ws + WS_MOUT) + ((size_t)(g * NTC + row)) * 128 + s * 8);
    }
}

__device__ __forceinline__ void carry_scan(const Params& P, LAS unsigned char* lds, int vb, int tid) {
    unsigned char* ws = P.ws;
    LAS f32x2* tot = (LAS f32x2*)lds;
    const int pair = vb >> 1, g = pair >> 2, b = pair & 3, nl = tid & 31, n = (vb & 1) * 32 + nl, seg = tid >> 5;
    const f32x2 a = ((const f32x2*)(ws + WS_A32))[g * NS + n];
    const float* EL = (const float*)(ws + WS_ELOC) + ((size_t)(g * CROWS + b * NCH + seg * 16)) * 128;
    float er[16], ei[16];
#pragma unroll
    for (int i = 0; i < 16; ++i) { er[i] = EL[(size_t)i * 128 + n]; ei[i] = EL[(size_t)i * 128 + 64 + n]; }
    float pr[16], pi[16]; float sr = 0.f, si = 0.f;
#pragma unroll
    for (int i = 0; i < 16; ++i) { pr[i] = sr; pi[i] = si; const float tr = a.x * sr - a.y * si + er[i], ti = a.x * si + a.y * sr + ei[i]; sr = tr; si = ti; }
    tot[seg * 32 + nl] = (f32x2){sr, si};
    __syncthreads();
    f32x2 a16 = a;
#pragma unroll
    for (int k = 0; k < 4; ++k) a16 = (f32x2){a16.x * a16.x - a16.y * a16.y, 2.f * a16.x * a16.y};
    float cr = 0.f, ci = 0.f;
    for (int j = 0; j < seg; ++j) { const f32x2 tj = tot[j * 32 + nl]; const float tr = a16.x * cr - a16.y * ci + tj.x, ti = a16.x * ci + a16.y * cr + tj.y; cr = tr; ci = ti; }
    bf16_t* U = (bf16_t*)(ws + WS_UGS) + ((size_t)(g * CROWS + b * NCH + seg * 16)) * KU;
#pragma unroll
    for (int i = 0; i < 16; ++i) {
        U[(size_t)i * KU + n] = f2bf(cr + pr[i]); U[(size_t)i * KU + 64 + n] = f2bf(ci + pi[i]);
        const float tr = a.x * cr - a.y * ci, ti = a.x * ci + a.y * cr; cr = tr; ci = ti;
    }
    __syncthreads();
}

struct AttnDesc { int bh, j, row0, nrows, diag; };
__device__ __forceinline__ void attn_dma(const Params& P, LAS unsigned char* buf, const AttnDesc& u, int wid, int lane) {
    const size_t blkoff = ((size_t)u.bh * SEQ + u.j * 256) * HD;
    const bf16_t* kg = (const bf16_t*)(P.ws + WS_KH) + blkoff; const bf16_t* vg = (const bf16_t*)(P.ws + WS_VT) + blkoff;
#pragma unroll
    for (int i = 0; i < 4; ++i) {
        const int c = wid * 4 + i;
        { const int rho = c * 8 + (lane >> 3), cc = (lane & 7) ^ ((rho >> 1) & 7), kv = (rho & ~12) | ((rho & 4) << 1) | ((rho & 8) >> 1);
          __builtin_amdgcn_global_load_lds((const unsigned*)(kg + kv * 64 + cc * 8), (LAS unsigned*)(buf + c * 1024), 16, 0, 0); }
        { const int dd = c * 2 + (lane >> 5), c16 = (lane & 31) ^ (dd & 15);
          __builtin_amdgcn_global_load_lds((const unsigned*)(vg + dd * 256 + c16 * 8), (LAS unsigned*)(buf + 32768 + c * 1024), 16, 0, 0); }
    }
}
__device__ __forceinline__ unsigned attn_entry(const Params& P, const AttnDesc& u, int rq) {
    if (u.diag) return (unsigned)(u.j * 256 + rq) | (3u << 13);
    return (rq < u.nrows) ? (unsigned)((const unsigned short*)(P.ws + WS_LISTS))[(size_t)(u.bh * NBLK + u.j) * SEQ + u.row0 + rq] : 0u;
}
__device__ __forceinline__ void attn_qload(const Params& P, bf16x8 (&qf)[4], int bh, unsigned e, int hi) {
    const bf16_t* qp = (const bf16_t*)(P.ws + WS_QH) + ((size_t)bh * SEQ + (e & 0x1fff)) * HD + hi * 8;
#pragma unroll
    for (int d0 = 0; d0 < 4; ++d0) qf[d0] = *(const bf16x8*)(qp + d0 * 16);
}

template <class F> __device__ __forceinline__ void block_prefix_1024(LAS int* pre, LAS int* wt, int tid, const F& val) {
    const int lane = tid & 63, wid = tid >> 6;
    const int a = val(2 * tid), b = val(2 * tid + 1), s = a + b;
    int inc = s;
#pragma unroll
    for (int o = 1; o < 64; o <<= 1) { const int v = shup(inc, o, lane); if (lane >= o) inc += v; }
    if (lane == 63) wt[wid] = inc;
    __syncthreads();
    int woff = 0;
    for (int w = 0; w < wid; ++w) woff += wt[w];
    const int ex = inc - s + woff;
    pre[2 * tid] = ex; pre[2 * tid + 1] = ex + a;
    if (tid == 511) pre[1024] = ex + s;
    __syncthreads();
}

__device__ __forceinline__ bool attn_unit_desc(const Params& P, const LAS int* pre, int total, int nunits, int u, AttnDesc& D) {
    if (u >= nunits) return false;
    if (u < total) {
        int lo = 0, hi = 1023;
        while (lo < hi) { const int mid = (lo + hi + 1) >> 1; if (pre[mid] <= u) lo = mid; else hi = mid - 1; }
        const int L = __builtin_amdgcn_readfirstlane(lo), tile = u - __builtin_amdgcn_readfirstlane(pre[L]);
        const int cnt = __builtin_amdgcn_readfirstlane(pre[1040 + L]);
        D.bh = L >> 5; D.j = L & 31; D.row0 = tile * 256; D.nrows = min(256, cnt - tile * 256); D.diag = 0;
    } else { const int d = u - total; D.bh = d >> 5; D.j = d & 31; D.row0 = 0; D.nrows = 256; D.diag = 1; }
    return true;
}
#define ATT_QK(sacc, kt) do { const int rho_ = (kt) * 32 + r32; const LAS unsigned char* kb_ = buf + rho_ * 128; const int sw_ = (rho_ >> 1) & 7; \
        { const bf16x8 kf_ = *(const LAS bf16x8*)(kb_ + ((hi ^ sw_) << 4)); sacc = __builtin_amdgcn_mfma_f32_32x32x16_bf16(kf_, qf[0], cinit, 0, 0, 0); } \
        _Pragma("unroll") for (int d0 = 1; d0 < 4; ++d0) { const bf16x8 kf_ = *(const LAS bf16x8*)(kb_ + (((d0 * 2 + hi) ^ sw_) << 4)); sacc = __builtin_amdgcn_mfma_f32_32x32x16_bf16(kf_, qf[d0], sacc, 0, 0, 0); } } while (0)
#define ATT_PV(sacc, kt) do { _Pragma("unroll") for (int r = 0; r < 16; ++r) { const float p_ = __builtin_amdgcn_exp2f(sacc[r]); sacc[r] = p_; l += p_; } \
        _Pragma("unroll") for (int s2 = 0; s2 < 2; ++s2) { u32x4 pw_; pw_.x = pk2(sacc[8 * s2 + 0], sacc[8 * s2 + 1]); pw_.y = pk2(sacc[8 * s2 + 2], sacc[8 * s2 + 3]); pw_.z = pk2(sacc[8 * s2 + 4], sacc[8 * s2 + 5]); pw_.w = pk2(sacc[8 * s2 + 6], sacc[8 * s2 + 7]); \
            const bf16x8 pf_ = __builtin_bit_cast(bf16x8, pw_); \
            _Pragma("unroll") for (int dt = 0; dt < 2; ++dt) { const int dd_ = dt * 32 + r32; \
                const bf16x8 vf_ = *(const LAS bf16x8*)(buf + 32768 + dd_ * 512 + ((((kt) * 4 + 2 * s2 + hi) ^ (dd_ & 15)) << 4)); \
                ot[dt] = __builtin_amdgcn_mfma_f32_32x32x16_bf16(vf_, pf_, ot[dt], 0, 0, 0); } } } while (0)
__device__ __forceinline__ void attn_phase(const Params& P, LAS unsigned char* lds, int G, const int tid) {
    unsigned char* ws = P.ws;
    LAS int* pre = (LAS int*)(lds + MISC_OFF);
    LAS int* wt = pre + 1032;
    const int* lcnt = (const int*)(ws + WS_CTL) + CW_LCNT;
    { const int c0 = lcnt[2 * tid], c1 = lcnt[2 * tid + 1]; pre[1040 + 2 * tid] = c0; pre[1040 + 2 * tid + 1] = c1; }
    block_prefix_1024(pre, wt, tid, [&](int i) { return (pre[1040 + i] + 255) >> 8; });
    const int total = __builtin_amdgcn_readfirstlane(pre[1024]), nunits = total + NBH * NBLK;
    const int lane = tid & 63, wid = __builtin_amdgcn_readfirstlane(tid >> 6), r32 = lane & 31, hi = lane >> 5, rq = wid * 32 + r32;
    float gq = 0.f, gk = 0.f;
    for (int d = 0; d < HD; ++d) { gq = fmaxf(gq, fabsf(P.in[I_QG][d])); gk = fmaxf(gk, fabsf(P.in[I_KG][d])); }
    const float negB = -(64.0f * QSCALE * 1.02f) * gq * gk;
    f32x16 cinit;
#pragma unroll
    for (int r = 0; r < 16; ++r) cinit[r] = negB;
    LAS int* dtab = pre + 2080;
    if (tid < 64) {
        const int uu = (int)blockIdx.x + tid * G;
        if (uu < nunits) {
            LAS int* e = dtab + tid * 8;
            if (uu < total) {
                int lo = 0, hi2 = 1023;
                while (lo < hi2) { const int mid = (lo + hi2 + 1) >> 1; if (pre[mid] <= uu) lo = mid; else hi2 = mid - 1; }
                const int tile = uu - pre[lo], cnt = pre[1040 + lo];
                e[0] = lo >> 5; e[1] = lo & 31; e[2] = tile * 256; e[3] = min(256, cnt - tile * 256); e[4] = 0;
            } else { const int d = uu - total; e[0] = d >> 5; e[1] = d & 31; e[2] = 0; e[3] = 256; e[4] = 1; }
        }
    }
    __syncthreads();
    const int nmine = ((int)blockIdx.x < nunits) ? (nunits - 1 - (int)blockIdx.x) / G + 1 : 0;
#define ATT_DESC(i, D) ((i) < nmine ? ((D).bh = __builtin_amdgcn_readfirstlane(dtab[(i) * 8]), (D).j = __builtin_amdgcn_readfirstlane(dtab[(i) * 8 + 1]), (D).row0 = __builtin_amdgcn_readfirstlane(dtab[(i) * 8 + 2]), \
        (D).nrows = __builtin_amdgcn_readfirstlane(dtab[(i) * 8 + 3]), (D).diag = __builtin_amdgcn_readfirstlane(dtab[(i) * 8 + 4]), true) : false)
    AttnDesc cur, nxt, nn;
    int ui = 0;
    if (!ATT_DESC(0, cur)) return;
    bool has_next = ATT_DESC(1, nxt);
    unsigned ecur = attn_entry(P, cur, rq), enext = has_next ? attn_entry(P, nxt, rq) : 0u;
    attn_dma(P, lds, cur, wid, lane);
    bf16x8 qf[4], qn[4];
    attn_qload(P, qf, cur.bh, ecur, hi);
    asm volatile("s_waitcnt vmcnt(0) lgkmcnt(0)" ::: "memory"); __builtin_amdgcn_s_barrier();
    int b = 0;
    for (;;) {
        LAS unsigned char* buf = lds + b * 65536;
#ifdef PROBE_A
        const unsigned long long tu0_ = __builtin_amdgcn_s_memrealtime();
#endif
        const bool has_nn = has_next && ATT_DESC(ui + 2, nn);
        unsigned enn = 0u;
        if (has_nn) enn = attn_entry(P, nn, rq);
        if (has_next) { attn_dma(P, lds + (b ^ 1) * 65536, nxt, wid, lane); attn_qload(P, qn, nxt.bh, enext, hi); }
        else {
#pragma unroll
            for (int d0 = 0; d0 < 4; ++d0) qn[d0] = qf[d0]; }
        f32x16 ot[2];
#pragma unroll
        for (int r = 0; r < 16; ++r) { ot[0][r] = 0.f; ot[1][r] = 0.f; }
        float l = 0.f;
        if (!cur.diag) {
            f32x16 sA, sB;
            ATT_QK(sA, 0);
            ATT_QK(sB, 1); ATT_PV(sA, 0);
            ATT_QK(sA, 2); ATT_PV(sB, 1);
            ATT_QK(sB, 3); ATT_PV(sA, 2);
            ATT_QK(sA, 4); ATT_PV(sB, 3);
            ATT_QK(sB, 5); ATT_PV(sA, 4);
            ATT_QK(sA, 6); ATT_PV(sB, 5);
            ATT_QK(sB, 7); ATT_PV(sA, 6);
            ATT_PV(sB, 7);
        } else {
            int qrel = r32 - 8 * hi; asm volatile("" : "+v"(qrel));
#pragma unroll
            for (int kt = 0; kt < 8; ++kt) {
                if (kt <= wid) {
                    f32x16 sA; ATT_QK(sA, kt);
                    if (kt == wid) {
#pragma unroll
                        for (int r = 0; r < 16; ++r) if ((r & 3) + 4 * ((r >> 2) & 1) + 16 * (r >> 3) > qrel) sA[r] = -INFINITY;
                    }
                    ATT_PV(sA, kt);
                }
            }
        }
        l += shx(l, 32, lane);
#ifdef PROBE_A
        const unsigned long long tw0_ = __builtin_amdgcn_s_memrealtime();
        if (blockIdx.x == PROBE_BLK && tid == PROBE_TID) { LAS unsigned long long* t_ = (LAS unsigned long long*)(lds + MISC_OFF + 12288); if (cur.diag) { t_[35] += tw0_ - tu0_; t_[36] += 100; } else { t_[33] += tw0_ - tu0_; t_[34] += 100; } }
        asm volatile("s_waitcnt vmcnt(0) lgkmcnt(0)" ::: "memory");
        const unsigned long long tw1_ = __builtin_amdgcn_s_memrealtime();
        __builtin_amdgcn_s_barrier(); asm volatile("" ::: "memory");
        if (blockIdx.x == PROBE_BLK && tid == 0) { LAS unsigned long long* t_ = (LAS unsigned long long*)(lds + MISC_OFF + 12288); t_[30] += tw1_ - tw0_; t_[32] += __builtin_amdgcn_s_memrealtime() - tw1_; }
#else
        asm volatile("s_waitcnt vmcnt(0) lgkmcnt(0)" ::: "memory"); __builtin_amdgcn_s_barrier(); asm volatile("" ::: "memory");
#endif
        if (rq < cur.nrows) {
            const int spos = ecur & 0x1fff, slot = ecur >> 13;
            const size_t prow = ((size_t)((cur.bh >> 3) * SEQ + spos) * NH + (cur.bh & 7)) * 4 + slot;
            if (hi == 0) ((f32x2*)(ws + WS_PML))[prow] = (f32x2){0.f, l};
        }
        {
            const int spos = ecur & 0x1fff, slot = ecur >> 13;
            const unsigned prow = (unsigned)((((cur.bh >> 3) * SEQ + spos) * NH + (cur.bh & 7)) * 4 + slot);
            const float inv = 1.0f / l;
            LAS unsigned char* patch = buf + wid * 4096;
            LAS unsigned* prw = (LAS unsigned*)(lds + MISC_OFF + 10496) + wid * 32;
            if (hi == 0) prw[r32] = (rq < cur.nrows) ? prow : 0xffffffffu;
#pragma unroll
            for (int dt = 0; dt < 2; ++dt)
#pragma unroll
                for (int g4 = 0; g4 < 4; ++g4) {
                    u32x2 w; w.x = pk2(ot[dt][4 * g4] * inv, ot[dt][4 * g4 + 1] * inv); w.y = pk2(ot[dt][4 * g4 + 2] * inv, ot[dt][4 * g4 + 3] * inv);
                    *(LAS u32x2*)(patch + r32 * 128 + (((4 * dt + g4) ^ (r32 & 7)) << 4) + 8 * hi) = w;
                }
            asm volatile("s_waitcnt lgkmcnt(0)" ::: "memory"); __builtin_amdgcn_wave_barrier();
#pragma unroll
            for (int it = 0; it < 4; ++it) {
                const int row = it * 8 + (lane >> 3), pc = lane & 7;
                const unsigned pr = prw[row];
                const u32x4 v = *(const LAS u32x4*)(patch + row * 128 + (pc << 4));
                if (pr != 0xffffffffu) *(u32x4*)((bf16_t*)P.out + (size_t)pr * HD + ((pc ^ (row & 7)) << 3)) = v;
            }
            asm volatile("s_waitcnt lgkmcnt(0)" ::: "memory");
        }
        if (!has_next) break;
        cur = nxt; nxt = nn; has_next = has_nn; ++ui; b ^= 1; ecur = enext; enext = enn;
#pragma unroll
        for (int d0 = 0; d0 < 4; ++d0) qf[d0] = qn[d0];
    }
    asm volatile("s_waitcnt vmcnt(0)" ::: "memory");
    __syncthreads();
}
#undef ATT_QK
#undef ATT_PV
#undef ATT_DESC

__device__ __forceinline__ void combine_phase(const Params& P, int G, const int tid) {
    unsigned char* ws = P.ws;
    const f32x2* PML = (const f32x2*)(ws + WS_PML); const bf16_t* PO = (const bf16_t*)P.out; bf16_t* ATT = (bf16_t*)(ws + WS_ATT);
    constexpr int NIT = T * NH * 4;
    for (int idx0 = blockIdx.x * 512 + tid; idx0 < NIT; idx0 += 2 * G * 512) {
        float ll[2][4]; u32x4 pw[2][4][2];
#pragma unroll
        for (int t = 0; t < 2; ++t) {
            const int idx = idx0 + t * G * 512; const bool in = idx < NIT; const int ii = in ? idx : idx0;
            const int qd = ii & 3, th = ii >> 2, token = th >> 3, qblk = (token & (SEQ - 1)) >> 8, nv = qblk < 3 ? qblk : 3;
#pragma unroll
            for (int sl = 0; sl < 4; ++sl) {
                const bool v = (sl < nv) || (sl == 3);
                ll[t][sl] = v ? PML[(size_t)th * 4 + sl].y : 0.f;
                const u32x4* pp = (const u32x4*)(PO + ((size_t)th * 4 + (v ? sl : 3)) * HD + qd * 16);
                pw[t][sl][0] = pp[0]; pw[t][sl][1] = pp[1];
            }
        }
#pragma unroll
        for (int t = 0; t < 2; ++t) {
            const int idx = idx0 + t * G * 512; if (idx >= NIT) break;
            const int qd = idx & 3, th = idx >> 2, token = th >> 3, head = th & 7;
            float o[16];
#pragma unroll
            for (int i = 0; i < 16; ++i) o[i] = 0.f;
            float W = 0.f;
#pragma unroll
            for (int sl = 0; sl < 4; ++sl) {
                const float w = ll[t][sl]; W += w;
                f32x4 a, b, c, d; unpk8(pw[t][sl][0], a, b); unpk8(pw[t][sl][1], c, d);
#pragma unroll
                for (int i = 0; i < 4; ++i) { o[i] += w * a[i]; o[4 + i] += w * b[i]; o[8 + i] += w * c[i]; o[12 + i] += w * d[i]; }
            }
            const float inv = 1.0f / W;
            u32x4 w0, w1;
            w0.x = pk2(o[0] * inv, o[1] * inv); w0.y = pk2(o[2] * inv, o[3] * inv); w0.z = pk2(o[4] * inv, o[5] * inv); w0.w = pk2(o[6] * inv, o[7] * inv);
            w1.x = pk2(o[8] * inv, o[9] * inv); w1.y = pk2(o[10] * inv, o[11] * inv); w1.z = pk2(o[12] * inv, o[13] * inv); w1.w = pk2(o[14] * inv, o[15] * inv);
            u32x4* dp = (u32x4*)(ATT + (size_t)token * SSMW + head * HD + qd * 16);
            dp[0] = w0; dp[1] = w1;
        }
    }
}

__device__ __forceinline__ void route_phase(const Params& P, LAS unsigned char* lds, int G, const int tid) {
    unsigned char* ws = P.ws;
    const int lane = tid & 63, wid = __builtin_amdgcn_readfirstlane(tid >> 6), rr = lane & 15, kq = lane >> 4;
    LAS float* lg = (LAS float*)(lds + 65536 + wid * 3200);
    LAS int* he = (LAS int*)(lds + MISC_OFF);
    LAS int* hp = he + 32;
    LAS int* be = hp + 112;
    LAS int* bp = be + 32;
    int* gcnt = (int*)(ws + WS_CTL);
    const bf16_t* WHL = (const bf16_t*)(ws + WS_WRT);
    const bf16_t* X1H = (const bf16_t*)(ws + WS_X1B); const bf16_t* X1L = (const bf16_t*)(ws + WS_X1L);
    constexpr int WROW = 136;
    constexpr int NSTG = 8, STG_BYTES = 96 * WROW * 2;
    for (int base = 0; base < T / 16; base += G * 8) {
        const int tile = base + blockIdx.x * 8 + wid; const bool active = tile < T / 16;
        if (tid < 144) he[tid] = 0;
        u32x4 wq[3];
#pragma unroll
        for (int i = 0; i < 3; ++i) { const int pc = tid + 512 * i, row = pc >> 4, ch = pc & 15; wq[i] = *(const u32x4*)(WHL + (size_t)row * DM + ch * 8); }
#pragma unroll
        for (int i = 0; i < 3; ++i) { const int pc = tid + 512 * i, row = pc >> 4, ch = pc & 15; *(LAS u32x4*)(lds + (row * WROW + ch * 8) * 2) = wq[i]; }
        const size_t arow = (size_t)((active ? tile : 0) * 16 + rr) * DM + kq * 8;
        bf16x8 ah[4], al[4];
#pragma unroll
        for (int k = 0; k < 4; ++k) { ah[k] = *(const bf16x8*)(X1H + arow + k * 32); al[k] = (bf16x8){0, 0, 0, 0, 0, 0, 0, 0}; }
        f32x4 acc[3]; float ssq = 0.f;
#pragma unroll
        for (int ct = 0; ct < 3; ++ct) acc[ct] = (f32x4){0.f, 0.f, 0.f, 0.f};
        __syncthreads();
#pragma unroll 1
        for (int q = 0; q < NSTG; ++q) {
            LAS unsigned char* wb = lds + (q & 1) * STG_BYTES;
            const int qn = (q + 1 < NSTG) ? q + 1 : q;
#pragma unroll
            for (int i = 0; i < 3; ++i) { const int pc = tid + 512 * i, row = pc >> 4, ch = pc & 15; wq[i] = *(const u32x4*)(WHL + (size_t)row * DM + qn * 128 + ch * 8); }
            bf16x8 nh[4], nl[4];
#pragma unroll
            for (int k = 0; k < 4; ++k) { nh[k] = *(const bf16x8*)(X1H + arow + qn * 128 + k * 32); nl[k] = (bf16x8){0, 0, 0, 0, 0, 0, 0, 0}; }
#pragma unroll
            for (int k = 0; k < 4; ++k) {
                { const u32x4 hw = __builtin_bit_cast(u32x4, ah[k]), lw = __builtin_bit_cast(u32x4, al[k]); f32x4 h0, h1, l0, l1; unpk8(hw, h0, h1); unpk8(lw, l0, l1);
                  const f32x4 x0 = h0 + l0, x1 = h1 + l1; ssq += (x0.x * x0.x + x0.y * x0.y) + (x0.z * x0.z + x0.w * x0.w) + (x1.x * x1.x + x1.y * x1.y) + (x1.z * x1.z + x1.w * x1.w); }
#pragma unroll
                for (int ct = 0; ct < 3; ++ct) {
                    const LAS unsigned char* bpw = wb + ((ct * 16 + rr) * WROW + k * 32 + kq * 8) * 2;
                    const bf16x8 bh = *(const LAS bf16x8*)bpw, bl = *(const LAS bf16x8*)(bpw + 48 * WROW * 2);
                    acc[ct] = __builtin_amdgcn_mfma_f32_16x16x32_bf16(ah[k], bh, acc[ct], 0, 0, 0);
                    acc[ct] = __builtin_amdgcn_mfma_f32_16x16x32_bf16(ah[k], bl, acc[ct], 0, 0, 0);
                }
            }
            {
                LAS unsigned char* wn = lds + ((q + 1) & 1) * STG_BYTES;
#pragma unroll
                for (int i = 0; i < 3; ++i) { const int pc = tid + 512 * i, row = pc >> 4, ch = pc & 15; *(LAS u32x4*)(wn + (row * WROW + ch * 8) * 2) = wq[i]; }
#pragma unroll
                for (int k = 0; k < 4; ++k) { ah[k] = nh[k]; al[k] = nl[k]; }
            }
            __syncthreads();
        }
        int E0 = 0, E1 = 0, pp = 0, sl0 = 0, re0 = 0, re1 = 0, rp = 0; float w0 = 0.f, w1 = 0.f, r2 = 0.f;
        if (active) {
            ssq += shx(ssq, 16, lane); ssq += shx(ssq, 32, lane);
#pragma unroll
            for (int ct = 0; ct < 3; ++ct)
#pragma unroll
                for (int rg = 0; rg < 4; ++rg) lg[(kq * 4 + rg) * 49 + ct * 16 + rr] = acc[ct][rg];
            asm volatile("s_waitcnt lgkmcnt(0)" ::: "memory"); __builtin_amdgcn_wave_barrier();
            if (lane < 16) {
                r2 = 1.0f / sqrtf(ssq * (1.f / DM) + EPS);
                const LAS float* row = lg + lane * 49;
                float gl[4]; int gi = 0; float gmax = -INFINITY;
#pragma unroll
                for (int c = 0; c < 4; ++c) { gl[c] = row[c] * r2 + P.in[I_BRG][c]; if (gl[c] > gmax) { gmax = gl[c]; gi = c; } }
                float den = 0.f;
#pragma unroll
                for (int c = 0; c < 4; ++c) den += __expf(gl[c] - gmax);
                const float gp = 1.0f / den;
                float ev[8];
#pragma unroll
                for (int e = 0; e < 8; ++e) ev[e] = row[4 + gi * 8 + e] * r2 + P.in[I_BREX][gi * 8 + e];
                int i0 = 0; float v0 = -INFINITY;
#pragma unroll
                for (int e = 0; e < 8; ++e) if (ev[e] > v0) { v0 = ev[e]; i0 = e; }
                int i1 = 0; float v1 = -INFINITY;
#pragma unroll
                for (int e = 0; e < 8; ++e) if (e != i0 && ev[e] > v1) { v1 = ev[e]; i1 = e; }
                const float tt = __expf(v1 - v0);
                w0 = gp / (1.0f + tt); w1 = gp * tt / (1.0f + tt);
                const int lo = i0 < i1 ? i0 : i1, hh = i0 < i1 ? i1 : i0;
                pp = gi * 28 + (lo * (15 - lo)) / 2 + (hh - lo - 1);
                sl0 = (i0 == lo) ? 0 : 1;
                E0 = gi * 8 + i0; E1 = gi * 8 + i1;
                re0 = atomicAdd((int*)&he[E0], 1); re1 = atomicAdd((int*)&he[E1], 1); rp = atomicAdd((int*)&hp[pp], 1);
            }
        }
        __syncthreads();
        if (tid < 144) { const int h = he[tid]; be[tid] = h ? atomicAdd(gcnt + (tid < 32 ? CW_ECNT + tid : CW_PCNT + tid - 32), h) : 0; }
        __syncthreads();
        if (active && lane < 16) {
            const int token = tile * 16 + lane;
            const int rankp = bp[pp] + rp;
            const size_t i0x = (size_t)E0 * T + be[E0] + re0, i1x = (size_t)E1 * T + be[E1] + re1;
            ((int*)(ws + WS_ELTOK))[i0x] = token; ((int*)(ws + WS_ELDST))[i0x] = (pp << 17) | (sl0 << 16) | rankp; ((float*)(ws + WS_ELW))[i0x] = w0; ((float*)(ws + WS_ELR2))[i0x] = r2;
            ((int*)(ws + WS_ELTOK))[i1x] = token; ((int*)(ws + WS_ELDST))[i1x] = (pp << 17) | ((1 - sl0) << 16) | rankp; ((float*)(ws + WS_ELW))[i1x] = w1; ((float*)(ws + WS_ELR2))[i1x] = r2;
            ((int*)(ws + WS_PLTOK))[(size_t)pp * T + rankp] = token;
        }
        __syncthreads();
    }
}

struct MoeTables { LAS int *ecnt, *efpre, *eplist, *pcnt, *pfpre, *pplist, *pairoff; int enfull, enpart, pnfull, pnpart; };
__device__ __forceinline__ MoeTables moe_tables(const Params& P, LAS unsigned char* lds, int tid) {
    MoeTables M;
    M.ecnt = (LAS int*)(lds + MISC_OFF); M.efpre = M.ecnt + 32; M.eplist = M.efpre + 40; M.pcnt = M.eplist + 32; M.pfpre = M.pcnt + 112; M.pplist = M.pfpre + 120; M.pairoff = M.pplist + 112;
    LAS int* hdr = M.pairoff + 120;
    const int* gcnt = (const int*)(P.ws + WS_CTL);
    if (tid < 32) M.ecnt[tid] = gcnt[CW_ECNT + tid];
    if (tid >= 64 && tid < 64 + NPAIR) M.pcnt[tid - 64] = gcnt[CW_PCNT + tid - 64];
    __syncthreads();
    if (tid == 0) { int s = 0, np = 0; for (int e = 0; e < NE; ++e) { M.efpre[e] = s; s += M.ecnt[e] >> 8; if (M.ecnt[e] & 255) M.eplist[np++] = e; } M.efpre[NE] = s; hdr[0] = s; hdr[1] = np; }
    if (tid == 64) { int s = 0, r = 0, np = 0; for (int p = 0; p < NPAIR; ++p) { M.pfpre[p] = s; M.pairoff[p] = r; s += M.pcnt[p] >> 8; r += ((M.pcnt[p] + 255) >> 8) * 256; if (M.pcnt[p] & 255) M.pplist[np++] = p; } M.pfpre[NPAIR] = s; M.pairoff[NPAIR] = r; hdr[2] = s; hdr[3] = np; }
    __syncthreads();
    M.enfull = __builtin_amdgcn_readfirstlane(hdr[0]); M.enpart = __builtin_amdgcn_readfirstlane(hdr[1]); M.pnfull = __builtin_amdgcn_readfirstlane(hdr[2]); M.pnpart = __builtin_amdgcn_readfirstlane(hdr[3]);
    return M;
}

constexpr int CW_BAR = 8192;
#define XB_TMO      128
#define XB_XCNT(j)  (256  + 64 * (j))
#define XB_XSUB(j)  (1280 + 64 * (j))
#define XB_XGEN(j)  (2304 + 64 * (j))
#define XB_TOP      3328
#define XB_TOPGEN   3392
#define XCD_BAR_WORDS 3456
#define XB_SPIN_CAP (1u << 18)
__device__ __forceinline__ unsigned xb_ld(unsigned* p)              { return __hip_atomic_load(p, __ATOMIC_RELAXED, __HIP_MEMORY_SCOPE_AGENT); }
__device__ __forceinline__ unsigned xb_add(unsigned* p, unsigned v) { return __hip_atomic_fetch_add(p, v, __ATOMIC_RELAXED, __HIP_MEMORY_SCOPE_AGENT); }
__device__ __forceinline__ unsigned xb_xcc_id() { return (unsigned)__builtin_amdgcn_s_getreg((3 << 11) | 20) & 0xFu; }
#define XB_SPIN(cond, bar) do { unsigned _sp = 0; while (cond) { __builtin_amdgcn_s_sleep(1); \
    if ((++_sp & 255u) == 0u) { if (xb_ld(&(bar)[XB_TMO])) break; if (_sp > XB_SPIN_CAP) { atomicAdd(&(bar)[XB_TMO], 1u); break; } } } } while (0)
struct XcdBarrier { unsigned* bar; unsigned x; volatile LAS unsigned* st; };
__device__ __forceinline__ XcdBarrier xcd_barrier_post(unsigned* bar, volatile LAS unsigned* st) {
    XcdBarrier b; b.bar = bar; b.x = xb_xcc_id(); b.st = st;
    if (threadIdx.x == 0) (void)xb_add(&bar[XB_XCNT(b.x)], 1u);
    return b;
}
__device__ __forceinline__ void xcd_barrier_complete(unsigned* bar, unsigned x, unsigned& nloc, unsigned& nx) {
    const unsigned G = gridDim.x * gridDim.y * gridDim.z;
    unsigned sum, cnt, mine, sp = 0u;
    for (;;) {
        sum = 0u; cnt = 0u; mine = 0u;
#pragma unroll
        for (unsigned j = 0; j < 16; ++j) { const unsigned c = xb_ld(&bar[XB_XCNT(j)]); sum += c; cnt += (c > 0u) ? 1u : 0u; mine = (j == x) ? c : mine; }
        if (sum == G) break;
        __builtin_amdgcn_s_sleep(1);
        if ((++sp & 255u) == 0u) { if (xb_ld(&bar[XB_TMO])) break; if (sp > XB_SPIN_CAP) { atomicAdd(&bar[XB_TMO], 1u); break; } }
    }
    nloc = mine > 0u ? mine : 1u; nx = cnt > 0u ? cnt : 1u;
}
__device__ __forceinline__ void xcd_barrier(const XcdBarrier& b, const int tid) {
    asm volatile("s_waitcnt vmcnt(0)" ::: "memory");
    __syncthreads();
    if (tid == 0) {
        unsigned* bar = b.bar;
        __builtin_amdgcn_s_waitcnt(0);
        unsigned nloc = b.st[0], nx = b.st[1];
        if (nloc == 0u) { xcd_barrier_complete(bar, b.x, nloc, nx); b.st[0] = nloc; b.st[1] = nx; }
        const unsigned old = xb_add(&bar[XB_XSUB(b.x)], 1u);
        const unsigned gen = old / nloc;
        if (old + 1u == (gen + 1u) * nloc) {
            __builtin_amdgcn_fence(__ATOMIC_RELEASE, "agent");
            asm volatile("s_waitcnt vmcnt(0)" ::: "memory");
            const unsigned og = xb_add(&bar[XB_TOP], 1u);
            const unsigned tg = og / nx;
            if (og + 1u == (tg + 1u) * nx) xb_add(&bar[XB_TOPGEN], 1u);
            else XB_SPIN(xb_ld(&bar[XB_TOPGEN]) == tg, bar);
            __builtin_amdgcn_fence(__ATOMIC_ACQUIRE, "agent");
            xb_add(&bar[XB_XGEN(b.x)], 1u);
            asm volatile("s_waitcnt vmcnt(0)" ::: "memory");
        } else {
            XB_SPIN(xb_ld(&bar[XB_XGEN(b.x)]) == gen, bar);
            __builtin_amdgcn_fence(__ATOMIC_ACQUIRE, "agent");
            asm volatile("s_waitcnt vmcnt(0)" ::: "memory");
        }
    }
    __syncthreads();
}

#ifndef N_PHASES
#define N_PHASES 11
#endif
__global__ void __launch_bounds__(512, 2) hybrid_fwd(Params P) {
    extern __shared__ __attribute__((aligned(16))) unsigned char lds_raw[];
    LAS unsigned char* lds = (LAS unsigned char*)lds_raw;
    const int G = gridDim.x, c = blockIdx.x, wave = __builtin_amdgcn_readfirstlane(threadIdx.x >> 6);
#define FT fresh_tid(wave)
    volatile LAS unsigned* bst = (volatile LAS unsigned*)(lds + LDS_BYTES - 16);
    if (threadIdx.x == 0) { bst[0] = 0u; bst[1] = 0u; }
    __syncthreads();
    const XcdBarrier bar = xcd_barrier_post((unsigned*)(P.ws + WS_CTL) + CW_BAR, bst);
#define GRID_SYNC() xcd_barrier(bar, FT)
#ifndef PROBE_TID
#define PROBE_TID 0
#endif
#ifdef PROBE_A
    LAS unsigned long long* tsl = (LAS unsigned long long*)(lds + MISC_OFF + 12288);
#define STAMP(i) do { if (blockIdx.x == PROBE_BLK && threadIdx.x == 0) tsl[i] = __builtin_amdgcn_s_memrealtime(); } while (0)
#else
#define STAMP(i) do { } while (0)
#endif
    STAMP(0);
#ifdef PROBE_A
    if (blockIdx.x == PROBE_BLK && threadIdx.x == 0) { for (int i_ = 30; i_ < 40; ++i_) tsl[i_] = 0; }
#endif
    unsigned char* ws = P.ws;
#define BF(off) ((bf16_t*)(ws + (off)))
    phase0(P, lds, G, FT);
    GRID_SYNC();
    STAMP(1);
    { ProjOrder S; S.g.init(T / 256, 1536 / 256, DM, DM, DM, G, c); S.nmain = (T / 256) * 6;
      EpiProj E{BF(WS_UGS), BF(WS_QH), BF(WS_KH), BF(WS_VT), P.in[I_QG], P.in[I_KG], (const float*)(ws + WS_ROPE), (float*)(ws + WS_KMEAN), (LAS float*)(lds + MISC_OFF)};
      gk::gemm_phase<EpiProj, ProjOrder, false, false>(lds, FT, (const bf16_t*)ws, DM, (const bf16_t*)ws, DM, S, E); }
    GRID_SYNC();
    STAMP(2);
    select_phase(P, lds, G, FT);
    STAMP(22);
    STAMP(23);
    {
        const int nel = NG * 4, nslots = (G > nel) ? nel + 2 * (G - nel) : G;
        const int s0 = (G > nel && c >= nel) ? nel + 2 * (c - nel) : c, ns = (G > nel && c >= nel) ? 2 : 1;
        for (int k = 0; k < ns; ++k) tg_expand(P, G, FT, s0 + k, nslots);
        STAMP(24);
        for (int k = 0; k < ns; ++k) { late_transposes(P, lds, G, FT, 0, s0 + k, nslots); late_transposes(P, lds, G, FT, 1, s0 + k, nslots); }
    }
    { ElocOrder S{G, c}; EpiEloc E{(float*)(ws + WS_ELOC)};
      gk::gemm_phase<EpiEloc, ElocOrder, false, false>(lds, FT, BF(WS_UGS), KU, BF(WS_MIN), NTC, S, E); }
    GRID_SYNC();
    STAMP(3);
    STAMP(4);
    for (int L = c; L < NG * 8; L += G) { const int g = L >> 3, bb = (L >> 1) & 3; carry_scan(P, lds, (g * 4 + bb) * 2, FT); carry_scan(P, lds, (g * 4 + bb) * 2 + 1, FT); }
    asm volatile("s_waitcnt vmcnt(0)" ::: "memory"); __syncthreads();
    { SsmOrder S{G, c}; EpiSsm E{BF(WS_Z)};
      gk::gemm_phase<EpiSsm, SsmOrder, false, false>(lds, FT, BF(WS_UGS), KU, BF(WS_TG), KU, S, E); }
    STAMP(20);
    attn_phase(P, lds, G, FT);
    STAMP(21);
    GRID_SYNC();
    STAMP(5);
    combine_phase(P, G, FT);
    STAMP(25);
    { gk::GridOrder S; S.init(T / 256, SSMW / 256, SSMW, SSMW, SSMW, G, c);
      EpiGlu E{BF(WS_Z), P.in[I_BGLU], BF(WS_OS)};
      gk::gemm_phase<EpiGlu, gk::GridOrder, false, false>(lds, FT, BF(WS_Z), SSMW, BF(WS_WGLU), SSMW, S, E); }
    GRID_SYNC();
    STAMP(6);
    { MergeOrder S; S.g.init(T / 256, DM / 256, DM, DM, DM, G, c); S.order = (c >> 3) & 1;
      EpiMerge E{BF(WS_MG), BF(WS_TMP)};
      gk::gemm_phase<EpiMerge, MergeOrder, false, false, true, 6>(lds, FT, (const bf16_t*)ws, DM, (const bf16_t*)ws, DM, S, E); }
    GRID_SYNC();
    STAMP(7);
    { gk::GridOrder S; S.init(T / 256, DM / 256, DM, DM, DM, G, c);
      EpiOut E{P.in[I_X], BF(WS_X1B), nullptr};
      gk::gemm_phase<EpiOut, gk::GridOrder, false, false, false, 7>(lds, FT, BF(WS_MG), DM, BF(WS_WOUT), DM, S, E); }
    GRID_SYNC();
    STAMP(8);
    route_phase(P, lds, G, FT);
    GRID_SYNC();
    STAMP(9);
    MoeTables M = moe_tables(P, lds, FT);
    { GUOrder S{M.efpre, M.ecnt, M.eplist, M.enfull, M.enpart, (const int*)(ws + WS_ELTOK), G, c};
      EpiGU E{(const int*)(ws + WS_ELDST), (const float*)(ws + WS_ELW), (const float*)(ws + WS_ELR2), BF(WS_ACT), M.pairoff};
      gk::gemm_phase<EpiGU, GUOrder, true, false>(lds, FT, BF(WS_X1B), DM, BF(WS_WGU), DM, S, E); }
    GRID_SYNC();
    STAMP(10);
    { DNOrder S{M.pfpre, M.pcnt, M.pairoff, M.pplist, M.pnfull, M.pnpart, G, c};
      EpiDN E{(const int*)(ws + WS_PLTOK), BF(WS_X1B), BF(WS_X1L), P.out};
      gk::gemm_phase<EpiDN, DNOrder, false, true>(lds, FT, BF(WS_ACT), 256, BF(WS_WDN), NE * DE, S, E); }
    STAMP(11);
#ifdef PROBE_A
    GRID_SYNC();
    if (blockIdx.x == PROBE_BLK && threadIdx.x == 0) { const float us = (float)(tsl[PROBE_B] - tsl[PROBE_A]) * 0.01f; P.out[0] += us * PROBE_SCALE; }
#endif
#undef BF
#undef FT
#undef GRID_SYNC
}

extern "C" void kernel_launch(void* const* d_in, const int* in_sizes, int n_in, void* d_out, int out_size, void* d_ws, size_t ws_size, hipStream_t stream) {
    static int grid = 0;
    if (grid == 0) {
        if (n_in != 26 || in_sizes[0] != T * DM || out_size != T * DM || ws_size < WS_END) {
            fprintf(stderr, "kernel_launch: unexpected shapes (n_in %d, in0 %d, out %d, ws %zu)\n", n_in, n_in > 0 ? in_sizes[0] : -1, out_size, ws_size); grid = -1; return; }
        int dev = 0, cus = 0, per_cu = 0;
        (void)hipGetDevice(&dev);
        (void)hipDeviceGetAttribute(&cus, hipDeviceAttributeMultiprocessorCount, dev);
        (void)hipFuncSetAttribute((const void*)hybrid_fwd, hipFuncAttributeMaxDynamicSharedMemorySize, LDS_BYTES);
        (void)hipOccupancyMaxActiveBlocksPerMultiprocessor(&per_cu, (const void*)hybrid_fwd, 512, LDS_BYTES);
        if (per_cu < 1) { fprintf(stderr, "kernel_launch: occupancy query says %d blocks/CU\n", per_cu); grid = -1; return; }
        grid = cus * (per_cu > 1 ? 1 : per_cu);
        (void)hipGetLastError();
    }
    if (grid < 0) return;
    (void)hipMemsetAsync((char*)d_ws + WS_CTL, 0, 64 * 1024, stream);
    Params p{};
    for (int i = 0; i < 26; ++i) p.in[i] = (const float*)d_in[i];
    p.out = (float*)d_out; p.ws = (unsigned char*)d_ws;
    void* args[] = {&p};
    hipError_t e = hipLaunchCooperativeKernel((const void*)hybrid_fwd, dim3(grid), dim3(512), args, LDS_BYTES, stream);
    if (e != hipSuccess) fprintf(stderr, "cooperative launch failed: %s (grid %d)\n", hipGetErrorString(e), grid);
}
```

```cpp
#include <hip/hip_runtime.h>
#include <hip/hip_cooperative_groups.h>
#include <cstdio>
#include <cstdint>
namespace cg = cooperative_groups;

#define LAS __attribute__((address_space(3)))
typedef unsigned short bf16_t;
typedef short bf16x8 __attribute__((ext_vector_type(8)));
typedef float f32x2 __attribute__((ext_vector_type(2)));
typedef float f32x4 __attribute__((ext_vector_type(4)));
typedef float f32x16 __attribute__((ext_vector_type(16)));
typedef unsigned u32x2 __attribute__((ext_vector_type(2)));
typedef unsigned u32x4 __attribute__((ext_vector_type(4)));
typedef __bf16 bf16x2_t __attribute__((ext_vector_type(2)));

constexpr int NB = 4, SEQ = 8192, T = NB * SEQ, DM = 1024, NIN = 4096;
constexpr int NH = 8, HD = 64, NBH = NB * NH, NBLK = 32, BLK = 256;
constexpr int SSMW = 512, NG = 32, GC = 16, NS = 64;
constexpr int CL = 32, NCH = SEQ / CL, CROWS = NB * NCH  , KU = 128 + CL * GC  , NTC = CL * GC  ;
constexpr int NE = 32, DE = 128, NPAIR = 112;
constexpr float EPS = 1e-6f;
constexpr float QSCALE = 0.125f * 1.4426950408889634f;

constexpr size_t MiB = 1u << 20;
constexpr size_t WS_CTL = 0;
constexpr size_t WS_KMEAN = 1 * MiB;
constexpr size_t WS_A32 = WS_KMEAN + 256 * 1024;
constexpr size_t WS_WRT = WS_A32 + 64 * 1024;
constexpr size_t WS_ROPE = 1 * MiB + 512 * 1024;
constexpr size_t WS_KC = 2 * MiB;
constexpr size_t WS_MIN = 3 * MiB;
constexpr size_t WS_WIN = 8 * MiB;
constexpr size_t WS_WGLU = 16 * MiB;
constexpr size_t WS_WPS = 17 * MiB;
constexpr size_t WS_WPA = 18 * MiB;
constexpr size_t WS_WOUT = 19 * MiB;
constexpr size_t WS_WGU = 21 * MiB;
constexpr size_t WS_WDN = 37 * MiB;
constexpr size_t WS_MOUT = 46 * MiB;
constexpr size_t WS_A = 50 * MiB;
constexpr size_t WS_XN = 210 * MiB;
constexpr size_t WS_LISTS = WS_A;
constexpr size_t WS_TG = WS_A + 16 * MiB;
constexpr size_t WS_ELOC = WS_A + 40 * MiB;
constexpr size_t WS_ATT = WS_A;
constexpr size_t WS_OS = WS_A + 32 * MiB;
constexpr size_t WS_B = 114 * MiB;
constexpr size_t WS_QH = WS_B, WS_KH = WS_B + 32 * MiB, WS_VT = WS_B + 64 * MiB;
constexpr size_t WS_MG = WS_B;
constexpr size_t WS_ACT = WS_B;
constexpr size_t WS_ELTOK = WS_B + 64 * MiB;
constexpr size_t WS_ELDST = WS_B + 68 * MiB;
constexpr size_t WS_ELW = WS_B + 72 * MiB;
constexpr size_t WS_ELR2 = WS_B + 76 * MiB;
constexpr size_t WS_PLTOK = WS_B + 80 * MiB;
constexpr size_t WS_C = 210 * MiB;
constexpr size_t WS_TMP = WS_C + 64 * MiB;
constexpr size_t WS_X1B = WS_C;
constexpr size_t WS_X1L = WS_C + 64 * MiB;
constexpr size_t WS_UGS = 338 * MiB;
constexpr size_t WS_Z = 380 * MiB;
constexpr size_t WS_PML = 412 * MiB;
constexpr size_t WS_KPART = 412 * MiB;
constexpr size_t WS_END = 420 * MiB;
constexpr int CW_LCNT = 1024;
constexpr int CW_ECNT = 4096;
constexpr int CW_PCNT = 4224;
constexpr int CW_AQ = 2048;

constexpr int RING_BYTES = 131072;
constexpr int MISC_OFF = RING_BYTES;
constexpr int LDS_BYTES = 147456;

__device__ __forceinline__ unsigned pk2(float lo, float hi) { f32x2 v = {lo, hi}; bf16x2_t b = __builtin_convertvector(v, bf16x2_t); return __builtin_bit_cast(unsigned, b); }
__device__ __forceinline__ bf16_t f2bf(float f) { return (bf16_t)(pk2(f, 0.f) & 0xffffu); }
__device__ __forceinline__ float bflo(unsigned w) { return __uint_as_float(w << 16); }
__device__ __forceinline__ float bfhi(unsigned w) { return __uint_as_float(w & 0xffff0000u); }
__device__ __forceinline__ float bf2f(bf16_t b) { return __uint_as_float(((unsigned)b) << 16); }
__device__ __forceinline__ u32x4 pk8(f32x4 a, f32x4 b) { u32x4 w; w.x = pk2(a[0], a[1]); w.y = pk2(a[2], a[3]); w.z = pk2(b[0], b[1]); w.w = pk2(b[2], b[3]); return w; }
__device__ __forceinline__ void unpk8(u32x4 w, f32x4& a, f32x4& b) { a = (f32x4){bflo(w.x), bfhi(w.x), bflo(w.y), bfhi(w.y)}; b = (f32x4){bflo(w.z), bfhi(w.z), bflo(w.w), bfhi(w.w)}; }
__device__ __forceinline__ float sigmoidf_(float x) { return __builtin_amdgcn_rcpf(1.0f + __expf(-x)); }
__device__ __forceinline__ float gelu_tanh(float x) { const float u = 0.7978845608028654f * (x + 0.044715f * x * x * x); const float e = __expf(-2.0f * u); return x * __builtin_amdgcn_rcpf(1.0f + e); }
__device__ __forceinline__ int lane_id() { unsigned z = 0u; asm volatile("" : "+v"(z)); return __builtin_amdgcn_mbcnt_hi(~0u, __builtin_amdgcn_mbcnt_lo(~0u, z)); }
__device__ __forceinline__ float shx(float v, int mask, int lane) { return __uint_as_float(__builtin_amdgcn_ds_bpermute((lane ^ mask) << 2, __float_as_uint(v))); }
__device__ __forceinline__ int shup(int v, int o, int lane) { return __builtin_amdgcn_ds_bpermute((lane - o) << 2, v); }
__device__ __forceinline__ int fresh_tid(int wave) { int t = wave * 64 + lane_id(); asm volatile("" : "+v"(t)); return t; }
__device__ __forceinline__ float wave_sum(float v) {
    const int lane = lane_id();
#pragma unroll
    for (int o = 1; o < 64; o <<= 1) v += shx(v, o, lane);
    return v;
}

namespace gk {
constexpr int BM = 256, BK = 64, HALF = 128, HTB = HALF * BK * 2, STAGE_BYTES = 8 * HTB;
__device__ __forceinline__ int lds_byte(int r, int c) { const int st = (r >> 4) * 2 + (c >> 5), rr = r & 15, cc = c & 31, ob = rr * 64 + cc * 2; return st * 1024 + (ob ^ (((ob >> 9) & 1) << 5)); }
__device__ __forceinline__ void stage_rc(int b, int& R, int& C) { const int st = b / 1024, sb = b % 1024, swz = sb ^ (((sb >> 9) & 1) << 5); R = (st >> 1) * 16 + swz / 64; C = (st & 1) * 32 + (swz % 64) / 2; }
__device__ __forceinline__ int perm32(int rho) { const int n = rho >> 4, i = rho & 15; return 8 * (i >> 2) + 4 * n + (i & 3); }

struct Unit {
    int pm, pn;
    long aoff, boff;
    int nt;
    int nvalid;
    const int* rows;
    int bsplit; long bjump;
    int aux0, aux1;
    int lda, ldb;
};

template <class F> __device__ __forceinline__ void epi_rows(const f32x4 (&acc)[2][2][4][2], int wr, int wc, int fr, int fq, const F& f) {
#pragma unroll
    for (int ai = 0; ai < 2; ++ai)
#pragma unroll
        for (int m = 0; m < 4; ++m) {
            const int rl = ai * HALF + wr * 64 + m * 16 + fr;
#pragma unroll
            for (int bj = 0; bj < 2; ++bj) f(rl, bj * HALF + wc * 32 + 8 * fq, acc[ai][bj][m][0], acc[ai][bj][m][1]);
        }
}

template <class L, class FL, class FC> __device__ __forceinline__ void epi_rows2(const f32x4 (&acc)[2][2][4][2], int wr, int wc, int fr, int fq, const FL& fl, const FC& fc) {
#pragma unroll
    for (int ai = 0; ai < 2; ++ai) {
        L pre[4][2];
#pragma unroll
        for (int m = 0; m < 4; ++m)
#pragma unroll
            for (int bj = 0; bj < 2; ++bj) pre[m][bj] = fl(ai * HALF + wr * 64 + m * 16 + fr, bj * HALF + wc * 32 + 8 * fq);
#pragma unroll
        for (int m = 0; m < 4; ++m)
#pragma unroll
            for (int bj = 0; bj < 2; ++bj) fc(ai * HALF + wr * 64 + m * 16 + fr, bj * HALF + wc * 32 + 8 * fq, acc[ai][bj][m][0], acc[ai][bj][m][1], pre[m][bj]);
    }
}

#ifndef PROBE_PID
#define PROBE_PID -1
#endif
template <class Epi, class Sched, bool GATHER, bool BSPLIT, bool VARLD = false, int PID = 0>
__device__ __forceinline__ void gemm_phase(LAS unsigned char* lds, const int tid, const bf16_t* A, int lda, const bf16_t* Bt, int ldb, const Sched& S, const Epi& E) {
    const int wid = __builtin_amdgcn_readfirstlane(tid >> 6), lane = tid & 63, wr = wid >> 2, wc = wid & 3, fr = lane & 15, fq = lane >> 4;
    int Rr[2], Cc[2];
    unsigned voffA[2][2], voffB[2][2], voffN[2][2], voffBn[2][2];
#pragma unroll
    for (int i = 0; i < 2; ++i) {
        stage_rc(tid * 16 + i * 8192, Rr[i], Cc[i]);
        const int Rb = (Rr[i] & ~31) + perm32(Rr[i] & 31);
#pragma unroll
        for (int h = 0; h < 2; ++h) {
            voffA[h][i] = (unsigned)((h * HALF + Rr[i]) * lda + Cc[i]) * 2u;
            voffB[h][i] = (unsigned)((h * HALF + Rb) * ldb + Cc[i]) * 2u;
            voffN[h][i] = voffA[h][i]; voffBn[h][i] = voffB[h][i];
        }
    }
    constexpr size_t kstep = (size_t)(BK * 2);
    const unsigned ldsw = (unsigned)wid * 1024u;
    const int aoff = lds_byte(wr * 64 + fr, fq * 8), boff = lds_byte(wc * 32 + fr, fq * 8);
#define GK_SA(b, h) (((b) * 2 + (h)) * HTB)
#define GK_SB(b, h) ((4 + (b) * 2 + (h)) * HTB)
#define GK_STAGE(bufoff, gbase, voff) do { _Pragma("unroll") for (int _i = 0; _i < 2; ++_i) \
        __builtin_amdgcn_global_load_lds((const unsigned*)((const char*)(gbase) + (voff)[_i]), (LAS unsigned*)(lds + (bufoff) + ldsw + _i * 8192), 16, 0, 0); } while (0)
#define GK_LDA(dst, b, h) do { _Pragma("unroll") for (int m = 0; m < 4; ++m) _Pragma("unroll") for (int k = 0; k < 2; ++k) dst[m][k] = *(const LAS bf16x8*)(lds + GK_SA(b, h) + aoff + m * 2048 + k * 1024); } while (0)
#define GK_LDB(dst, b, h) do { _Pragma("unroll") for (int n = 0; n < 2; ++n) _Pragma("unroll") for (int k = 0; k < 2; ++k) dst[n][k] = *(const LAS bf16x8*)(lds + GK_SB(b, h) + boff + n * 2048 + k * 1024); } while (0)
#define GK_MMA(ai, bj, At, Bt_) do { __builtin_amdgcn_s_setprio(1); _Pragma("unroll") for (int m = 0; m < 4; ++m) _Pragma("unroll") for (int n = 0; n < 2; ++n) _Pragma("unroll") for (int k = 0; k < 2; ++k) \
        acc[ai][bj][m][n] = __builtin_amdgcn_mfma_f32_16x16x32_bf16(Bt_[n][k], At[m][k], acc[ai][bj][m][n], 0, 0, 0); __builtin_amdgcn_s_setprio(0); } while (0)
#define GK_WAIT_V(n) asm volatile("s_waitcnt vmcnt(" #n ")" ::: "memory")
#define GK_WAIT_L(n) asm volatile("s_waitcnt lgkmcnt(" #n ")" ::: "memory")
#define GK_BAR __builtin_amdgcn_s_barrier()
#define GK_SCHED __builtin_amdgcn_sched_barrier(0)
#define GK_GATHER(u, vo) do { if constexpr (GATHER) { _Pragma("unroll") for (int _h = 0; _h < 2; ++_h) _Pragma("unroll") for (int _i = 0; _i < 2; ++_i) { \
        const int _r = _h * HALF + Rr[_i]; const int _t = (_r < (u).nvalid) ? (u).rows[_r] : 0; vo[_h][_i] = (unsigned)(_t * lda + Cc[_i]) * 2u; } } } while (0)
#define GK_VARLD(u, vA, vB) do { if constexpr (VARLD) { _Pragma("unroll") for (int _h = 0; _h < 2; ++_h) _Pragma("unroll") for (int _i = 0; _i < 2; ++_i) { \
        const int _rb = (Rr[_i] & ~31) + perm32(Rr[_i] & 31); vA[_h][_i] = (unsigned)((_h * HALF + Rr[_i]) * (u).lda + Cc[_i]) * 2u; vB[_h][_i] = (unsigned)((_h * HALF + _rb) * (u).ldb + Cc[_i]) * 2u; } } } while (0)
#define GK_BP(u, base, t) ((base) + (size_t)(t) * kstep + ((BSPLIT && (t) >= (u).bsplit) ? (u).bjump : 0l))
    Unit cur, nxt; int ui = 0;
    if (!S.next(0, cur)) return;
    f32x4 acc[2][2][4][2];
#pragma unroll
    for (int a = 0; a < 2; ++a)
#pragma unroll
        for (int b = 0; b < 2; ++b)
#pragma unroll
            for (int m = 0; m < 4; ++m)
#pragma unroll
                for (int n = 0; n < 2; ++n) acc[a][b][m][n] = (f32x4){0.f, 0.f, 0.f, 0.f};
    bf16x8 At[4][2], B0[2][2], B1[2][2];
    const char* cA = (const char*)A + cur.aoff; const char* cB = (const char*)Bt + cur.boff;
    GK_GATHER(cur, voffA); GK_VARLD(cur, voffA, voffB);
    GK_STAGE(GK_SB(0, 0), GK_BP(cur, cB, 0), voffB[0]); GK_STAGE(GK_SB(0, 1), GK_BP(cur, cB, 0), voffB[1]); GK_STAGE(GK_SA(0, 0), cA, voffA[0]); GK_STAGE(GK_SA(0, 1), cA, voffA[1]);
    if (wr == 1) GK_BAR;
    GK_WAIT_V(2); GK_BAR;
    GK_STAGE(GK_SB(1, 0), GK_BP(cur, cB, 1), voffB[0]); GK_STAGE(GK_SA(1, 0), cA + kstep, voffA[0]); GK_STAGE(GK_SB(1, 1), GK_BP(cur, cB, 1), voffB[1]);
    GK_WAIT_V(6); GK_BAR;
    for (;;) {
        const bool has_next = S.next(ui + 1, nxt);
        if (!has_next) nxt = cur;
        const char* nA = has_next ? (const char*)A + nxt.aoff : cA; const char* nB = has_next ? (const char*)Bt + nxt.boff : cB;
        if constexpr (GATHER) { if (has_next) { GK_GATHER(nxt, voffN); } else {
#pragma unroll
            for (int h = 0; h < 2; ++h)
#pragma unroll
                for (int i = 0; i < 2; ++i) voffN[h][i] = voffA[h][i]; } }
        const int nt = cur.nt;
        for (int t = 0; t < nt; t += 2) {
            const bool last = (t == nt - 2);
            const char* a1 = cA + (size_t)(t + 1) * kstep;
            const char* a2 = last ? nA : cA + (size_t)(t + 2) * kstep; const char* a3 = a2 + kstep;
            const char* b2 = last ? GK_BP(nxt, nB, 0) : GK_BP(cur, cB, t + 2);
            const char* b3 = last ? GK_BP(nxt, nB, 1) : GK_BP(cur, cB, t + 3);
            unsigned vA2[2][2], vB2[2][2];
#pragma unroll
            for (int h = 0; h < 2; ++h)
#pragma unroll
                for (int i = 0; i < 2; ++i) { vA2[h][i] = (GATHER && last) ? voffN[h][i] : voffA[h][i]; vB2[h][i] = voffB[h][i]; }
            if constexpr (VARLD) { if (last) { GK_VARLD(nxt, vA2, vB2); } }
            GK_LDB(B0, 0, 0); GK_LDB(B1, 0, 1); GK_SCHED; GK_LDA(At, 0, 0); GK_STAGE(GK_SA(1, 1), a1, voffA[1]);
            GK_WAIT_V(8); GK_WAIT_L(0); GK_BAR; GK_MMA(0, 0, At, B0); GK_MMA(0, 1, At, B1); GK_BAR; GK_SCHED;
            GK_LDA(At, 0, 1); GK_STAGE(GK_SB(0, 0), b2, vB2[0]); GK_STAGE(GK_SB(0, 1), b2, vB2[1]); GK_STAGE(GK_SA(0, 0), a2, vA2[0]);
            GK_WAIT_V(8); GK_WAIT_L(0); GK_BAR; GK_MMA(1, 0, At, B0); GK_MMA(1, 1, At, B1); GK_BAR; GK_SCHED;
            GK_LDB(B0, 1, 0); GK_LDB(B1, 1, 1); GK_SCHED; GK_LDA(At, 1, 0); GK_STAGE(GK_SA(0, 1), a2, vA2[1]);
            GK_WAIT_V(8); GK_WAIT_L(0); GK_BAR; GK_MMA(0, 0, At, B0); GK_MMA(0, 1, At, B1); GK_BAR; GK_SCHED;
            GK_LDA(At, 1, 1); GK_STAGE(GK_SB(1, 0), b3, vB2[0]); GK_STAGE(GK_SB(1, 1), b3, vB2[1]); GK_STAGE(GK_SA(1, 0), a3, vA2[0]);
            GK_WAIT_V(8); GK_WAIT_L(0); GK_BAR; GK_MMA(1, 0, At, B0); GK_MMA(1, 1, At, B1); GK_BAR; GK_SCHED;
        }
        if (wr == 0) GK_BAR;
#ifdef PROBE_A
        unsigned long long te0_ = 0; if (PID == PROBE_PID) te0_ = __builtin_amdgcn_s_memrealtime();
#endif
        E(acc, cur, wr, wc, fr, fq);
#ifdef PROBE_A
        if (PID == PROBE_PID) { const unsigned long long te1_ = __builtin_amdgcn_s_memrealtime(); asm volatile("s_waitcnt vmcnt(0)" ::: "memory"); if (blockIdx.x == PROBE_BLK && tid == PROBE_TID) { LAS unsigned long long* t_ = (LAS unsigned long long*)(lds + MISC_OFF + 12288); t_[37] += te1_ - te0_; t_[39] += __builtin_amdgcn_s_memrealtime() - te1_; t_[38] += 100; } }
#endif
        if (!has_next) break;
#pragma unroll
        for (int a = 0; a < 2; ++a)
#pragma unroll
            for (int b = 0; b < 2; ++b)
#pragma unroll
                for (int m = 0; m < 4; ++m)
#pragma unroll
                    for (int n = 0; n < 2; ++n) acc[a][b][m][n] = (f32x4){0.f, 0.f, 0.f, 0.f};
        cur = nxt; cA = nA; cB = nB; ++ui;
        if constexpr (GATHER || VARLD) {
#pragma unroll
            for (int h = 0; h < 2; ++h)
#pragma unroll
                for (int i = 0; i < 2; ++i) { if constexpr (GATHER) voffA[h][i] = voffN[h][i]; } }
        if constexpr (VARLD) { GK_VARLD(cur, voffA, voffB); }
        if (wr == 1) GK_BAR;
    }
    GK_WAIT_V(0);
    GK_BAR;
#undef GK_SA
#undef GK_SB
#undef GK_STAGE
#undef GK_LDA
#undef GK_LDB
#undef GK_MMA
#undef GK_WAIT_V
#undef GK_WAIT_L
#undef GK_BAR
#undef GK_SCHED
#undef GK_GATHER
#undef GK_VARLD
#undef GK_BP
}

struct GridOrder {
    int nM, nN, nwg, G, c, nt; long astep, bstep;
    __device__ void init(int nM_, int nN_, int K, int lda, int ldb, int G_, int c_) { nM = nM_; nN = nN_; nwg = nM * nN; G = G_; c = c_; nt = K / BK; astep = (long)BM * lda * 2; bstep = (long)BM * ldb * 2; }
    __device__ bool next(int i, Unit& u) const {
        const long L = (long)i * G + c; if (L >= nwg) return false;
        int wgid = (int)L; { const int q = nwg / 8, r = nwg % 8, xcd = wgid % 8, off = wgid / 8; wgid = (xcd < r ? xcd * (q + 1) : r * (q + 1) + (xcd - r) * q) + off; }
        const int WGM = 8, nig = WGM * nN, gid = wgid / nig, fm = gid * WGM, gsz = (nM - fm) < WGM ? (nM - fm) : WGM;
        u.pm = fm + ((wgid % nig) % gsz); u.pn = (wgid % nig) / gsz;
        u.aoff = u.pm * astep; u.boff = u.pn * bstep; u.nt = nt; u.nvalid = 256; u.rows = nullptr; u.bsplit = 1 << 30; u.bjump = 0; u.aux0 = 0; u.aux1 = 0; u.lda = 0; u.ldb = 0;
        return true;
    }
};
}

struct Params { const float* in[26]; float* out; unsigned char* ws; };
enum { I_X = 0, I_N1G, I_WIN, I_LAMRE, I_LAMIM, I_LOGDT, I_BRE, I_BIM, I_CRE, I_CIM, I_SSMD, I_WGLU, I_BGLU, I_QG, I_KG, I_WPS, I_WPA, I_WOUT, I_N2G, I_WRG, I_BRG, I_WRE, I_BREX, I_WGATE, I_WUP, I_WDOWN };

using gk::Unit; using gk::epi_rows; using gk::epi_rows2;
struct Pre1 { u32x4 a; }; struct Pre2 { u32x4 a, b; }; struct PreF2 { f32x4 a, b; };
typedef f32x4 Acc[2][2][4][2];

struct EpiProj {
    bf16_t *UGS, *QH, *KH, *VT; const float *QG, *KG, *ROPE; float* KMEAN; LAS float* misc;
    __device__ __forceinline__ void operator()(const Acc& acc, const Unit& u, int wr, int wc, int fr_, int fq_) const {
        int fr = fr_, fq = fq_; asm volatile("" : "+v"(fr), "+v"(fq));
        if (u.aux0) {
            const int tok0 = u.pn * 256, b = tok0 >> 13, blk = (tok0 & 8191) >> 8;
            epi_rows(acc, wr, wc, fr, fq, [&](int rl, int cl, f32x4 v0, f32x4 v1) {
                const int dim = u.pm * 256 + rl, h = dim >> 6, d = dim & 63;
                *(u32x4*)(VT + ((size_t)((b * NH + h) * NBLK + blk) * HD + d) * 256 + cl) = pk8(v0, v1);
            });
            return;
        }
        const int pn = u.pn, row0 = u.pm * 256;
        if (pn < 2) {
            epi_rows(acc, wr, wc, fr, fq, [&](int rl, int cl, f32x4 v0, f32x4 v1) {
                const int row = row0 + rl, col = pn * 256 + cl, b = row >> 13, s = row & 8191;
                const int g = col >> 4, ch0 = col & 15, chunk = s >> 5, t = s & 31;
                *(u32x4*)(UGS + ((size_t)(g * CROWS + b * NCH + chunk) * KU + 128 + t * 16 + ch0)) = pk8(v0, v1);
            });
            return;
        }
        const int which = (pn - 2) >> 1, hd0 = ((pn - 2) & 1) * 4, lane = fq * 16 + fr, bidx = row0 >> 13, blk = (row0 & 8191) >> 8;
        const int dbase = 32 * (wc & 1) + 8 * fq;
        const float* gain = which ? KG : QG;
        const f32x4 g0 = *(const f32x4*)(gain + dbase), g1 = *(const f32x4*)(gain + dbase + 4);
        LAS float* sq = misc;
        LAS float* kss = misc + 2048;
        float ps[2][4][2];
#pragma unroll
        for (int ai = 0; ai < 2; ++ai)
#pragma unroll
            for (int m = 0; m < 4; ++m)
#pragma unroll
                for (int bj = 0; bj < 2; ++bj) {
                    const f32x4 v0 = acc[ai][bj][m][0], v1 = acc[ai][bj][m][1];
                    float p = (v0.x * v0.x + v0.y * v0.y) + (v0.z * v0.z + v0.w * v0.w) + (v1.x * v1.x + v1.y * v1.y) + (v1.z * v1.z + v1.w * v1.w);
                    p += shx(p, 16, lane); p += shx(p, 32, lane);
                    ps[ai][m][bj] = p;
                    if (fq == 0) sq[(wc * 256 + ai * 128 + wr * 64 + m * 16 + fr) * 2 + bj] = p;
                }
        asm volatile("s_waitcnt lgkmcnt(0)" ::: "memory"); __builtin_amdgcn_s_barrier(); asm volatile("" ::: "memory");
#pragma unroll
        for (int ai = 0; ai < 2; ++ai)
#pragma unroll
            for (int m = 0; m < 4; ++m)
#pragma unroll
                for (int bj = 0; bj < 2; ++bj) { const float tot = ps[ai][m][bj] + sq[((wc ^ 1) * 256 + ai * 128 + wr * 64 + m * 16 + fr) * 2 + bj]; ps[ai][m][bj] = __builtin_amdgcn_rsqf(tot * (1.f / HD) + EPS); }
        f32x4 ks[2][2];
#pragma unroll
        for (int bj = 0; bj < 2; ++bj) { ks[bj][0] = (f32x4){0.f, 0.f, 0.f, 0.f}; ks[bj][1] = (f32x4){0.f, 0.f, 0.f, 0.f}; }
        const bool ropew = (wc & 1) == 0;
        bf16_t* outb = QH + (size_t)which * (16u << 20);
        f32x4 rc[4];
        auto ld_rope = [&](int gi) {
            const int s_ = blk * 256 + (gi >> 2) * 128 + wr * 64 + (gi & 3) * 16 + fr;
            rc[0] = (f32x4){1.f, 1.f, 1.f, 1.f}; rc[1] = rc[0]; rc[2] = (f32x4){0.f, 0.f, 0.f, 0.f}; rc[3] = rc[2];
            if (ropew && fq < 2) { const f32x4* rt = (const f32x4*)(ROPE + (size_t)s_ * 16); rc[0] = rt[0]; rc[1] = rt[1]; rc[2] = rt[2]; rc[3] = rt[3]; }
        };
        ld_rope(0);
#pragma unroll
        for (int gi = 0; gi < 8; ++gi) {
            const int ai = gi >> 2, m = gi & 3;
            const int rl = ai * 128 + wr * 64 + m * 16 + fr, s = blk * 256 + rl;
            f32x4 c0 = rc[0], c1 = rc[1], s0 = rc[2], s1 = rc[3];
            if (fq == 0) { s0 = -s0; s1 = -s1; }
            u32x4 o[2];
#pragma unroll
            for (int bj = 0; bj < 2; ++bj) {
                const float rs = ps[ai][m][bj];
                f32x4 a = acc[ai][bj][m][0] * rs * g0, b = acc[ai][bj][m][1] * rs * g1;
                if (ropew) {
                    f32x4 pa, pb;
#pragma unroll
                    for (int j = 0; j < 4; ++j) { pa[j] = shx(a[j], 16, lane); pb[j] = shx(b[j], 16, lane); }
                    a = a * c0 + pa * s0; b = b * c1 + pb * s1;
                }
                if (which) { ks[bj][0] += a; ks[bj][1] += b; o[bj] = pk8(a, b); }
                else o[bj] = pk8(a * QSCALE, b * QSCALE);
            }
            asm volatile("" : "+v"(o[0]), "+v"(o[1]));
            if (gi + 1 < 8) ld_rope(gi + 1);
#pragma unroll
            for (int bj = 0; bj < 2; ++bj) *(u32x4*)(outb + ((size_t)((bidx * NH + hd0 + 2 * bj + (wc >> 1)) * SEQ + s) * HD + dbase)) = o[bj];
        }
        if (which) {
#pragma unroll
            for (int bj = 0; bj < 2; ++bj)
#pragma unroll
                for (int n = 0; n < 2; ++n)
#pragma unroll
                    for (int j = 0; j < 4; ++j) { float v = ks[bj][n][j]; v += shx(v, 1, lane); v += shx(v, 2, lane); v += shx(v, 4, lane); v += shx(v, 8, lane);
                        if (fr == 0) kss[wr * 256 + bj * 128 + wc * 32 + 8 * fq + 4 * n + j] = v; }
            asm volatile("s_waitcnt lgkmcnt(0)" ::: "memory"); __builtin_amdgcn_s_barrier(); asm volatile("" ::: "memory");
            const int t = (wr * 4 + wc) * 64 + lane;
            if (t < 256) KMEAN[((size_t)((bidx * NH + hd0 + (t >> 6)) * NBLK + blk)) * HD + (t & 63)] = (kss[t] + kss[256 + t]) * (1.f / 256.f);
        }
    }
};
struct ProjOrder {
    gk::GridOrder g;
    __device__ bool next(int i, Unit& u) const {
        if (!g.next(i, u)) return false;
        if (u.pn < 6) { u.aoff += (long)WS_XN; u.boff += (long)WS_WIN; return true; }
        const int vm = u.pn - 6, vn = u.pm;
        u.pm = vm; u.pn = vn; u.aoff = (long)WS_WIN + (long)(1536 + vm * 256) * DM * 2; u.boff = (long)WS_XN + (long)vn * 256 * DM * 2; u.aux0 = 1;
        return true;
    }
};
struct EpiEloc {
    float* ELOC;
    __device__ __forceinline__ void operator()(const Acc& acc, const Unit& u, int wr, int wc, int fr, int fq) const {
        const int rowbase = u.aux0 * CROWS + u.pm * 256;
        epi_rows(acc, wr, wc, fr, fq, [&](int rl, int cl, f32x4 v0, f32x4 v1) {
            if (cl < 128) { float* d = ELOC + (size_t)(rowbase + rl) * 128 + cl; *(f32x4*)d = v0; *(f32x4*)(d + 4) = v1; }
        });
    }
};
struct EpiSsm {
    bf16_t* Z;
    __device__ __forceinline__ void operator()(const Acc& acc, const Unit& u, int wr, int wc, int fr, int fq) const {
        const int g = u.aux0, r0 = u.pm * 256, c0 = u.pn * 256;
        epi_rows(acc, wr, wc, fr, fq, [&](int rl, int cl, f32x4 v0, f32x4 v1) {
            const int col = c0 + cl, t = col >> 4, ch0 = col & 15; const size_t tok = (size_t)(r0 + rl) * CL + t;
            f32x4 a, bb;
#pragma unroll
            for (int j = 0; j < 4; ++j) { a[j] = gelu_tanh(v0[j]); bb[j] = gelu_tanh(v1[j]); }
            *(u32x4*)(Z + tok * SSMW + g * GC + ch0) = pk8(a, bb);
        });
    }
};
struct EpiGlu {
    const bf16_t* Z; const float* bias; bf16_t* OS;
    __device__ __forceinline__ void operator()(const Acc& acc, const Unit& u, int wr, int wc, int fr, int fq) const {
        const int r0 = u.pm * 256, c0 = u.pn * 256;
        f32x4 bs[2][2];
#pragma unroll
        for (int bj = 0; bj < 2; ++bj) { const float* bp = bias + c0 + bj * 128 + wc * 32 + 8 * fq; bs[bj][0] = *(const f32x4*)bp; bs[bj][1] = *(const f32x4*)(bp + 4); }
        epi_rows2<Pre1>(acc, wr, wc, fr, fq,
            [&](int rl, int cl) { Pre1 p; p.a = *(const u32x4*)(Z + (size_t)(r0 + rl) * SSMW + c0 + cl); return p; },
            [&](int rl, int cl, f32x4 v0, f32x4 v1, const Pre1& p) {
                f32x4 z0, z1; unpk8(p.a, z0, z1);
                const f32x4 b0 = bs[cl >> 7][0], b1 = bs[cl >> 7][1];
                f32x4 a, bb;
#pragma unroll
                for (int j = 0; j < 4; ++j) { a[j] = z0[j] * sigmoidf_(v0[j] + b0[j]); bb[j] = z1[j] * sigmoidf_(v1[j] + b1[j]); }
                *(u32x4*)(OS + (size_t)(r0 + rl) * SSMW + c0 + cl) = pk8(a, bb);
            });
    }
};
struct EpiMerge {
    bf16_t* MG; bf16_t* TMP;
    __device__ __forceinline__ void operator()(const Acc& acc, const Unit& u, int wr, int wc, int fr_, int fq_) const {
        int fr = fr_, fq = fq_; asm volatile("" : "+v"(fr), "+v"(fq));
        const int r0 = u.pm * 256, c0 = u.pn * 256, ps = u.aux0;
        const bool sg = ((ps & 1) == 0) == (u.aux1 == 0);
        if ((ps & 1) == 0) {
            bf16_t* D = ps ? TMP : MG;
            epi_rows(acc, wr, wc, fr, fq, [&](int rl, int cl, f32x4 v0, f32x4 v1) {
                f32x4 a = v0, bb = v1;
                if (sg) {
#pragma unroll
                    for (int j = 0; j < 4; ++j) { a[j] = sigmoidf_(v0[j]); bb[j] = sigmoidf_(v1[j]); } }
                *(u32x4*)(D + (size_t)(r0 + rl) * DM + c0 + cl) = pk8(a, bb);
            });
        } else if (ps == 1) {
            epi_rows2<Pre1>(acc, wr, wc, fr, fq,
                [&](int rl, int cl) { Pre1 p; p.a = *(const u32x4*)(MG + (size_t)(r0 + rl) * DM + c0 + cl); return p; },
                [&](int rl, int cl, f32x4 v0, f32x4 v1, const Pre1& p) { f32x4 m0, m1; unpk8(p.a, m0, m1); f32x4 a = v0, bb = v1;
                    if (sg) {
#pragma unroll
                        for (int j = 0; j < 4; ++j) { a[j] = sigmoidf_(v0[j]); bb[j] = sigmoidf_(v1[j]); } }
                    *(u32x4*)(MG + (size_t)(r0 + rl) * DM + c0 + cl) = pk8(m0 * a, m1 * bb); });
        } else {
            epi_rows2<Pre2>(acc, wr, wc, fr, fq,
                [&](int rl, int cl) { Pre2 p; const size_t off = (size_t)(r0 + rl) * DM + c0 + cl; p.a = *(const u32x4*)(MG + off); p.b = *(const u32x4*)(TMP + off); return p; },
                [&](int rl, int cl, f32x4 v0, f32x4 v1, const Pre2& p) { f32x4 m0, m1, t0, t1; unpk8(p.a, m0, m1); unpk8(p.b, t0, t1); f32x4 a = v0, bb = v1;
                    if (sg) {
#pragma unroll
                        for (int j = 0; j < 4; ++j) { a[j] = sigmoidf_(v0[j]); bb[j] = sigmoidf_(v1[j]); } }
                    *(u32x4*)(MG + (size_t)(r0 + rl) * DM + c0 + cl) = pk8(m0 + t0 * a, m1 + t1 * bb); });
        }
    }
};
struct MergeOrder {
    gk::GridOrder g; int order;
    __device__ bool next(int i, Unit& u) const {
        if (!g.next(i >> 2, u)) return false;
        const int ps = i & 3, br = ps >> 1; u.aux0 = ps; u.aux1 = order;
        const bool gate = ((ps & 1) == 0) == (order == 0);
        if (gate) { u.aoff = (long)WS_XN + (long)u.pm * 256 * DM * 2; u.boff = (long)WS_WIN + (long)(2048 + br * 1024 + u.pn * 256) * DM * 2; u.nt = DM / 64; u.lda = DM; u.ldb = DM; }
        else { u.aoff = (long)(br == 0 ? WS_OS : WS_ATT) + (long)u.pm * 256 * SSMW * 2; u.boff = (long)(br == 0 ? WS_WPS : WS_WPA) + (long)u.pn * 256 * SSMW * 2; u.nt = SSMW / 64; u.lda = SSMW; u.ldb = SSMW; }
        return true;
    }
};
struct EpiOut {
    const float* X; bf16_t* X1H; bf16_t* X1L;
    __device__ __forceinline__ void operator()(const Acc& acc, const Unit& u, int wr, int wc, int fr, int fq) const {
        const int r0 = u.pm * 256, c0 = u.pn * 256;
        epi_rows2<PreF2>(acc, wr, wc, fr, fq,
            [&](int rl, int cl) { PreF2 p; const float* xp = X + (size_t)(r0 + rl) * DM + c0 + cl; p.a = *(const f32x4*)xp; p.b = *(const f32x4*)(xp + 4); return p; },
            [&](int rl, int cl, f32x4 v0, f32x4 v1, const PreF2& p) {
                const size_t off = (size_t)(r0 + rl) * DM + c0 + cl;
                const f32x4 a = p.a + v0, bb = p.b + v1;
                const u32x4 hw = pk8(a, bb); f32x4 h0, h1; unpk8(hw, h0, h1);
                *(u32x4*)(X1H + off) = hw; if (X1L) *(u32x4*)(X1L + off) = pk8(a - h0, bb - h1);
            });
    }
};
struct EpiGU {
    const int* ELDST; const float* ELW; const float* ELR2; bf16_t* ACT; const LAS int* pairoff;
    __device__ __forceinline__ void operator()(const Acc& acc, const Unit& u, int wr, int wc, int fr, int fq) const {
        const int e = u.aux0, tile = u.pm;
        int dst[2][4]; float w[2][4], r2[2][4];
#pragma unroll
        for (int ai = 0; ai < 2; ++ai)
#pragma unroll
            for (int m = 0; m < 4; ++m) {
                const int rl = ai * 128 + wr * 64 + m * 16 + fr; const size_t idx = (size_t)e * T + tile * 256 + (rl < u.nvalid ? rl : 0);
                dst[ai][m] = ELDST[idx]; w[ai][m] = ELW[idx]; r2[ai][m] = ELR2[idx];
            }
#pragma unroll
        for (int ai = 0; ai < 2; ++ai) {
#pragma unroll
            for (int m = 0; m < 4; ++m) {
                const int rl = ai * 128 + wr * 64 + m * 16 + fr;
                if (rl < u.nvalid) {
                    const int p = dst[ai][m] >> 17, slot = (dst[ai][m] >> 16) & 1, rank = dst[ai][m] & 0xffff;
                    const size_t prow = (size_t)(pairoff[p] + rank);
                    f32x4 a[2];
#pragma unroll
                    for (int n = 0; n < 2; ++n)
#pragma unroll
                        for (int j = 0; j < 4; ++j) { const float gt = acc[ai][0][m][n][j] * r2[ai][m], up = acc[ai][1][m][n][j] * r2[ai][m]; a[n][j] = gt * sigmoidf_(gt) * up * w[ai][m]; }
                    *(u32x4*)(ACT + prow * 256 + slot * 128 + wc * 32 + 8 * fq) = pk8(a[0], a[1]);
                }
            }
        }
    }
};
struct EpiDN {
    const int* PLTOK; const bf16_t* X1H; const bf16_t* X1L; float* OUT;
    __device__ __forceinline__ void operator()(const Acc& acc, const Unit& u, int wr, int wc, int fr, int fq) const {
        const int p = u.aux0, tile = u.aux1, c0 = u.pn * 256, nv = u.nvalid;
        int tok[2][4];
#pragma unroll
        for (int ai = 0; ai < 2; ++ai)
#pragma unroll
            for (int m = 0; m < 4; ++m) { const int rl = ai * 128 + wr * 64 + m * 16 + fr; tok[ai][m] = PLTOK[(size_t)p * T + tile * 256 + (rl < nv ? rl : 0)]; }
        u32x4 xh[2][4][2];
#pragma unroll
        for (int ai = 0; ai < 2; ++ai)
#pragma unroll
            for (int m = 0; m < 4; ++m)
#pragma unroll
                for (int bj = 0; bj < 2; ++bj) { const size_t off = (size_t)tok[ai][m] * DM + c0 + bj * 128 + wc * 32 + 8 * fq; xh[ai][m][bj] = *(const u32x4*)(X1H + off); }
#pragma unroll
        for (int ai = 0; ai < 2; ++ai)
#pragma unroll
            for (int m = 0; m < 4; ++m) {
                const int rl = ai * 128 + wr * 64 + m * 16 + fr;
                if (rl < nv) {
#pragma unroll
                    for (int bj = 0; bj < 2; ++bj) {
                        const size_t off = (size_t)tok[ai][m] * DM + c0 + bj * 128 + wc * 32 + 8 * fq;
                        f32x4 h0, h1; unpk8(xh[ai][m][bj], h0, h1);
                        *(f32x4*)(OUT + off) = h0 + acc[ai][bj][m][0]; *(f32x4*)(OUT + off + 4) = h1 + acc[ai][bj][m][1];
                    }
                }
            }
    }
};

struct ElocOrder {
    int G, c;
    __device__ bool next(int i, Unit& u) const {
        const int L = i * G + c; if (L >= NG * 4) return false;
        const int g = L >> 2, pm = L & 3;
        u.pm = pm; u.pn = 0; u.aoff = ((long)(g * CROWS + pm * 256) * KU + 128) * 2; u.boff = (long)g * 128 * NTC * 2; u.nt = NTC / 64;
        u.nvalid = 256; u.rows = nullptr; u.bsplit = 1 << 30; u.bjump = 0; u.aux0 = g; u.aux1 = 0; return true;
    }
};
struct SsmOrder {
    int G, c;
    __device__ bool next(int i, Unit& u) const {
        const int L = i * G + c; if (L >= NG * 8) return false;
        const int g = L >> 3, pm = (L >> 1) & 3, pn = L & 1;
        u.pm = pm; u.pn = pn; u.aoff = (long)(g * CROWS + pm * 256) * KU * 2; u.boff = (long)(g * NTC + pn * 256) * KU * 2; u.nt = pn ? 10 : 6;
        u.nvalid = 256; u.rows = nullptr; u.bsplit = 1 << 30; u.bjump = 0; u.aux0 = g; u.aux1 = 0; return true;
    }
};
struct GUOrder {
    const LAS int* fpre; const LAS int* ecnt; const LAS int* plist; int nfull, npart; const int* ELTOK; int G, c;
    __device__ bool next(int i, Unit& u) const {
        const int L = i * G + c; if (L >= nfull + npart) return false;
        int e, tile;
        if (L < nfull) { const int ln = lane_id(); e = __builtin_popcountll(__builtin_amdgcn_ballot_w64(ln < NE && fpre[ln + 1] <= L)); tile = L - __builtin_amdgcn_readfirstlane(fpre[e]); }
        else { e = __builtin_amdgcn_readfirstlane(plist[L - nfull]); tile = __builtin_amdgcn_readfirstlane(ecnt[e]) >> 8; }
        const int cnt = __builtin_amdgcn_readfirstlane(ecnt[e]);
        u.pm = tile; u.pn = 0; u.aoff = 0; u.boff = (long)e * 256 * DM * 2; u.nt = DM / 64;
        u.nvalid = min(256, cnt - tile * 256); u.rows = ELTOK + (size_t)e * T + tile * 256; u.bsplit = 1 << 30; u.bjump = 0; u.aux0 = e; u.aux1 = 0; u.lda = 0; u.ldb = 0; return true;
    }
};
struct DNOrder {
    const LAS int* fpre; const LAS int* pcnt; const LAS int* pairoff; const LAS int* plist; int nfull, npart, G, c;
    __device__ bool next(int i, Unit& u) const {
        const int L = i * G + c; if (L >= (nfull + npart) * 4) return false;
        const int rt = L >> 2, pn = L & 3; int p, tile;
        if (rt < nfull) { const int ln = lane_id(); p = __builtin_popcountll(__builtin_amdgcn_ballot_w64(fpre[ln + 1] <= rt)) + __builtin_popcountll(__builtin_amdgcn_ballot_w64(ln + 65 <= NPAIR && fpre[ln + 65] <= rt)); tile = rt - __builtin_amdgcn_readfirstlane(fpre[p]); }
        else { p = __builtin_amdgcn_readfirstlane(plist[rt - nfull]); tile = __builtin_amdgcn_readfirstlane(pcnt[p]) >> 8; }
        const int cnt = __builtin_amdgcn_readfirstlane(pcnt[p]), po = __builtin_amdgcn_readfirstlane(pairoff[p]);
        const int g = p / 28; int q = p % 28, lo = 0; while (q >= 7 - lo) { q -= 7 - lo; ++lo; } const int hi = lo + 1 + q;
        u.pm = 0; u.pn = pn; u.aoff = (long)(po + tile * 256) * 256 * 2; u.boff = ((long)pn * 256 * (NE * DE) + (g * 8 + lo) * DE) * 2; u.nt = 4;
        u.nvalid = min(256, cnt - tile * 256); u.rows = nullptr; u.bsplit = 2; u.bjump = (long)(hi - lo) * DE * 2 - 2 * 128; u.aux0 = p; u.aux1 = tile; u.lda = 0; u.ldb = 0; return true;
    }
};

__device__ __forceinline__ void p0_transpose_item(const float* W, int N, const float* kscale, bf16_t* WT, int ldt, LAS float* scr, int item, int lane) {
    const int nblk = N / 32, kb = item / nblk, nb = item % nblk, k0 = 64 * kb, n0 = 32 * nb;
    float v[32];
#pragma unroll
    for (int i = 0; i < 32; ++i) v[i] = W[(size_t)(k0 + 2 * i + (lane >> 5)) * N + n0 + (lane & 31)];
    if (kscale) {
#pragma unroll
        for (int i = 0; i < 32; ++i) v[i] *= kscale[k0 + 2 * i + (lane >> 5)];
    }
#pragma unroll
    for (int i = 0; i < 32; ++i) scr[(2 * i + (lane >> 5)) * 33 + (lane & 31)] = v[i];
    asm volatile("s_waitcnt lgkmcnt(0)" ::: "memory");
    const int c = lane & 7;
#pragma unroll
    for (int j = 0; j < 4; ++j) { const int n = (lane >> 3) + 8 * j; const LAS float* s = scr + (8 * c) * 33 + n;
        u32x4 o; o.x = pk2(s[0 * 33], s[1 * 33]); o.y = pk2(s[2 * 33], s[3 * 33]); o.z = pk2(s[4 * 33], s[5 * 33]); o.w = pk2(s[6 * 33], s[7 * 33]);
        *(u32x4*)(WT + (size_t)(n0 + n) * ldt + k0 + 8 * c) = o; }
    asm volatile("s_waitcnt lgkmcnt(0)" ::: "memory");
}

__device__ __forceinline__ void p0_ssm_tables(const Params& P, LAS unsigned char* lds, int g, int part, int tid) {
    unsigned char* ws = P.ws;
    LAS double* xs = (LAS double*)lds;
    LAS double* ys = xs + 64;
    LAS float* cfr = (LAS float*)(ys + 64);
    LAS float* cfi = cfr + 64;
    LAS f32x2* AP = (LAS f32x2*)(cfi + 64);
    LAS f32x2* BB = AP + 33 * 64;
    LAS f32x2* CC = BB + 64 * 16;
    if (tid < 64) {
        const int n = tid;
        const double dt = exp((double)P.in[I_LOGDT][g]);
        const float lrf = fminf(P.in[I_LAMRE][g * NS + n], -1e-4f);
        const double lr = lrf, li = P.in[I_LAMIM][g * NS + n];
        const double x = lr * dt, y = li * dt, mag = exp(x), ar = mag * cos(y), ai = mag * sin(y);
        const double den = lr * lr + li * li, nr = ar - 1.0, ni = ai;
        xs[n] = x; ys[n] = y; cfr[n] = (float)((nr * lr + ni * li) / den); cfi[n] = (float)((ni * lr - nr * li) / den);
        const double m32 = exp(32.0 * x);
        if (part == 0) ((f32x2*)(ws + WS_A32))[g * NS + n] = (f32x2){(float)(m32 * cos(32.0 * y)), (float)(m32 * sin(32.0 * y))};
    }
    __syncthreads();
#pragma unroll 1
    for (int idx = tid; idx < 33 * 64; idx += 512) { const int tau = idx >> 6, n = idx & 63; const float m = expf((float)xs[n] * (float)tau), a = (float)(ys[n] * tau); float sn, cs; sincosf(a, &sn, &cs); AP[idx] = (f32x2){m * cs, m * sn}; }
#pragma unroll 1
    for (int idx = tid; idx < 1024; idx += 512) {
        { const int n = idx >> 4; const float br = P.in[I_BRE][(size_t)g * 1024 + idx], bi = P.in[I_BIM][(size_t)g * 1024 + idx]; BB[idx] = (f32x2){cfr[n] * br - cfi[n] * bi, cfr[n] * bi + cfi[n] * br}; }
        CC[idx] = (f32x2){P.in[I_CRE][(size_t)g * 1024 + idx], P.in[I_CIM][(size_t)g * 1024 + idx]};
    }
    __syncthreads();
    float* KC = (float*)(ws + WS_KC) + (size_t)g * 32 * 256;
#pragma unroll 1
    for (int idx = part * 1024 + tid; idx < (part + 1) * 1024; idx += 512) {
        const int tau = idx >> 8, c = (idx >> 4) & 15, cp = idx & 15; float s = 0.f;
#pragma unroll 4
        for (int n = 0; n < 64; ++n) { const f32x2 cc = CC[c * 64 + n], ap = AP[tau * 64 + n], bb = BB[n * 16 + cp];
            const float xr = cc.x * ap.x - cc.y * ap.y, xi = cc.x * ap.y + cc.y * ap.x; s += xr * bb.x - xi * bb.y; }
        if (tau == 0 && c == cp) s += P.in[I_SSMD][g * GC + c];
        KC[idx] = s;
    }
    bf16_t* MO = (bf16_t*)(ws + WS_MOUT) + (size_t)g * NTC * 128;
#pragma unroll 1
    for (int idx = part * (NTC * 16) + tid; idx < (part + 1) * (NTC * 16); idx += 512) {
        const int row = idx >> 7, np = idx & 127, n = np & 63, t = row >> 4, c = row & 15;
        const f32x2 cc = CC[c * 64 + n], ap = AP[(t + 1) * 64 + n];
        const float zr = cc.x * ap.x - cc.y * ap.y, zi = cc.x * ap.y + cc.y * ap.x;
        MO[idx] = f2bf(np < 64 ? zr : -zi);
    }
    bf16_t* MIN = (bf16_t*)(ws + WS_MIN) + (size_t)g * 128 * NTC;
#pragma unroll 1
    for (int idx = part * (NTC * 16) + tid; idx < (part + 1) * (NTC * 16); idx += 512) {
        const int np = idx >> 9, k = idx & 511, n = np & 63, s = k >> 4, cp = k & 15;
        const f32x2 ap = AP[(31 - s) * 64 + n], bb = BB[n * 16 + cp];
        const float wr_ = ap.x * bb.x - ap.y * bb.y, wi_ = ap.x * bb.y + ap.y * bb.x;
        MIN[idx] = f2bf(np < 64 ? wr_ : wi_);
    }
    __syncthreads();
}

__device__ __forceinline__ void p0_prep(const Params& P, LAS unsigned char* lds, int G, const int tid) {
    unsigned char* ws = P.ws;
    const int lane = tid & 63, wid = __builtin_amdgcn_readfirstlane(tid >> 6), bid = blockIdx.x;
    for (int u = bid; u < NG * 8; u += G) p0_ssm_tables(P, lds, u >> 3, u & 7, tid);
#ifdef PROBE_A
#define P0STAMP(i) do { if (blockIdx.x == PROBE_BLK && tid == 0) ((LAS unsigned long long*)(lds + MISC_OFF + 12288))[i] = __builtin_amdgcn_s_memrealtime(); } while (0)
#else
#define P0STAMP(i) do { } while (0)
#endif
    P0STAMP(26);
    {
        LAS float* scr = (LAS float*)(lds + wid * 16384);
        const int gw = bid * 8 + wid, NGW = G * 8;
        for (int it = gw; it < 16 * 128; it += NGW) p0_transpose_item(P.in[I_WIN], NIN, nullptr, (bf16_t*)(ws + WS_WIN), DM, scr, it, lane);
    }
    P0STAMP(27);
    {
        bf16_t* HI = (bf16_t*)(ws + WS_WRT); bf16_t* LO = HI + 48 * DM;
        for (int idx = bid * 512 + tid; idx < 48 * DM; idx += G * 512) {
            const int col = idx >> 10, k = idx & 1023;
            float v = 0.f;
            if (col < 4) v = P.in[I_WRG][k * 4 + col]; else if (col < 36) v = P.in[I_WRE][k * 32 + col - 4];
            v *= P.in[I_N2G][k];
            const bf16_t h = f2bf(v); HI[idx] = h; LO[idx] = f2bf(v - bf2f(h));
        }
    }
    {
        const float invf[8] = {1.0f, 0.1939227432012558f, 0.03760603070259094f, 0.007292664609849453f, 0.0014142135623842478f, 0.00027424818836152554f, 5.318296098266728e-05f, 1.0313386155758053e-05f};
        float* RT = (float*)(ws + WS_ROPE);
        for (int idx = bid * 512 + tid; idx < SEQ * 8; idx += G * 512) {
            const int pos = idx >> 3, i = idx & 7; float fr = 1.0f;
#pragma unroll
            for (int k = 0; k < 8; ++k) if (i == k) fr = invf[k];
            const float ang = (float)pos * fr;
            RT[pos * 16 + i] = cosf(ang); RT[pos * 16 + 8 + i] = sinf(ang);
        }
    }
    P0STAMP(28);
}
__device__ __forceinline__ void p0_xn(const Params& P, int G, const int tid) {
    unsigned char* ws = P.ws;
    const int lane = tid & 63, wid = __builtin_amdgcn_readfirstlane(tid >> 6), bid = blockIdx.x;
    {
        const int gw = bid * 8 + wid, NGW = G * 8;
        const f32x4* gp = (const f32x4*)P.in[I_N1G] + lane;
        f32x4 gv[4];
#pragma unroll
        for (int j = 0; j < 4; ++j) gv[j] = gp[64 * j];
        f32x4 r[4][4];
#pragma unroll
        for (int u = 0; u < 3; ++u) { const int mp = (gw + u * NGW < T) ? gw + u * NGW : gw; if (gw < T) { const f32x4* xr = (const f32x4*)(P.in[I_X] + (size_t)mp * DM) + lane;
#pragma unroll
            for (int j = 0; j < 4; ++j) r[u][j] = xr[64 * j]; } }
        for (int m0 = gw; m0 < T; m0 += 4 * NGW) {
#pragma unroll
            for (int u = 0; u < 4; ++u) {
                const int m = m0 + u * NGW;
                if (m < T) {
                    const int mp = (m + 3 * NGW < T) ? m + 3 * NGW : m;
                    { const f32x4* xr = (const f32x4*)(P.in[I_X] + (size_t)mp * DM) + lane;
#pragma unroll
                      for (int j = 0; j < 4; ++j) r[(u + 3) & 3][j] = xr[64 * j]; }
                    float ssum = 0.f;
#pragma unroll
                    for (int j = 0; j < 4; ++j) ssum += (r[u][j].x * r[u][j].x + r[u][j].y * r[u][j].y) + (r[u][j].z * r[u][j].z + r[u][j].w * r[u][j].w);
                    const float rs = __builtin_amdgcn_rsqf(wave_sum(ssum) * (1.f / DM) + EPS);
                    u32x2* o8 = (u32x2*)((bf16_t*)(ws + WS_XN) + (size_t)m * DM) + lane;
#pragma unroll
                    for (int j = 0; j < 4; ++j) { const f32x4 y = r[u][j] * rs * gv[j]; u32x2 w; w.x = pk2(y.x, y.y); w.y = pk2(y.z, y.w); o8[64 * j] = w; }
                }
            }
        }
    }
}


__device__ __forceinline__ void phase0(const Params& P, LAS unsigned char* lds, int G, const int tid) {
    if (blockIdx.x & 1) { p0_xn(P, G, tid); p0_prep(P, lds, G, tid); }
    else { p0_prep(P, lds, G, tid); p0_xn(P, G, tid); }
}

__device__ __forceinline__ void late_transposes(const Params& P, LAS unsigned char* lds, int G, const int tid, int half, int slot, int nslots) {
    unsigned char* ws = P.ws;
    const int lane = tid & 63, wid = __builtin_amdgcn_readfirstlane(tid >> 6), bid = blockIdx.x;
    LAS float* scr = (LAS float*)(lds + wid * 16384);
    const int gw = slot * 8 + wid, NGW = nslots * 8;
    constexpr int I_GLU = 8 * 16, I_P = 8 * 32, I_O = 16 * 32, I_E = 64 * NE;
    constexpr int NIT = I_GLU + 2 * I_P + I_O + 3 * I_E;
    bf16_t* WGU = (bf16_t*)(ws + WS_WGU); bf16_t* WDN = (bf16_t*)(ws + WS_WDN);
    const int lo = half ? NIT / 2 : 0, hi = half ? NIT : NIT / 2;
    for (int it = lo + gw; it < hi; it += NGW) {
        int r = it;
        if (r < I_GLU) { p0_transpose_item(P.in[I_WGLU], SSMW, nullptr, (bf16_t*)(ws + WS_WGLU), SSMW, scr, r, lane); continue; } r -= I_GLU;
        if (r < I_P) { p0_transpose_item(P.in[I_WPS], DM, nullptr, (bf16_t*)(ws + WS_WPS), SSMW, scr, r, lane); continue; } r -= I_P;
        if (r < I_P) { p0_transpose_item(P.in[I_WPA], DM, nullptr, (bf16_t*)(ws + WS_WPA), SSMW, scr, r, lane); continue; } r -= I_P;
        if (r < I_O) { p0_transpose_item(P.in[I_WOUT], DM, nullptr, (bf16_t*)(ws + WS_WOUT), DM, scr, r, lane); continue; } r -= I_O;
        if (r < I_E) { const int e = r >> 6; p0_transpose_item(P.in[I_WGATE] + (size_t)e * DM * DE, DE, P.in[I_N2G], WGU + (size_t)e * 256 * DM, DM, scr, r & 63, lane); continue; } r -= I_E;
        if (r < I_E) { const int e = r >> 6; p0_transpose_item(P.in[I_WUP] + (size_t)e * DM * DE, DE, P.in[I_N2G], WGU + (size_t)(e * 256 + 128) * DM, DM, scr, r & 63, lane); continue; } r -= I_E;
        { const int e = r >> 6; p0_transpose_item(P.in[I_WDOWN] + (size_t)e * DE * DM, DM, nullptr, WDN + e * DE, NE * DE, scr, r & 63, lane); }
    }
    __syncthreads();
}

struct QkvRegs { u32x4 q[4], k[4]; };
__device__ __forceinline__ void qkv_load(const Params& P, int wu, int lane, QkvRegs& R) {
    const int bh = wu >> 8, blk = (wu >> 3) & 31, sub = wu & 7;
    const size_t off = ((size_t)bh * SEQ + blk * 256 + sub * 32 + (lane >> 3)) * HD + (lane & 7) * 8;
    const bf16_t* qp = (const bf16_t*)(P.ws + WS_QH) + off; const bf16_t* kp = (const bf16_t*)(P.ws + WS_KH) + off;
#pragma unroll
    for (int it = 0; it < 4; ++it) { R.q[it] = *(const u32x4*)(qp + it * 8 * HD); R.k[it] = *(const u32x4*)(kp + it * 8 * HD); }
}
__device__ __forceinline__ void qkv_wave_unit(const Params& P, LAS bf16_t* vt, int wu, int lane, const QkvRegs& R, const f32x4 (&gq)[2], const f32x4 (&gk)[2]) {
    unsigned char* ws = P.ws;
    const int bh = wu >> 8, blk = (wu >> 3) & 31, sub = wu & 7, r8 = lane >> 3, c8 = lane & 7;
    const size_t blkoff = ((size_t)bh * SEQ + blk * 256) * HD;
    const size_t off = blkoff + (size_t)(sub * 32 + r8) * HD + c8 * 8;
    bf16_t* qp = (bf16_t*)(ws + WS_QH) + off; bf16_t* kp = (bf16_t*)(ws + WS_KH) + off;
    f32x4 ks0 = {0.f, 0.f, 0.f, 0.f}, ks1 = {0.f, 0.f, 0.f, 0.f};
#pragma unroll
    for (int it = 0; it < 4; ++it) {
        const int pos = blk * 256 + sub * 32 + it * 8 + r8;
        f32x4 c0 = {1.f, 1.f, 1.f, 1.f}, c1 = c0, s0 = {0.f, 0.f, 0.f, 0.f}, s1 = s0;
        if (c8 < 2) { const f32x4* rt = (const f32x4*)((const float*)(ws + WS_ROPE) + (size_t)pos * 16); c0 = rt[0]; c1 = rt[1]; s0 = rt[2]; s1 = rt[3]; if (c8 == 0) { s0 = -s0; s1 = -s1; } }
#pragma unroll
        for (int w = 0; w < 2; ++w) {
            f32x4 a, b; unpk8(w ? R.k[it] : R.q[it], a, b);
            float ss = (a.x * a.x + a.y * a.y) + (a.z * a.z + a.w * a.w) + (b.x * b.x + b.y * b.y) + (b.z * b.z + b.w * b.w);
            ss += shx(ss, 1, lane); ss += shx(ss, 2, lane); ss += shx(ss, 4, lane);
            const float rs = __builtin_amdgcn_rsqf(ss * (1.f / HD) + EPS);
            a = a * rs * (w ? gk[0] : gq[0]); b = b * rs * (w ? gk[1] : gq[1]);
            f32x4 pa, pb;
#pragma unroll
            for (int j = 0; j < 4; ++j) { pa[j] = shx(a[j], 1, lane); pb[j] = shx(b[j], 1, lane); }
            a = a * c0 + pa * s0; b = b * c1 + pb * s1;
            if (w) { ks0 += a; ks1 += b; *(u32x4*)(kp + it * 8 * HD) = pk8(a, b); }
            else *(u32x4*)(qp + it * 8 * HD) = pk8(a * QSCALE, b * QSCALE);
        }
    }
#pragma unroll
    for (int j = 0; j < 4; ++j) { ks0[j] += shx(ks0[j], 8, lane); ks0[j] += shx(ks0[j], 16, lane); ks0[j] += shx(ks0[j], 32, lane); ks1[j] += shx(ks1[j], 8, lane); ks1[j] += shx(ks1[j], 16, lane); ks1[j] += shx(ks1[j], 32, lane); }
    if (lane < 8) { float* kpart = (float*)(ws + WS_KPART) + ((size_t)(bh * NBLK + blk) * 8 + sub) * HD + c8 * 8; *(f32x4*)kpart = ks0; *(f32x4*)(kpart + 4) = ks1; }
}
__device__ __forceinline__ void qkv_phase(const Params& P, LAS unsigned char* lds, int G, const int tid) {
    const int lane = tid & 63, wid = __builtin_amdgcn_readfirstlane(tid >> 6), c8 = lane & 7;
    LAS bf16_t* vt = (LAS bf16_t*)(lds + wid * 8192);
    f32x4 gq[2], gk[2];
    gq[0] = *(const f32x4*)(P.in[I_QG] + c8 * 8); gq[1] = *(const f32x4*)(P.in[I_QG] + c8 * 8 + 4); gk[0] = *(const f32x4*)(P.in[I_KG] + c8 * 8); gk[1] = *(const f32x4*)(P.in[I_KG] + c8 * 8 + 4);
    const int NWU = NBH * NBLK * 8, step = G * 8;
    int wu = blockIdx.x * 8 + wid;
    QkvRegs Ra, Rb;
    if (wu < NWU) qkv_load(P, wu, lane, Ra);
    for (; wu < NWU; wu += 2 * step) {
        if (wu + step < NWU) qkv_load(P, wu + step, lane, Rb);
        qkv_wave_unit(P, vt, wu, lane, Ra, gq, gk);
        if (wu + step < NWU) { if (wu + 2 * step < NWU) qkv_load(P, wu + 2 * step, lane, Ra); qkv_wave_unit(P, vt, wu + step, lane, Rb, gq, gk); }
    }
    __syncthreads();
}

__device__ __forceinline__ void select_phase(const Params& P, LAS unsigned char* lds, int G, const int tid) {
    unsigned char* ws = P.ws;
    LAS int* lc = (LAS int*)lds;
    LAS int* lb = lc + 128;
    const int lane = tid & 63, wid = __builtin_amdgcn_readfirstlane(tid >> 6), q32 = lane & 31, hi = lane >> 5, r = wid * 32 + q32;
    const int NU = NBH * NBLK;
    for (int u0 = blockIdx.x; u0 < NU; u0 += 4 * G) {
        if (tid < 128) lc[tid] = 0;
        bf16x8 qf[4][4];
#pragma unroll
        for (int k = 0; k < 4; ++k) { const int u = u0 + k * G; const int uu = u < NU ? u : u0;
            const bf16_t* qp = (const bf16_t*)(ws + WS_QH) + ((size_t)(uu >> 5) * SEQ + (uu & 31) * 256 + r) * HD + hi * 8;
#pragma unroll
            for (int d0 = 0; d0 < 4; ++d0) qf[k][d0] = *(const bf16x8*)(qp + d0 * 16); }
        f32x4 kmn[4][2];
        { const float* kmp = (const float*)(ws + WS_KMEAN) + ((size_t)(u0 >> 5) * NBLK + q32) * HD + hi * 8;
#pragma unroll
          for (int d0 = 0; d0 < 4; ++d0) { kmn[d0][0] = *(const f32x4*)(kmp + d0 * 16); kmn[d0][1] = *(const f32x4*)(kmp + d0 * 16 + 4); } }
        __syncthreads();
        int sj[4][3], srank[4][3];
#pragma unroll
        for (int k = 0; k < 4; ++k) {
            const int u = u0 + k * G; const bool act = u < NU; const int uu = act ? u : u0, bh = uu >> 5, qb = uu & 31;
            f32x16 sc;
#pragma unroll
            for (int i = 0; i < 16; ++i) sc[i] = 0.f;
            f32x4 km[4][2];
#pragma unroll
            for (int d0 = 0; d0 < 4; ++d0) { km[d0][0] = kmn[d0][0]; km[d0][1] = kmn[d0][1]; }
            if (k + 1 < 4) {
                const int un = u0 + (k + 1) * G; const int uun = un < NU ? un : u0;
                const float* kmp = (const float*)(ws + WS_KMEAN) + ((size_t)(uun >> 5) * NBLK + q32) * HD + hi * 8;
#pragma unroll
                for (int d0 = 0; d0 < 4; ++d0) { kmn[d0][0] = *(const f32x4*)(kmp + d0 * 16); kmn[d0][1] = *(const f32x4*)(kmp + d0 * 16 + 4); }
            }
#pragma unroll
            for (int d0 = 0; d0 < 4; ++d0) {
                const u32x4 hw = pk8(km[d0][0], km[d0][1]); f32x4 h0, h1; unpk8(hw, h0, h1); const u32x4 lw = pk8(km[d0][0] - h0, km[d0][1] - h1);
                sc = __builtin_amdgcn_mfma_f32_32x32x16_bf16(__builtin_bit_cast(bf16x8, hw), qf[k][d0], sc, 0, 0, 0);
                sc = __builtin_amdgcn_mfma_f32_32x32x16_bf16(__builtin_bit_cast(bf16x8, lw), qf[k][d0], sc, 0, 0, 0);
            }
            float b0, b1, b2; int i0, i1, i2;
            {
                float sv[16];
#pragma unroll
                for (int rr = 0; rr < 16; ++rr) { const int j = (rr & 3) + 8 * (rr >> 2) + 4 * hi; sv[rr] = j < qb ? sc[rr] : -INFINITY; }
                float bm[3]; int bi[3];
#pragma unroll
                for (int c = 0; c < 3; ++c) {
                    float m = sv[0];
#pragma unroll
                    for (int rr = 1; rr < 16; ++rr) m = fmaxf(m, sv[rr]);
                    int idx = 1 << 20;
#pragma unroll
                    for (int rr = 15; rr >= 0; --rr) { const int j = (rr & 3) + 8 * (rr >> 2) + 4 * hi; idx = (sv[rr] == m) ? j : idx; }
                    if (c < 2) {
#pragma unroll
                        for (int rr = 0; rr < 16; ++rr) { const int j = (rr & 3) + 8 * (rr >> 2) + 4 * hi; sv[rr] = (j == idx) ? -INFINITY : sv[rr]; }
                    }
                    bm[c] = m; bi[c] = idx;
                }
                b0 = bm[0]; b1 = bm[1]; b2 = bm[2]; i0 = bi[0]; i1 = bi[1]; i2 = bi[2];
            }
            const float pb[3] = {shx(b0, 32, lane), shx(b1, 32, lane), shx(b2, 32, lane)};
            const int pi[3] = {__builtin_amdgcn_ds_bpermute((lane ^ 32) << 2, i0), __builtin_amdgcn_ds_bpermute((lane ^ 32) << 2, i1), __builtin_amdgcn_ds_bpermute((lane ^ 32) << 2, i2)};
#pragma unroll
            for (int c = 0; c < 3; ++c) {
                const float sv = pb[c]; const int j = pi[c];
                if (sv > b0 || (sv == b0 && j < i0)) { b2 = b1; i2 = i1; b1 = b0; i1 = i0; b0 = sv; i0 = j; }
                else if (sv > b1 || (sv == b1 && j < i1)) { b2 = b1; i2 = i1; b1 = sv; i1 = j; }
                else if (sv > b2 || (sv == b2 && j < i2)) { b2 = sv; i2 = j; }
            }
            sj[k][0] = i0; sj[k][1] = i1; sj[k][2] = i2;
            const int nsel = act ? (qb < 3 ? qb : 3) : 0;
#pragma unroll
            for (int c = 0; c < 3; ++c) { srank[k][c] = 0; if (hi == 0 && c < nsel) srank[k][c] = atomicAdd((int*)&lc[k * 32 + sj[k][c]], 1); }
        }
        __syncthreads();
        if (tid < 128) { const int k = tid >> 5, j = tid & 31, u = u0 + k * G; const int n = lc[tid];
            lb[tid] = (u < NU && n > 0) ? atomicAdd((int*)(ws + WS_CTL) + CW_LCNT + (u >> 5) * NBLK + j, n) : 0; }
        __syncthreads();
        if (hi == 0) {
            unsigned short* lists = (unsigned short*)(ws + WS_LISTS);
#pragma unroll
            for (int k = 0; k < 4; ++k) { const int u = u0 + k * G; if (u < NU) { const int bh = u >> 5, qb = u & 31, nsel = qb < 3 ? qb : 3;
#pragma unroll
                for (int c = 0; c < 3; ++c) if (c < nsel) lists[(size_t)(bh * NBLK + sj[k][c]) * SEQ + lb[k * 32 + sj[k][c]] + srank[k][c]] = (unsigned short)((qb * 256 + r) | (c << 13)); } }
        }
        __syncthreads();
    }
}

__device__ __forceinline__ void tg_expand(const Params& P, int G, const int tid, int slot, int nslots) {
    unsigned char* ws = P.ws;
    const float* KC = (const float*)(ws + WS_KC); bf16_t* TG = (bf16_t*)(ws + WS_TG);
    for (int idx = slot * 512 + tid; idx < NG * NTC * CL; idx += nslots * 512) {
        const int s = idx & 31, row = (idx >> 5) & 511, g = idx >> 14, t = row >> 4, c = row & 15;
        u32x4 w0 = {0u, 0u, 0u, 0u}, w1 = {0u, 0u, 0u, 0u};
        if (s <= t) { const f32x4* kp = (const f32x4*)(KC + ((size_t)(g * 32 + (t - s)) * 16 + c) * 16); w0 = pk8(kp[0], kp[1]); w1 = pk8(kp[2], kp[3]); }
        bf16_t* d = TG + ((size_t)(g * NTC + row)) * KU + 128 + s * 16;
        *(u32x4*)d = w0; *(u32x4*)(d + 8) = w1;
        if (s < 16) *(u32x4*)(TG + ((size_t)(g * NTC + row)) * KU + s * 8) = *(const u32x4*)((const bf16_t*)(ws + WS_MOUT) + ((size_t)(g * NTC + row)) * 128 + s * 8);
    }
}

__device__ __forceinline__ void carry_scan(const Params& P, LAS unsigned char* lds, int pair, int tid) {
    unsigned char* ws = P.ws;
    LAS f32x2* tot = (LAS f32x2*)lds;
    const int g = pair >> 2, b = pair & 3, nl = tid & 31, seg = tid >> 5;
    f32x2 a[2]; float er[2][16], ei[2][16];
#pragma unroll
    for (int h = 0; h < 2; ++h) {
        const int n = h * 32 + nl;
        a[h] = ((const f32x2*)(ws + WS_A32))[g * NS + n];
        const float* EL = (const float*)(ws + WS_ELOC) + ((size_t)(g * CROWS + b * NCH + seg * 16)) * 128;
#pragma unroll
        for (int i = 0; i < 16; ++i) { er[h][i] = EL[(size_t)i * 128 + n]; ei[h][i] = EL[(size_t)i * 128 + 64 + n]; }
    }
    float pr[2][16], pi[2][16];
#pragma unroll
    for (int h = 0; h < 2; ++h) {
        float sr = 0.f, si = 0.f;
#pragma unroll
        for (int i = 0; i < 16; ++i) { pr[h][i] = sr; pi[h][i] = si; const float tr = a[h].x * sr - a[h].y * si + er[h][i], ti = a[h].x * si + a[h].y * sr + ei[h][i]; sr = tr; si = ti; }
        tot[h * 512 + seg * 32 + nl] = (f32x2){sr, si};
    }
    __syncthreads();
#pragma unroll
    for (int h = 0; h < 2; ++h) {
        const int n = h * 32 + nl;
        f32x2 a16 = a[h];
#pragma unroll
        for (int k = 0; k < 4; ++k) a16 = (f32x2){a16.x * a16.x - a16.y * a16.y, 2.f * a16.x * a16.y};
        float cr = 0.f, ci = 0.f;
        for (int j = 0; j < seg; ++j) { const f32x2 tj = tot[h * 512 + j * 32 + nl]; const float tr = a16.x * cr - a16.y * ci + tj.x, ti = a16.x * ci + a16.y * cr + tj.y; cr = tr; ci = ti; }
        bf16_t* U = (bf16_t*)(ws + WS_UGS) + ((size_t)(g * CROWS + b * NCH + seg * 16)) * KU;
#pragma unroll
        for (int i = 0; i < 16; ++i) {
            U[(size_t)i * KU + n] = f2bf(cr + pr[h][i]); U[(size_t)i * KU + 64 + n] = f2bf(ci + pi[h][i]);
            const float tr = a[h].x * cr - a[h].y * ci, ti = a[h].x * ci + a[h].y * cr; cr = tr; ci = ti;
        }
    }
    __syncthreads();
}

struct AttnDesc { int bh, j, row0, nrows, diag; };
__device__ __forceinline__ void attn_dma(const Params& P, LAS unsigned char* buf, const AttnDesc& u, int wid, int lane) {
    const size_t blkoff = ((size_t)u.bh * SEQ + u.j * 256) * HD;
    const bf16_t* kg = (const bf16_t*)(P.ws + WS_KH) + blkoff; const bf16_t* vg = (const bf16_t*)(P.ws + WS_VT) + blkoff;
#pragma unroll
    for (int i = 0; i < 4; ++i) {
        const int c = wid * 4 + i;
        { const int rho = c * 8 + (lane >> 3), cc = (lane & 7) ^ ((rho >> 1) & 7), kv = (rho & ~12) | ((rho & 4) << 1) | ((rho & 8) >> 1);
          __builtin_amdgcn_global_load_lds((const unsigned*)(kg + kv * 64 + cc * 8), (LAS unsigned*)(buf + c * 1024), 16, 0, 0); }
        { const int dd = c * 2 + (lane >> 5), c16 = (lane & 31) ^ (dd & 15);
          __builtin_amdgcn_global_load_lds((const unsigned*)(vg + dd * 256 + c16 * 8), (LAS unsigned*)(buf + 32768 + c * 1024), 16, 0, 0); }
    }
}
__device__ __forceinline__ unsigned attn_entry(const Params& P, const AttnDesc& u, int rq) {
    if (u.diag) return (unsigned)(u.j * 256 + rq) | (3u << 13);
    return (rq < u.nrows) ? (unsigned)((const unsigned short*)(P.ws + WS_LISTS))[(size_t)(u.bh * NBLK + u.j) * SEQ + u.row0 + rq] : 0u;
}
__device__ __forceinline__ void attn_qload(const Params& P, bf16x8 (&qf)[4], int bh, unsigned e, int hi) {
    const bf16_t* qp = (const bf16_t*)(P.ws + WS_QH) + ((size_t)bh * SEQ + (e & 0x1fff)) * HD + hi * 8;
#pragma unroll
    for (int d0 = 0; d0 < 4; ++d0) qf[d0] = *(const bf16x8*)(qp + d0 * 16);
}

template <class F> __device__ __forceinline__ void block_prefix_1024(LAS int* pre, LAS int* wt, int tid, const F& val) {
    const int lane = tid & 63, wid = tid >> 6;
    const int a = val(2 * tid), b = val(2 * tid + 1), s = a + b;
    int inc = s;
#pragma unroll
    for (int o = 1; o < 64; o <<= 1) { const int v = shup(inc, o, lane); if (lane >= o) inc += v; }
    if (lane == 63) wt[wid] = inc;
    __syncthreads();
    int woff = 0;
    for (int w = 0; w < wid; ++w) woff += wt[w];
    const int ex = inc - s + woff;
    pre[2 * tid] = ex; pre[2 * tid + 1] = ex + a;
    if (tid == 511) pre[1024] = ex + s;
    __syncthreads();
}

__device__ __forceinline__ bool attn_unit_desc(const Params& P, const LAS int* pre, int total, int nunits, int u, AttnDesc& D) {
    if (u >= nunits) return false;
    if (u < total) {
        int lo = 0, hi = 1023;
        while (lo < hi) { const int mid = (lo + hi + 1) >> 1; if (pre[mid] <= u) lo = mid; else hi = mid - 1; }
        const int L = __builtin_amdgcn_readfirstlane(lo), tile = u - __builtin_amdgcn_readfirstlane(pre[L]);
        const int cnt = __builtin_amdgcn_readfirstlane(pre[1040 + L]);
        D.bh = L >> 5; D.j = L & 31; D.row0 = tile * 256; D.nrows = min(256, cnt - tile * 256); D.diag = 0;
    } else { const int d = u - total; D.bh = d >> 5; D.j = d & 31; D.row0 = 0; D.nrows = 256; D.diag = 1; }
    return true;
}
#define ATT_QK(sacc, kt) do { const int rho_ = (kt) * 32 + r32; const LAS unsigned char* kb_ = buf + rho_ * 128; const int sw_ = (rho_ >> 1) & 7; \
        { const bf16x8 kf_ = *(const LAS bf16x8*)(kb_ + ((hi ^ sw_) << 4)); sacc = __builtin_amdgcn_mfma_f32_32x32x16_bf16(kf_, qf[0], cinit, 0, 0, 0); } \
        _Pragma("unroll") for (int d0 = 1; d0 < 4; ++d0) { const bf16x8 kf_ = *(const LAS bf16x8*)(kb_ + (((d0 * 2 + hi) ^ sw_) << 4)); sacc = __builtin_amdgcn_mfma_f32_32x32x16_bf16(kf_, qf[d0], sacc, 0, 0, 0); } } while (0)
#define ATT_PV(sacc, kt) do { _Pragma("unroll") for (int r = 0; r < 16; ++r) { const float p_ = __builtin_amdgcn_exp2f(sacc[r]); sacc[r] = p_; l += p_; } \
        _Pragma("unroll") for (int s2 = 0; s2 < 2; ++s2) { u32x4 pw_; pw_.x = pk2(sacc[8 * s2 + 0], sacc[8 * s2 + 1]); pw_.y = pk2(sacc[8 * s2 + 2], sacc[8 * s2 + 3]); pw_.z = pk2(sacc[8 * s2 + 4], sacc[8 * s2 + 5]); pw_.w = pk2(sacc[8 * s2 + 6], sacc[8 * s2 + 7]); \
            const bf16x8 pf_ = __builtin_bit_cast(bf16x8, pw_); \
            _Pragma("unroll") for (int dt = 0; dt < 2; ++dt) { const int dd_ = dt * 32 + r32; \
                const bf16x8 vf_ = *(const LAS bf16x8*)(buf + 32768 + dd_ * 512 + ((((kt) * 4 + 2 * s2 + hi) ^ (dd_ & 15)) << 4)); \
                ot[dt] = __builtin_amdgcn_mfma_f32_32x32x16_bf16(vf_, pf_, ot[dt], 0, 0, 0); } } } while (0)
__device__ __forceinline__ void attn_phase(const Params& P, LAS unsigned char* lds, int G, const int tid) {
    unsigned char* ws = P.ws;
    LAS int* pre = (LAS int*)(lds + MISC_OFF);
    LAS int* wt = pre + 1032;
    const int* lcnt = (const int*)(ws + WS_CTL) + CW_LCNT;
    { const int c0 = lcnt[2 * tid], c1 = lcnt[2 * tid + 1]; pre[1040 + 2 * tid] = c0; pre[1040 + 2 * tid + 1] = c1; }
    block_prefix_1024(pre, wt, tid, [&](int i) { return (pre[1040 + i] + 255) >> 8; });
    const int total = __builtin_amdgcn_readfirstlane(pre[1024]), nunits = total + NBH * NBLK;
    const int lane = tid & 63, wid = __builtin_amdgcn_readfirstlane(tid >> 6), r32 = lane & 31, hi = lane >> 5, rq = wid * 32 + r32;
    float gq = fabsf(P.in[I_QG][lane]), gk = fabsf(P.in[I_KG][lane]);
#pragma unroll
    for (int o = 1; o < 64; o <<= 1) { gq = fmaxf(gq, shx(gq, o, lane)); gk = fmaxf(gk, shx(gk, o, lane)); }
    const float negB = -(64.0f * QSCALE * 1.02f) * gq * gk;
    f32x16 cinit;
#pragma unroll
    for (int r = 0; r < 16; ++r) cinit[r] = negB;
    LAS int* dtab = pre + 2080;
    const int vcb = (G % 8 == 0) ? ((int)blockIdx.x % 8) * (G / 8) + (int)blockIdx.x / 8 : (int)blockIdx.x;
    if (tid < 64) {
        const int uu = vcb + tid * G;
        if (uu < nunits) {
            LAS int* e = dtab + tid * 8;
            if (uu < total) {
                int lo = 0, hi2 = 1023;
                while (lo < hi2) { const int mid = (lo + hi2 + 1) >> 1; if (pre[mid] <= uu) lo = mid; else hi2 = mid - 1; }
                const int tile = uu - pre[lo], cnt = pre[1040 + lo];
                e[0] = lo >> 5; e[1] = lo & 31; e[2] = tile * 256; e[3] = min(256, cnt - tile * 256); e[4] = 0;
            } else { const int d = uu - total; e[0] = d >> 5; e[1] = d & 31; e[2] = 0; e[3] = 256; e[4] = 1; }
        }
    }
    const bool dyn = (nunits / G) >= 5;
    const int nstat = dyn ? nunits / G - 2 : ((vcb < nunits) ? (nunits - 1 - vcb) / G + 1 : 0);
    const int T0 = nstat * G, ntail = dyn ? nunits - T0 : 0;
    LAS unsigned* ttab = (LAS unsigned*)(lds + MISC_OFF + 12800);
    LAS int* dq = (LAS int*)(lds + MISC_OFF + 11520);
    int* qctr = (int*)(ws + WS_CTL) + CW_AQ;
    for (int k = tid; k < ntail && k < 880; k += 512) {
        const int uu = T0 + k; unsigned e;
        if (uu < total) {
            int lo = 0, hi2 = 1023;
            while (lo < hi2) { const int mid = (lo + hi2 + 1) >> 1; if (pre[mid] <= uu) lo = mid; else hi2 = mid - 1; }
            const int tile = uu - pre[lo], cnt = pre[1040 + lo];
            e = ((unsigned)lo << 13) | ((unsigned)tile << 8) | (unsigned)(min(256, cnt - tile * 256) - 1);
        } else e = (1u << 23) | ((unsigned)(uu - total) << 13) | 255u;
        ttab[k] = e;
    }
    __syncthreads();
#define ATT_DESC(i, D) ({ bool ok_ = false; const int i_ = (i); \
        if (i_ < nstat) { (D).bh = __builtin_amdgcn_readfirstlane(dtab[i_ * 8]); (D).j = __builtin_amdgcn_readfirstlane(dtab[i_ * 8 + 1]); (D).row0 = __builtin_amdgcn_readfirstlane(dtab[i_ * 8 + 2]); \
            (D).nrows = __builtin_amdgcn_readfirstlane(dtab[i_ * 8 + 3]); (D).diag = __builtin_amdgcn_readfirstlane(dtab[i_ * 8 + 4]); ok_ = true; } \
        else if (dyn) { const int k_ = __builtin_amdgcn_readfirstlane(dq[i_ & 3]); \
            if (k_ >= 0) { const unsigned e_ = (unsigned)__builtin_amdgcn_readfirstlane((int)ttab[k_]); const int L_ = (e_ >> 13) & 1023; \
                (D).diag = (int)(e_ >> 23); (D).bh = L_ >> 5; (D).j = L_ & 31; (D).row0 = (int)((e_ >> 8) & 31) * 256; (D).nrows = (int)(e_ & 255) + 1; ok_ = true; } } \
        ok_; })
    AttnDesc cur, nxt, nn;
    int ui = 0;
    if (!ATT_DESC(0, cur)) return;
    bool has_next = ATT_DESC(1, nxt);
    unsigned ecur = attn_entry(P, cur, rq), enext = has_next ? attn_entry(P, nxt, rq) : 0u;
    attn_dma(P, lds, cur, wid, lane);
    bf16x8 qf[4], qn[4];
    attn_qload(P, qf, cur.bh, ecur, hi);
    asm volatile("s_waitcnt vmcnt(0) lgkmcnt(0)" ::: "memory"); __builtin_amdgcn_s_barrier();
    int b = 0;
    for (;;) {
        LAS unsigned char* buf = lds + b * 65536;
#ifdef PROBE_A
        const unsigned long long tu0_ = __builtin_amdgcn_s_memrealtime();
#endif
        const bool has_nn = has_next && ATT_DESC(ui + 2, nn);
        const bool do_fetch = dyn && (ui + 3 >= nstat);
        int fetched = -1;
        if (do_fetch && tid == 0) fetched = atomicAdd(qctr, 1);
        unsigned enn = 0u;
        if (has_nn) enn = attn_entry(P, nn, rq);
        if (has_next) { attn_dma(P, lds + (b ^ 1) * 65536, nxt, wid, lane); attn_qload(P, qn, nxt.bh, enext, hi); }
        else {
#pragma unroll
            for (int d0 = 0; d0 < 4; ++d0) qn[d0] = qf[d0]; }
        f32x16 ot[2];
#pragma unroll
        for (int r = 0; r < 16; ++r) { ot[0][r] = 0.f; ot[1][r] = 0.f; }
        float l = 0.f;
        if (!cur.diag) {
          if (wid * 32 < cur.nrows) {
            f32x16 sA, sB;
            ATT_QK(sA, 0);
            ATT_QK(sB, 1); ATT_PV(sA, 0);
            ATT_QK(sA, 2); ATT_PV(sB, 1);
            ATT_QK(sB, 3); ATT_PV(sA, 2);
            ATT_QK(sA, 4); ATT_PV(sB, 3);
            ATT_QK(sB, 5); ATT_PV(sA, 4);
            ATT_QK(sA, 6); ATT_PV(sB, 5);
            ATT_QK(sB, 7); ATT_PV(sA, 6);
            ATT_PV(sB, 7);
          }
        } else {
            int qrel = r32 - 8 * hi; asm volatile("" : "+v"(qrel));
#pragma unroll
            for (int kt = 0; kt < 8; ++kt) {
                if (kt <= wid) {
                    f32x16 sA; ATT_QK(sA, kt);
                    if (kt == wid) {
#pragma unroll
                        for (int r = 0; r < 16; ++r) if ((r & 3) + 4 * ((r >> 2) & 1) + 16 * (r >> 3) > qrel) sA[r] = -INFINITY;
                    }
                    ATT_PV(sA, kt);
                }
            }
        }
        l += shx(l, 32, lane);
        if (do_fetch && tid == 0) dq[(ui + 3) & 3] = (fetched < ntail && fetched < 880) ? fetched : -1;
#ifdef PROBE_A
        const unsigned long long tw0_ = __builtin_amdgcn_s_memrealtime();
        if (blockIdx.x == PROBE_BLK && tid == PROBE_TID) { LAS unsigned long long* t_ = (LAS unsigned long long*)(lds + MISC_OFF + 12288); if (cur.diag) { t_[35] += tw0_ - tu0_; t_[36] += 100; } else { t_[33] += tw0_ - tu0_; t_[34] += 100; } }
        asm volatile("s_waitcnt vmcnt(0) lgkmcnt(0)" ::: "memory");
        const unsigned long long tw1_ = __builtin_amdgcn_s_memrealtime();
        __builtin_amdgcn_s_barrier(); asm volatile("" ::: "memory");
        if (blockIdx.x == PROBE_BLK && tid == 0) { LAS unsigned long long* t_ = (LAS unsigned long long*)(lds + MISC_OFF + 12288); t_[30] += tw1_ - tw0_; t_[32] += __builtin_amdgcn_s_memrealtime() - tw1_; }
#else
        asm volatile("s_waitcnt vmcnt(0) lgkmcnt(0)" ::: "memory"); __builtin_amdgcn_s_barrier(); asm volatile("" ::: "memory");
#endif
        if (rq < cur.nrows) {
            const int spos = ecur & 0x1fff, slot = ecur >> 13;
            const size_t prow = ((size_t)((cur.bh >> 3) * SEQ + spos) * NH + (cur.bh & 7)) * 4 + slot;
            if (hi == 0) ((f32x2*)(ws + WS_PML))[prow] = (f32x2){0.f, l};
        }
        {
            const int spos = ecur & 0x1fff, slot = ecur >> 13;
            const unsigned prow = (unsigned)((((cur.bh >> 3) * SEQ + spos) * NH + (cur.bh & 7)) * 4 + slot);
            const float inv = __builtin_amdgcn_rcpf(l);
            LAS unsigned char* patch = buf + wid * 4096;
            LAS unsigned* prw = (LAS unsigned*)(lds + MISC_OFF + 10496) + wid * 32;
            if (hi == 0) prw[r32] = (rq < cur.nrows) ? prow : 0xffffffffu;
#pragma unroll
            for (int dt = 0; dt < 2; ++dt)
#pragma unroll
                for (int g4 = 0; g4 < 4; ++g4) {
                    u32x2 w; w.x = pk2(ot[dt][4 * g4] * inv, ot[dt][4 * g4 + 1] * inv); w.y = pk2(ot[dt][4 * g4 + 2] * inv, ot[dt][4 * g4 + 3] * inv);
                    *(LAS u32x2*)(patch + r32 * 128 + (((4 * dt + g4) ^ (r32 & 7)) << 4) + 8 * hi) = w;
                }
            asm volatile("s_waitcnt lgkmcnt(0)" ::: "memory"); __builtin_amdgcn_wave_barrier();
#pragma unroll
            for (int it = 0; it < 4; ++it) {
                const int row = it * 8 + (lane >> 3), pc = lane & 7;
                const unsigned pr = prw[row];
                const u32x4 v = *(const LAS u32x4*)(patch + row * 128 + (pc << 4));
                if (pr != 0xffffffffu) *(u32x4*)((bf16_t*)P.out + (size_t)pr * HD + ((pc ^ (row & 7)) << 3)) = v;
            }
            asm volatile("s_waitcnt lgkmcnt(0)" ::: "memory");
        }
        if (!has_next) break;
        cur = nxt; nxt = nn; has_next = has_nn; ++ui; b ^= 1; ecur = enext; enext = enn;
#pragma unroll
        for (int d0 = 0; d0 < 4; ++d0) qf[d0] = qn[d0];
    }
    asm volatile("s_waitcnt vmcnt(0)" ::: "memory");
    __syncthreads();
}
#undef ATT_QK
#undef ATT_PV
#undef ATT_DESC

__device__ __forceinline__ void combine_phase(const Params& P, int G, const int tid) {
    unsigned char* ws = P.ws;
    const f32x2* PML = (const f32x2*)(ws + WS_PML); const bf16_t* PO = (const bf16_t*)P.out; bf16_t* ATT = (bf16_t*)(ws + WS_ATT);
    constexpr int NIT = T * NH * 4;
    for (int idx0 = blockIdx.x * 512 + tid; idx0 < NIT; idx0 += 2 * G * 512) {
        float ll[2][4]; u32x4 pw[2][4][2];
#pragma unroll
        for (int t = 0; t < 2; ++t) {
            const int idx = idx0 + t * G * 512; const bool in = idx < NIT; const int ii = in ? idx : idx0;
            const int qd = ii & 3, th = ii >> 2, token = th >> 3, qblk = (token & (SEQ - 1)) >> 8, nv = qblk < 3 ? qblk : 3;
#pragma unroll
            for (int sl = 0; sl < 4; ++sl) {
                const bool v = (sl < nv) || (sl == 3);
                ll[t][sl] = v ? PML[(size_t)th * 4 + sl].y : 0.f;
                const u32x4* pp = (const u32x4*)(PO + ((size_t)th * 4 + (v ? sl : 3)) * HD + qd * 16);
                pw[t][sl][0] = pp[0]; pw[t][sl][1] = pp[1];
            }
        }
#pragma unroll
        for (int t = 0; t < 2; ++t) {
            const int idx = idx0 + t * G * 512; if (idx >= NIT) break;
            const int qd = idx & 3, th = idx >> 2, token = th >> 3, head = th & 7;
            float o[16];
#pragma unroll
            for (int i = 0; i < 16; ++i) o[i] = 0.f;
            float W = 0.f;
#pragma unroll
            for (int sl = 0; sl < 4; ++sl) {
                const float w = ll[t][sl]; W += w;
                f32x4 a, b, c, d; unpk8(pw[t][sl][0], a, b); unpk8(pw[t][sl][1], c, d);
#pragma unroll
                for (int i = 0; i < 4; ++i) { o[i] += w * a[i]; o[4 + i] += w * b[i]; o[8 + i] += w * c[i]; o[12 + i] += w * d[i]; }
            }
            const float inv = __builtin_amdgcn_rcpf(W);
            u32x4 w0, w1;
            w0.x = pk2(o[0] * inv, o[1] * inv); w0.y = pk2(o[2] * inv, o[3] * inv); w0.z = pk2(o[4] * inv, o[5] * inv); w0.w = pk2(o[6] * inv, o[7] * inv);
            w1.x = pk2(o[8] * inv, o[9] * inv); w1.y = pk2(o[10] * inv, o[11] * inv); w1.z = pk2(o[12] * inv, o[13] * inv); w1.w = pk2(o[14] * inv, o[15] * inv);
            u32x4* dp = (u32x4*)(ATT + (size_t)token * SSMW + head * HD + qd * 16);
            dp[0] = w0; dp[1] = w1;
        }
    }
}

__device__ __forceinline__ void route_phase(const Params& P, LAS unsigned char* lds, int G, const int tid) {
    unsigned char* ws = P.ws;
    const int lane = tid & 63, wid = __builtin_amdgcn_readfirstlane(tid >> 6), rr = lane & 15, kq = lane >> 4;
    LAS float* lg = (LAS float*)(lds + 65536 + wid * 3200);
    LAS int* he = (LAS int*)(lds + MISC_OFF);
    LAS int* hp = he + 32;
    LAS int* be = hp + 112;
    LAS int* bp = be + 32;
    LAS float* rbias = (LAS float*)(bp + 112);
    int* gcnt = (int*)(ws + WS_CTL);
    const bf16_t* WHL = (const bf16_t*)(ws + WS_WRT);
    const bf16_t* X1H = (const bf16_t*)(ws + WS_X1B); const bf16_t* X1L = (const bf16_t*)(ws + WS_X1L);
    constexpr int WROW = 136;
    constexpr int NSTG = 8, STG_BYTES = 96 * WROW * 2;
    for (int base = 0; base < T / 16; base += G * 8) {
        const int tile = base + blockIdx.x * 8 + wid; const bool active = tile < T / 16;
        if (tid < 144) he[tid] = 0;
        if (tid >= 192 && tid < 228) { const int i = tid - 192; rbias[i] = (i < 4) ? P.in[I_BRG][i] : P.in[I_BREX][i - 4]; }
        const size_t arow = (size_t)((active ? tile : 0) * 16 + rr) * DM + kq * 8;
        u32x4 wreg[2][3]; bf16x8 xs[3][4];
#define RT_WLOAD(dst, q_) do { _Pragma("unroll") for (int i = 0; i < 3; ++i) { const int pc = tid + 512 * i, row = pc >> 4, ch = pc & 15; dst[i] = *(const u32x4*)(WHL + (size_t)row * DM + (q_) * 128 + ch * 8); } } while (0)
#define RT_WSTORE(src_, b_) do { _Pragma("unroll") for (int i = 0; i < 3; ++i) { const int pc = tid + 512 * i, row = pc >> 4, ch = pc & 15; *(LAS u32x4*)(lds + (b_) * STG_BYTES + (row * WROW + ch * 8) * 2) = src_[i]; } } while (0)
#define RT_XLOAD(dst, q_) do { _Pragma("unroll") for (int k = 0; k < 4; ++k) dst[k] = *(const bf16x8*)(X1H + arow + (q_) * 128 + k * 32); } while (0)
        RT_WLOAD(wreg[0], 0); RT_XLOAD(xs[0], 0); RT_WLOAD(wreg[1], 1); RT_XLOAD(xs[1], 1);
        f32x4 acc[3]; float ssq = 0.f;
#pragma unroll
        for (int ct = 0; ct < 3; ++ct) acc[ct] = (f32x4){0.f, 0.f, 0.f, 0.f};
        RT_WSTORE(wreg[0], 0);
        __syncthreads();
#pragma unroll
        for (int q = 0; q < NSTG; ++q) {
            LAS unsigned char* wb = lds + (q & 1) * STG_BYTES;
            if (q + 2 < NSTG) { RT_WLOAD(wreg[q & 1], q + 2); RT_XLOAD(xs[(q + 2) % 3], q + 2); }
#pragma unroll
            for (int k = 0; k < 4; ++k) {
                const bf16x8 ahk = xs[q % 3][k];
                { const u32x4 hw = __builtin_bit_cast(u32x4, ahk); f32x4 x0, x1; unpk8(hw, x0, x1);
                  ssq += (x0.x * x0.x + x0.y * x0.y) + (x0.z * x0.z + x0.w * x0.w) + (x1.x * x1.x + x1.y * x1.y) + (x1.z * x1.z + x1.w * x1.w); }
#pragma unroll
                for (int ct = 0; ct < 3; ++ct) {
                    const LAS unsigned char* bpw = wb + ((ct * 16 + rr) * WROW + k * 32 + kq * 8) * 2;
                    const bf16x8 bh = *(const LAS bf16x8*)bpw, bl = *(const LAS bf16x8*)(bpw + 48 * WROW * 2);
                    acc[ct] = __builtin_amdgcn_mfma_f32_16x16x32_bf16(ahk, bh, acc[ct], 0, 0, 0);
                    acc[ct] = __builtin_amdgcn_mfma_f32_16x16x32_bf16(ahk, bl, acc[ct], 0, 0, 0);
                }
            }
            if (q + 1 < NSTG) RT_WSTORE(wreg[(q + 1) & 1], (q + 1) & 1);
            __syncthreads();
        }
#undef RT_WLOAD
#undef RT_WSTORE
#undef RT_XLOAD
        int E0 = 0, E1 = 0, pp = 0, sl0 = 0, re0 = 0, re1 = 0, rp = 0; float w0 = 0.f, w1 = 0.f, r2 = 0.f;
        if (active) {
            ssq += shx(ssq, 16, lane); ssq += shx(ssq, 32, lane);
#pragma unroll
            for (int ct = 0; ct < 3; ++ct)
#pragma unroll
                for (int rg = 0; rg < 4; ++rg) lg[(kq * 4 + rg) * 49 + ct * 16 + rr] = acc[ct][rg];
            asm volatile("s_waitcnt lgkmcnt(0)" ::: "memory"); __builtin_amdgcn_wave_barrier();
            if (lane < 16) {
                r2 = __builtin_amdgcn_rsqf(ssq * (1.f / DM) + EPS);
                const LAS float* row = lg + lane * 49;
                float gl[4]; int gi = 0; float gmax = -INFINITY;
#pragma unroll
                for (int c = 0; c < 4; ++c) { gl[c] = row[c] * r2 + rbias[c]; if (gl[c] > gmax) { gmax = gl[c]; gi = c; } }
                float den = 0.f;
#pragma unroll
                for (int c = 0; c < 4; ++c) den += __expf(gl[c] - gmax);
                const float gp = __builtin_amdgcn_rcpf(den);
                float ev[8];
#pragma unroll
                for (int e = 0; e < 8; ++e) ev[e] = row[4 + gi * 8 + e] * r2 + rbias[4 + gi * 8 + e];
                int i0 = 0; float v0 = -INFINITY;
#pragma unroll
                for (int e = 0; e < 8; ++e) if (ev[e] > v0) { v0 = ev[e]; i0 = e; }
                int i1 = 0; float v1 = -INFINITY;
#pragma unroll
                for (int e = 0; e < 8; ++e) if (e != i0 && ev[e] > v1) { v1 = ev[e]; i1 = e; }
                const float tt = __expf(v1 - v0);
                w0 = gp * __builtin_amdgcn_rcpf(1.0f + tt); w1 = w0 * tt;
                const int lo = i0 < i1 ? i0 : i1, hh = i0 < i1 ? i1 : i0;
                pp = gi * 28 + (lo * (15 - lo)) / 2 + (hh - lo - 1);
                sl0 = (i0 == lo) ? 0 : 1;
                E0 = gi * 8 + i0; E1 = gi * 8 + i1;
                re0 = atomicAdd((int*)&he[E0], 1); re1 = atomicAdd((int*)&he[E1], 1); rp = atomicAdd((int*)&hp[pp], 1);
            }
        }
        __syncthreads();
        if (tid < 144) { const int h = he[tid]; be[tid] = h ? atomicAdd(gcnt + (tid < 32 ? CW_ECNT + tid : CW_PCNT + tid - 32), h) : 0; }
        __syncthreads();
        if (active && lane < 16) {
            const int token = tile * 16 + lane;
            const int rankp = bp[pp] + rp;
            const size_t i0x = (size_t)E0 * T + be[E0] + re0, i1x = (size_t)E1 * T + be[E1] + re1;
            ((int*)(ws + WS_ELTOK))[i0x] = token; ((int*)(ws + WS_ELDST))[i0x] = (pp << 17) | (sl0 << 16) | rankp; ((float*)(ws + WS_ELW))[i0x] = w0; ((float*)(ws + WS_ELR2))[i0x] = r2;
            ((int*)(ws + WS_ELTOK))[i1x] = token; ((int*)(ws + WS_ELDST))[i1x] = (pp << 17) | ((1 - sl0) << 16) | rankp; ((float*)(ws + WS_ELW))[i1x] = w1; ((float*)(ws + WS_ELR2))[i1x] = r2;
            ((int*)(ws + WS_PLTOK))[(size_t)pp * T + rankp] = token;
        }
        __syncthreads();
    }
}

struct MoeTables { LAS int *ecnt, *efpre, *eplist, *pcnt, *pfpre, *pplist, *pairoff; int enfull, enpart, pnfull, pnpart; };
__device__ __forceinline__ MoeTables moe_tables(const Params& P, LAS unsigned char* lds, int tid) {
    MoeTables M;
    M.ecnt = (LAS int*)(lds + MISC_OFF); M.efpre = M.ecnt + 32; M.eplist = M.efpre + 40; M.pcnt = M.eplist + 32; M.pfpre = M.pcnt + 112; M.pplist = M.pfpre + 120; M.pairoff = M.pplist + 112;
    LAS int* hdr = M.pairoff + 120;
    const int* gcnt = (const int*)(P.ws + WS_CTL);
    const int lane = tid & 63, wv = tid >> 6;
    if (wv == 0) {
        const int cnt = (lane < NE) ? gcnt[CW_ECNT + lane] : 0;
        if (lane < NE) M.ecnt[lane] = cnt;
        const int f = cnt >> 8, q = (cnt & 255) ? 1 : 0, mine = f | (q << 16);
        int inc = mine;
#pragma unroll
        for (int o = 1; o < 64; o <<= 1) { const int v = shup(inc, o, lane); if (lane >= o) inc += v; }
        const int ex = inc - mine;
        if (lane < NE) { M.efpre[lane] = ex & 0xffff; if (q) M.eplist[ex >> 16] = lane; }
        if (lane == 63) { M.efpre[NE] = inc & 0xffff; hdr[0] = inc & 0xffff; hdr[1] = inc >> 16; }
    } else if (wv == 1) {
        const int p0 = 2 * lane, p1 = p0 + 1; const bool ok = p0 < NPAIR;
        const int c0 = ok ? gcnt[CW_PCNT + p0] : 0, c1 = ok ? gcnt[CW_PCNT + p1] : 0;
        if (ok) { M.pcnt[p0] = c0; M.pcnt[p1] = c1; }
        const int f0 = c0 >> 8, f1 = c1 >> 8, t0 = (c0 + 255) >> 8, t1 = (c1 + 255) >> 8, q0 = (c0 & 255) ? 1 : 0, q1 = (c1 & 255) ? 1 : 0;
        const int mine = (f0 + f1) | ((q0 + q1) << 10) | ((t0 + t1) << 20);
        int inc = mine;
#pragma unroll
        for (int o = 1; o < 64; o <<= 1) { const int v = shup(inc, o, lane); if (lane >= o) inc += v; }
        const int ex = inc - mine, exF = ex & 1023, exQ = (ex >> 10) & 1023, exT = ex >> 20;
        if (ok) { M.pfpre[p0] = exF; M.pfpre[p1] = exF + f0; M.pairoff[p0] = exT * 256; M.pairoff[p1] = (exT + t0) * 256; if (q0) M.pplist[exQ] = p0; if (q1) M.pplist[exQ + q0] = p1; }
        if (lane == 63) { M.pfpre[NPAIR] = inc & 1023; M.pairoff[NPAIR] = (inc >> 20) * 256; hdr[2] = inc & 1023; hdr[3] = (inc >> 10) & 1023; }
    }
    __syncthreads();
    M.enfull = __builtin_amdgcn_readfirstlane(hdr[0]); M.enpart = __builtin_amdgcn_readfirstlane(hdr[1]); M.pnfull = __builtin_amdgcn_readfirstlane(hdr[2]); M.pnpart = __builtin_amdgcn_readfirstlane(hdr[3]);
    return M;
}

constexpr int CW_BAR = 8192;
#define XB_TMO      128
#define XB_XCNT(j)  (256  + 64 * (j))
#define XB_XSUB(j)  (1280 + 64 * (j))
#define XB_XGEN(j)  (2304 + 64 * (j))
#define XB_TOP      3328
#define XB_TOPGEN   3392
#define XCD_BAR_WORDS 3456
#define XB_SPIN_CAP (1u << 18)
__device__ __forceinline__ unsigned xb_ld(unsigned* p)              { return __hip_atomic_load(p, __ATOMIC_RELAXED, __HIP_MEMORY_SCOPE_AGENT); }
__device__ __forceinline__ unsigned xb_add(unsigned* p, unsigned v) { return __hip_atomic_fetch_add(p, v, __ATOMIC_RELAXED, __HIP_MEMORY_SCOPE_AGENT); }
__device__ __forceinline__ unsigned xb_xcc_id() { return (unsigned)__builtin_amdgcn_s_getreg((3 << 11) | 20) & 0xFu; }
#define XB_SPIN(cond, bar) do { unsigned _sp = 0; while (cond) { __builtin_amdgcn_s_sleep(1); \
    if ((++_sp & 255u) == 0u) { if (xb_ld(&(bar)[XB_TMO])) break; if (_sp > XB_SPIN_CAP) { atomicAdd(&(bar)[XB_TMO], 1u); break; } } } } while (0)
struct XcdBarrier { unsigned* bar; unsigned x; volatile LAS unsigned* st; };
__device__ __forceinline__ XcdBarrier xcd_barrier_post(unsigned* bar, volatile LAS unsigned* st) {
    XcdBarrier b; b.bar = bar; b.x = xb_xcc_id(); b.st = st;
    if (threadIdx.x == 0) (void)xb_add(&bar[XB_XCNT(b.x)], 1u);
    return b;
}
__device__ __forceinline__ void xcd_barrier_complete(unsigned* bar, unsigned x, unsigned& nloc, unsigned& nx) {
    const unsigned G = gridDim.x * gridDim.y * gridDim.z;
    unsigned sum, cnt, mine, sp = 0u;
    for (;;) {
        sum = 0u; cnt = 0u; mine = 0u;
#pragma unroll
        for (unsigned j = 0; j < 16; ++j) { const unsigned c = xb_ld(&bar[XB_XCNT(j)]); sum += c; cnt += (c > 0u) ? 1u : 0u; mine = (j == x) ? c : mine; }
        if (sum == G) break;
        __builtin_amdgcn_s_sleep(1);
        if ((++sp & 255u) == 0u) { if (xb_ld(&bar[XB_TMO])) break; if (sp > XB_SPIN_CAP) { atomicAdd(&bar[XB_TMO], 1u); break; } }
    }
    nloc = mine > 0u ? mine : 1u; nx = cnt > 0u ? cnt : 1u;
}
__device__ __forceinline__ void xcd_barrier(const XcdBarrier& b, const int tid) {
    asm volatile("s_waitcnt vmcnt(0)" ::: "memory");
    __syncthreads();
    if (tid == 0) {
        unsigned* bar = b.bar;
        __builtin_amdgcn_s_waitcnt(0);
        unsigned nloc = b.st[0], nx = b.st[1];
        if (nloc == 0u) { xcd_barrier_complete(bar, b.x, nloc, nx); b.st[0] = nloc; b.st[1] = nx; }
        const unsigned old = xb_add(&bar[XB_XSUB(b.x)], 1u);
        const unsigned gen = old / nloc;
        if (old + 1u == (gen + 1u) * nloc) {
            __builtin_amdgcn_fence(__ATOMIC_RELEASE, "agent");
            asm volatile("s_waitcnt vmcnt(0)" ::: "memory");
            const unsigned og = xb_add(&bar[XB_TOP], 1u);
            const unsigned tg = og / nx;
            if (og + 1u == (tg + 1u) * nx) xb_add(&bar[XB_TOPGEN], 1u);
            else XB_SPIN(xb_ld(&bar[XB_TOPGEN]) == tg, bar);
            __builtin_amdgcn_fence(__ATOMIC_ACQUIRE, "agent");
            xb_add(&bar[XB_XGEN(b.x)], 1u);
            asm volatile("s_waitcnt vmcnt(0)" ::: "memory");
        } else {
            XB_SPIN(xb_ld(&bar[XB_XGEN(b.x)]) == gen, bar);
            __builtin_amdgcn_fence(__ATOMIC_ACQUIRE, "agent");
            asm volatile("s_waitcnt vmcnt(0)" ::: "memory");
        }
    }
    __syncthreads();
}

#ifndef N_PHASES
#define N_PHASES 11
#endif
__global__ void __launch_bounds__(512, 2) hybrid_fwd(Params P) {
    extern __shared__ __attribute__((aligned(16))) unsigned char lds_raw[];
    LAS unsigned char* lds = (LAS unsigned char*)lds_raw;
    const int G = gridDim.x, c = blockIdx.x, wave = __builtin_amdgcn_readfirstlane(threadIdx.x >> 6);
#define FT fresh_tid(wave)
    const int vc = (G % 8 == 0) ? (c % 8) * (G / 8) + c / 8 : c;
    volatile LAS unsigned* bst = (volatile LAS unsigned*)(lds + LDS_BYTES - 16);
    if (threadIdx.x == 0) { bst[0] = 0u; bst[1] = 0u; }
    __syncthreads();
    const XcdBarrier bar = xcd_barrier_post((unsigned*)(P.ws + WS_CTL) + CW_BAR, bst);
#define GRID_SYNC() xcd_barrier(bar, FT)
#ifndef PROBE_TID
#define PROBE_TID 0
#endif
#ifdef PROBE_A
    LAS unsigned long long* tsl = (LAS unsigned long long*)(lds + MISC_OFF + 12288);
#define STAMP(i) do { if (blockIdx.x == PROBE_BLK && threadIdx.x == 0) tsl[i] = __builtin_amdgcn_s_memrealtime(); } while (0)
#else
#define STAMP(i) do { } while (0)
#endif
    STAMP(0);
#ifdef PROBE_A
    if (blockIdx.x == PROBE_BLK && threadIdx.x == 0) { for (int i_ = 30; i_ < 40; ++i_) tsl[i_] = 0; }
#endif
    unsigned char* ws = P.ws;
#define BF(off) ((bf16_t*)(ws + (off)))
    phase0(P, lds, G, FT);
    GRID_SYNC();
    STAMP(1);
    { ProjOrder S; S.g.init(T / 256, 8, DM, DM, DM, G, c);
      EpiProj E{BF(WS_UGS), BF(WS_QH), BF(WS_KH), BF(WS_VT), P.in[I_QG], P.in[I_KG], (const float*)(ws + WS_ROPE), (float*)(ws + WS_KMEAN), (LAS float*)(lds + MISC_OFF)};
      gk::gemm_phase<EpiProj, ProjOrder, false, false, false, 1>(lds, FT, (const bf16_t*)ws, DM, (const bf16_t*)ws, DM, S, E); }
    GRID_SYNC();
    STAMP(2);
    select_phase(P, lds, G, FT);
    STAMP(22);
    STAMP(23);
    {
        const int nel = NG * 4, nslots = (G > nel) ? nel + 2 * (G - nel) : G;
        const int s0 = (G > nel && vc >= nel) ? nel + 2 * (vc - nel) : vc, ns = (G > nel && vc >= nel) ? 2 : 1;
        for (int k = 0; k < ns; ++k) tg_expand(P, G, FT, s0 + k, nslots);
        STAMP(24);
        if (G > nel) { if (vc >= nel) { late_transposes(P, lds, G, FT, 0, vc - nel, G - nel); late_transposes(P, lds, G, FT, 1, vc - nel, G - nel); } }
        else { late_transposes(P, lds, G, FT, 0, vc, G); late_transposes(P, lds, G, FT, 1, vc, G); }
    }
    STAMP(47);
    { ElocOrder S{G, vc}; EpiEloc E{(float*)(ws + WS_ELOC)};
      gk::gemm_phase<EpiEloc, ElocOrder, false, false, false, 2>(lds, FT, BF(WS_UGS), KU, BF(WS_MIN), NTC, S, E); }
    GRID_SYNC();
    STAMP(3);
    STAMP(4);
    for (int L = vc; L < NG * 8; L += G) { const int g = L >> 3, bb = (L >> 1) & 3; carry_scan(P, lds, g * 4 + bb, FT); }
    asm volatile("s_waitcnt vmcnt(0)" ::: "memory"); __syncthreads();
    { SsmOrder S{G, vc}; EpiSsm E{BF(WS_Z)};
      gk::gemm_phase<EpiSsm, SsmOrder, false, false, false, 4>(lds, FT, BF(WS_UGS), KU, BF(WS_TG), KU, S, E); }
    STAMP(20);
    attn_phase(P, lds, G, FT);
    STAMP(21);
    GRID_SYNC();
    STAMP(5);
    if (c & 1) combine_phase(P, G, FT);
    STAMP(25);
    { gk::GridOrder S; S.init(T / 256, SSMW / 256, SSMW, SSMW, SSMW, G, c);
      EpiGlu E{BF(WS_Z), P.in[I_BGLU], BF(WS_OS)};
      gk::gemm_phase<EpiGlu, gk::GridOrder, false, false, false, 5>(lds, FT, BF(WS_Z), SSMW, BF(WS_WGLU), SSMW, S, E); }
    if (!(c & 1)) combine_phase(P, G, FT);
    GRID_SYNC();
    STAMP(6);
    { MergeOrder S; S.g.init(T / 256, DM / 256, DM, DM, DM, G, c); S.order = (c >> 3) & 1;
      EpiMerge E{BF(WS_MG), BF(WS_TMP)};
      gk::gemm_phase<EpiMerge, MergeOrder, false, false, true, 6>(lds, FT, (const bf16_t*)ws, DM, (const bf16_t*)ws, DM, S, E); }
    GRID_SYNC();
    STAMP(7);
    { gk::GridOrder S; S.init(T / 256, DM / 256, DM, DM, DM, G, c);
      EpiOut E{P.in[I_X], BF(WS_X1B), nullptr};
      gk::gemm_phase<EpiOut, gk::GridOrder, false, false, false, 7>(lds, FT, BF(WS_MG), DM, BF(WS_WOUT), DM, S, E); }
    GRID_SYNC();
    STAMP(8);
    route_phase(P, lds, G, FT);
    GRID_SYNC();
    STAMP(9);
    MoeTables M = moe_tables(P, lds, FT);
    { GUOrder S{M.efpre, M.ecnt, M.eplist, M.enfull, M.enpart, (const int*)(ws + WS_ELTOK), G, vc};
      EpiGU E{(const int*)(ws + WS_ELDST), (const float*)(ws + WS_ELW), (const float*)(ws + WS_ELR2), BF(WS_ACT), M.pairoff};
      gk::gemm_phase<EpiGU, GUOrder, true, false, false, 9>(lds, FT, BF(WS_X1B), DM, BF(WS_WGU), DM, S, E); }
    GRID_SYNC();
    STAMP(10);
    { DNOrder S{M.pfpre, M.pcnt, M.pairoff, M.pplist, M.pnfull, M.pnpart, G, vc};
      EpiDN E{(const int*)(ws + WS_PLTOK), BF(WS_X1B), BF(WS_X1L), P.out};
      gk::gemm_phase<EpiDN, DNOrder, false, true, false, 10>(lds, FT, BF(WS_ACT), 256, BF(WS_WDN), NE * DE, S, E); }
    STAMP(11);
#ifdef PROBE_A
    GRID_SYNC();
    if (blockIdx.x == PROBE_BLK && threadIdx.x == 0) { const float us = (float)(tsl[PROBE_B] - tsl[PROBE_A]) * 0.01f; P.out[0] += us * PROBE_SCALE; }
#endif
#undef BF
#undef FT
#undef GRID_SYNC
}

extern "C" void kernel_launch(void* const* d_in, const int* in_sizes, int n_in, void* d_out, int out_size, void* d_ws, size_t ws_size, hipStream_t stream) {
    static int grid = 0;
    if (grid == 0) {
        if (n_in != 26 || in_sizes[0] != T * DM || out_size != T * DM || ws_size < WS_END) {
            fprintf(stderr, "kernel_launch: unexpected shapes (n_in %d, in0 %d, out %d, ws %zu)\n", n_in, n_in > 0 ? in_sizes[0] : -1, out_size, ws_size); grid = -1; return; }
        int dev = 0, cus = 0, per_cu = 0;
        (void)hipGetDevice(&dev);
        (void)hipDeviceGetAttribute(&cus, hipDeviceAttributeMultiprocessorCount, dev);
        (void)hipFuncSetAttribute((const void*)hybrid_fwd, hipFuncAttributeMaxDynamicSharedMemorySize, LDS_BYTES);
        (void)hipOccupancyMaxActiveBlocksPerMultiprocessor(&per_cu, (const void*)hybrid_fwd, 512, LDS_BYTES);
        if (per_cu < 1) { fprintf(stderr, "kernel_launch: occupancy query says %d blocks/CU\n", per_cu); grid = -1; return; }
        grid = cus * (per_cu > 1 ? 1 : per_cu);
        (void)hipGetLastError();
    }
    if (grid < 0) return;
    (void)hipMemsetAsync((char*)d_ws + WS_CTL, 0, 64 * 1024, stream);
    Params p{};
    for (int i = 0; i < 26; ++i) p.in[i] = (const float*)d_in[i];
    p.out = (float*)d_out; p.ws = (unsigned char*)d_ws;
    void* args[] = {&p};
    hipError_t e = hipLaunchCooperativeKernel((const void*)hybrid_fwd, dim3(grid), dim3(512), args, LDS_BYTES, stream);
    if (e != hipSuccess) fprintf(stderr, "cooperative launch failed: %s (grid %d)\n", hipGetErrorString(e), grid);
}
```
